# Optimizing an MI355X kernel written in HIP

```python
import jax
import jax.numpy as jnp
from jax import lax
import numpy as np

D_MODEL = 1024
BATCH = 4
SEQ = 4096
DEPTH = 4

GRID_W = 64
CTX_LEN = 256
N_MIXERS = 3
ROPE_BASE = 10000.0
EPS = 1e-6

RET_DK = 256
RET_DV = 512
RET_HEADS = D_MODEL // RET_DK
RET_CHUNK = 128

MLA_DN = 128
MLA_DR = 64
MLA_DV = 128
MLA_HEADS = D_MODEL // 128
MLA_Q_LORA = D_MODEL // 4
MLA_KV_LORA = D_MODEL // 4
ATTN_BLOCK = 128

SGU_DIM = 3 * D_MODEL
SGU_GROUPS = 8
SGU_CHUNK = 128

D_FF = ((8 * D_MODEL // 3 + 255) // 256) * 256
N_EXPERTS = 8
MOE_TOP_K = 2
EXPERT_D_FF = 7 * D_MODEL // 2

N_RET = (DEPTH + 2) // 3
N_MLA = (DEPTH + 1) // 3
N_SGU = DEPTH // 3
N_DENSE = (DEPTH + 1) // 2
N_MOE = DEPTH // 2

kernel_name = 'hybrid_flow_backbone'


def rmsnorm(x, g):
    xf = x.astype(jnp.float32)
    y = xf * lax.rsqrt(jnp.mean(jnp.square(xf), axis=-1, keepdims=True) + EPS)
    return (y * g).astype(x.dtype)


def modulate(x, g, shift, scale):
    return rmsnorm(x, g) * (1.0 + scale) + shift


def adaln(cond, w, b):
    m = jax.nn.silu(cond) @ w + b
    return jnp.split(m[:, None, :], 6, axis=-1)


def axial_rope_tables(rows, n_ctx, rot_dim):
    row = jnp.repeat(jnp.arange(rows, dtype=jnp.float32), GRID_W)
    col = jnp.tile(jnp.arange(GRID_W, dtype=jnp.float32), rows)
    axis_dim = rot_dim // 2
    inv_freq = ROPE_BASE ** (-jnp.arange(0, axis_dim, 2, dtype=jnp.float32) / axis_dim)
    ang_r = row[:, None] * inv_freq
    ang_c = col[:, None] * inv_freq
    ang = jnp.concatenate([ang_r, ang_r, ang_c, ang_c], axis=-1)
    cos = jnp.concatenate([jnp.ones((n_ctx, rot_dim), jnp.float32), jnp.cos(ang)], axis=0)
    sin = jnp.concatenate([jnp.zeros((n_ctx, rot_dim), jnp.float32), jnp.sin(ang)], axis=0)
    return cos[:, None, :], sin[:, None, :]


def apply_rope(x, cos, sin):
    a1, a2, b1, b2 = jnp.split(x, 4, axis=-1)
    rot = jnp.concatenate([-a2, a1, -b2, b1], axis=-1)
    return (x * cos + rot * sin).astype(x.dtype)


def chunk_retention(q, k, v, log_gamma, s0):
    B, H, L, _ = q.shape
    n = L // RET_CHUNK
    pos = jnp.arange(RET_CHUNK, dtype=jnp.float32)
    lg = log_gamma[:, None]
    q_decay = jnp.exp(lg * (pos + 1.0))[..., None]
    k_decay = jnp.exp(lg * (RET_CHUNK - 1.0 - pos))[..., None]
    diff = pos[:, None] - pos[None, :]
    intra = jnp.where(diff >= 0, jnp.exp(lg[:, :, None] * jnp.maximum(diff, 0.0)), 0.0)
    chunk_decay = jnp.exp(log_gamma * RET_CHUNK)[:, None, None]

    def blocks(a):
        return jnp.moveaxis(a.reshape(B, H, n, RET_CHUNK, a.shape[-1]), 2, 0)

    def step(s, qkv):
        qb, kb, vb = qkv
        scores = jnp.einsum('bhqd,bhkd->bhqk', qb, kb) * intra
        o = (jnp.einsum('bhqk,bhkv->bhqv', scores, vb)
             + jnp.einsum('bhqd,bhdv->bhqv', qb * q_decay, s))
        s = s * chunk_decay + jnp.einsum('bhkd,bhkv->bhdv', kb * k_decay, vb)
        return s, o

    s, o = lax.scan(step, s0, (blocks(q), blocks(k), blocks(v)))
    o = jnp.moveaxis(o, 0, 2).reshape(B, H, L, v.shape[-1])
    return o, s


def head_groupnorm(o, g):
    o = jnp.moveaxis(o, 1, 2)
    mu = jnp.mean(o, axis=-1, keepdims=True)
    var = jnp.mean(jnp.square(o - mu), axis=-1, keepdims=True)
    y = (o - mu) * lax.rsqrt(var + EPS)
    return y.reshape(y.shape[0], y.shape[1], -1) * g


def retention_mixer(hc, hl, w_in, w_o, decay_f, decay_b, gn_f, gn_b, cos, sin, with_ctx):
    B, C, _ = hc.shape
    h = jnp.concatenate([hc, hl], axis=1)
    T = h.shape[1]
    qk_w, v_w = RET_HEADS * RET_DK, RET_HEADS * RET_DV
    q, k, v, gf, gb = jnp.split(h @ w_in, [qk_w, 2 * qk_w, 2 * qk_w + v_w, 2 * qk_w + 2 * v_w], axis=-1)
    q = apply_rope(q.reshape(B, T, RET_HEADS, RET_DK), cos, sin)
    k = apply_rope(k.reshape(B, T, RET_HEADS, RET_DK), cos, sin) * (RET_DK ** -0.5)
    v = v.reshape(B, T, RET_HEADS, RET_DV)
    q, k, v = [jnp.moveaxis(a, 1, 2).astype(jnp.float32) for a in (q, k, v)]
    zero = jnp.zeros((B, RET_HEADS, RET_DK, RET_DV), jnp.float32)

    def direction(decay_logit, reverse):
        lg = jax.nn.log_sigmoid(decay_logit.astype(jnp.float32))
        f = (lambda a: jnp.flip(a, axis=2)) if reverse else (lambda a: a)
        oc, s_ctx = chunk_retention(f(q[:, :, :C]), f(k[:, :, :C]), f(v[:, :, :C]), lg, zero)
        ol, _ = chunk_retention(f(q[:, :, C:]), f(k[:, :, C:]), f(v[:, :, C:]), lg, s_ctx)
        return jnp.concatenate([f(oc), f(ol)], axis=2) if with_ctx else f(ol)

    o_f = direction(decay_f, False)
    o_b = direction(decay_b, True)
    if not with_ctx:
        gf, gb = gf[:, C:], gb[:, C:]
    mixed = jax.nn.silu(gf) * head_groupnorm(o_f, gn_f) + jax.nn.silu(gb) * head_groupnorm(o_b, gn_b)
    y = mixed.astype(h.dtype) @ w_o
    return (y[:, :C], y[:, C:]) if with_ctx else (None, y)


def softmax_attend(q, k, v, scale):
    s = jnp.einsum('bqhd,bkhd->bhqk', q, k).astype(jnp.float32) * scale
    p = jax.nn.softmax(s, axis=-1).astype(v.dtype)
    return jnp.einsum('bhqk,bkhd->bqhd', p, v)


def mla_mixer(hc, hl, w_down, g_q, g_kv, w_uq, w_ukv, w_o, cos, sin, with_ctx):
    B, C, _ = hc.shape
    h = jnp.concatenate([hc, hl], axis=1)
    T = h.shape[1]
    L = T - C
    cq, ckv, kr = jnp.split(h @ w_down, [MLA_Q_LORA, MLA_Q_LORA + MLA_KV_LORA], axis=-1)
    q = (rmsnorm(cq, g_q) @ w_uq).reshape(B, T, MLA_HEADS, MLA_DN + MLA_DR)
    q = jnp.concatenate([q[..., :MLA_DN], apply_rope(q[..., MLA_DN:], cos, sin)], axis=-1)
    kv = (rmsnorm(ckv, g_kv) @ w_ukv).reshape(B, T, MLA_HEADS, MLA_DN + MLA_DV)
    k_rope = apply_rope(kr[:, :, None, :], cos, sin)
    k = jnp.concatenate([kv[..., :MLA_DN], jnp.broadcast_to(k_rope, (B, T, MLA_HEADS, MLA_DR))], axis=-1)
    v = kv[..., MLA_DN:]
    scale = (MLA_DN + MLA_DR) ** -0.5
    nb = L // ATTN_BLOCK
    qblocks = jnp.moveaxis(q[:, C:].reshape(B, nb, ATTN_BLOCK, MLA_HEADS, MLA_DN + MLA_DR), 1, 0)
    ol = lax.map(lambda qb: softmax_attend(qb, k, v, scale), qblocks)
    ol = jnp.moveaxis(ol, 0, 1).reshape(B, L, MLA_HEADS * MLA_DV)
    if with_ctx:
        oc = softmax_attend(q[:, :C], k[:, :C], v[:, :C], scale).reshape(B, C, MLA_HEADS * MLA_DV)
        y = jnp.concatenate([oc, ol], axis=1) @ w_o
        return y[:, :C], y[:, C:]
    return None, ol @ w_o


def sgu_mixer(hc, hl, w_in, g_v, w_s, b_s, w_out, with_ctx):
    C = hc.shape[1]
    h = jnp.concatenate([hc, hl], axis=1) if with_ctx else hl
    B, T, _ = h.shape
    u, v = jnp.split(jax.nn.gelu(h @ w_in), 2, axis=-1)
    v = rmsnorm(v, g_v).reshape(B, T // SGU_CHUNK, SGU_CHUNK, SGU_GROUPS, SGU_DIM // SGU_GROUPS)
    z = jnp.einsum('gpq,bnqgc->bnpgc', w_s, v) + jnp.swapaxes(b_s, 0, 1)[:, :, None]
    y = (u * z.reshape(B, T, SGU_DIM)) @ w_out
    return (y[:, :C], y[:, C:]) if with_ctx else (None, y)


def swiglu(h, w_gu, w_down):
    g, u = jnp.split(h @ w_gu, 2, axis=-1)
    return (jax.nn.silu(g) * u) @ w_down


def moe_swiglu(h, w_router, w_gu, w_down):
    B, T, D = h.shape
    hf = h.reshape(B * T, D)
    logits = (hf @ w_router).astype(jnp.float32)
    top_v, top_i = lax.top_k(logits, MOE_TOP_K)
    top_w = jax.nn.softmax(top_v, axis=-1)
    gates = jnp.sum(jax.nn.one_hot(top_i, N_EXPERTS, dtype=jnp.float32) * top_w[..., None], axis=1)
    gates = gates.astype(hf.dtype)
    y = jnp.zeros_like(hf)
    for e in range(N_EXPERTS):
        y = y + gates[:, e:e + 1] * swiglu(hf, w_gu[e], w_down[e])
    return y.reshape(B, T, D)


def setup_inputs(seed: int = 0) -> dict:
    key = jax.random.key(seed)
    keys = iter(jax.random.split(key, 40))
    f32 = jnp.float32

    def nrm(shape, fan_in, scale=1.0):
        return jax.random.normal(next(keys), shape, f32) * (scale * fan_in ** -0.5)

    def gain(shape):
        return 1.0 + 0.02 * jax.random.normal(next(keys), shape, f32)

    gamma0 = 1.0 - 2.0 ** (-5.0 - jnp.arange(RET_HEADS, dtype=f32))
    logit0 = jnp.log(gamma0) - jnp.log1p(-gamma0)
    return {
        'x': jax.random.normal(next(keys), (BATCH, SEQ, D_MODEL), f32),
        'c': jax.random.normal(next(keys), (BATCH, D_MODEL), f32),
        'ctx': jax.random.normal(next(keys), (BATCH, CTX_LEN, D_MODEL), f32),
        'c_ctx': jax.random.normal(next(keys), (D_MODEL,), f32),
        'ada_w': nrm((DEPTH, D_MODEL, 6 * D_MODEL), D_MODEL, 0.5),
        'ada_b': 0.02 * jax.random.normal(next(keys), (DEPTH, 6 * D_MODEL), f32),
        'norm_mix_g': gain((DEPTH, D_MODEL)),
        'norm_ffn_g': gain((DEPTH, D_MODEL)),
        'final_norm_g': gain((D_MODEL,)),
        'ret_w_in': nrm((N_RET, D_MODEL, 2 * RET_HEADS * RET_DK + 3 * RET_HEADS * RET_DV), D_MODEL),
        'ret_w_o': nrm((N_RET, RET_HEADS * RET_DV, D_MODEL), RET_HEADS * RET_DV),
        'ret_decay_f': logit0 + 0.1 * jax.random.normal(next(keys), (N_RET, RET_HEADS), f32),
        'ret_decay_b': logit0 + 0.1 * jax.random.normal(next(keys), (N_RET, RET_HEADS), f32),
        'ret_gn_f': gain((N_RET, RET_HEADS * RET_DV)),
        'ret_gn_b': gain((N_RET, RET_HEADS * RET_DV)),
        'mla_w_down': nrm((N_MLA, D_MODEL, MLA_Q_LORA + MLA_KV_LORA + MLA_DR), D_MODEL),
        'mla_g_q': gain((N_MLA, MLA_Q_LORA)),
        'mla_g_kv': gain((N_MLA, MLA_KV_LORA)),
        'mla_w_uq': nrm((N_MLA, MLA_Q_LORA, MLA_HEADS * (MLA_DN + MLA_DR)), MLA_Q_LORA),
        'mla_w_ukv': nrm((N_MLA, MLA_KV_LORA, MLA_HEADS * (MLA_DN + MLA_DV)), MLA_KV_LORA),
        'mla_w_o': nrm((N_MLA, MLA_HEADS * MLA_DV, D_MODEL), MLA_HEADS * MLA_DV),
        'sgu_w_in': nrm((N_SGU, D_MODEL, 2 * SGU_DIM), D_MODEL),
        'sgu_g_v': gain((N_SGU, SGU_DIM)),
        'sgu_w_s': nrm((N_SGU, SGU_GROUPS, SGU_CHUNK, SGU_CHUNK), SGU_CHUNK),
        'sgu_b_s': gain((N_SGU, SGU_GROUPS, SGU_CHUNK)),
        'sgu_w_out': nrm((N_SGU, SGU_DIM, D_MODEL), SGU_DIM),
        'ffn_w_gu': nrm((N_DENSE, D_MODEL, 2 * D_FF), D_MODEL),
        'ffn_w_down': nrm((N_DENSE, D_FF, D_MODEL), D_FF),
        'moe_w_router': nrm((N_MOE, D_MODEL, N_EXPERTS), D_MODEL),
        'moe_w_gu': nrm((N_MOE, N_EXPERTS, D_MODEL, 2 * EXPERT_D_FF), D_MODEL),
        'moe_w_down': nrm((N_MOE, N_EXPERTS, EXPERT_D_FF, D_MODEL), EXPERT_D_FF),
    }


def reference(x, c, ctx, c_ctx, ada_w, ada_b, norm_mix_g, norm_ffn_g, final_norm_g,
              ret_w_in, ret_w_o, ret_decay_f, ret_decay_b, ret_gn_f, ret_gn_b,
              mla_w_down, mla_g_q, mla_g_kv, mla_w_uq, mla_w_ukv, mla_w_o,
              sgu_w_in, sgu_g_v, sgu_w_s, sgu_b_s, sgu_w_out,
              ffn_w_gu, ffn_w_down, moe_w_router, moe_w_gu, moe_w_down):
    L = x.shape[1]
    C = ctx.shape[1]
    rows = L // GRID_W
    ret_cos, ret_sin = axial_rope_tables(rows, C, RET_DK)
    mla_cos, mla_sin = axial_rope_tables(rows, C, MLA_DR)
    xl, xc = x, ctx
    for i in range(DEPTH):
        with_ctx = i < DEPTH - 1
        ml = adaln(c, ada_w[i], ada_b[i])
        mc = adaln(c_ctx[None, :], ada_w[i], ada_b[i])
        hl = modulate(xl, norm_mix_g[i], ml[0], ml[1])
        hc = modulate(xc, norm_mix_g[i], mc[0], mc[1])
        kind, j = i % N_MIXERS, i // N_MIXERS
        if kind == 0:
            yc, yl = retention_mixer(hc, hl, ret_w_in[j], ret_w_o[j], ret_decay_f[j], ret_decay_b[j],
                                     ret_gn_f[j], ret_gn_b[j], ret_cos, ret_sin, with_ctx)
        elif kind == 1:
            yc, yl = mla_mixer(hc, hl, mla_w_down[j], mla_g_q[j], mla_g_kv[j], mla_w_uq[j],
                               mla_w_ukv[j], mla_w_o[j], mla_cos, mla_sin, with_ctx)
        else:
            yc, yl = sgu_mixer(hc, hl, sgu_w_in[j], sgu_g_v[j], sgu_w_s[j], sgu_b_s[j],
                               sgu_w_out[j], with_ctx)
        xl = xl + ml[2] * yl
        hl = modulate(xl, norm_ffn_g[i], ml[3], ml[4])
        if with_ctx:
            xc = xc + mc[2] * yc
            hc = modulate(xc, norm_ffn_g[i], mc[3], mc[4])
            h = jnp.concatenate([hc, hl], axis=1)
        else:
            h = hl
        f = i // 2
        if i % 2 == 0:
            y = swiglu(h, ffn_w_gu[f], ffn_w_down[f])
        else:
            y = moe_swiglu(h, moe_w_router[f], moe_w_gu[f], moe_w_down[f])
        if with_ctx:
            xc = xc + mc[5] * y[:, :C]
            xl = xl + ml[5] * y[:, C:]
        else:
            xl = xl + ml[5] * y
    return rmsnorm(xl, final_norm_g)
```

```cpp
#include <hip/hip_runtime.h>
#include <cstdio>
#include <cstdint>

namespace pg8 {
#define PG8_LAS __attribute__((address_space(3)))
typedef unsigned short bf16_t;
typedef short bf16x8 __attribute__((ext_vector_type(8)));
typedef float f32x4 __attribute__((ext_vector_type(4)));
typedef float f32x2 __attribute__((ext_vector_type(2)));
typedef unsigned u32x4 __attribute__((ext_vector_type(4)));
typedef unsigned u32x2 __attribute__((ext_vector_type(2)));
constexpr int BM = 256, BK = 64, HALF = 128, HTB = HALF * BK * 2  , STAGE_BYTES = 8 * HTB, NXCD = 8, WGM = 8;

__host__ __device__ __forceinline__ int lds_byte(int r, int c) { const int st = (r >> 4) * 2 + (c >> 5), rr = r & 15, cc = c & 31, ob = rr * 64 + cc * 2; return st * 1024 + (ob ^ (((ob >> 9) & 1) << 5)); }
__host__ __device__ __forceinline__ void stage_rc(int b, int& R, int& C) { const int st = b / 1024, sb = b % 1024, swz = sb ^ (((sb >> 9) & 1) << 5); R = (st >> 1) * 16 + swz / 64; C = (st & 1) * 32 + (swz % 64) / 2; }
__host__ __device__ __forceinline__ int perm32(int rho) { const int n = rho >> 4, i = rho & 15; return 8 * (i >> 2) + 4 * n + (i & 3); }

struct Unit { int pm, pn; };
struct Gemm { const bf16_t* A; const bf16_t* Bt; int K, lda; };

struct StaticOrder {
    int nM, nN, nwg, G, c; size_t tA, tB;
    __device__ void init(int nM_, int nN_, int G_, int c_, int K, int lda) { nM = nM_; nN = nN_; nwg = nM * nN; G = G_; c = c_; tA = (size_t)BM * lda * 2; tB = (size_t)BM * K * 2; }
    __device__ bool next(int i, Unit& u) const {
        const long L = (long)i * G + c; if (L >= nwg) return false;
        int wgid = (int)L; { const int q = nwg / NXCD, r = nwg % NXCD, xcd = wgid % NXCD, off = wgid / NXCD; wgid = (xcd < r ? xcd * (q + 1) : r * (q + 1) + (xcd - r) * q) + off; }
        const int nig = WGM * nN, gid = wgid / nig, fm = gid * WGM, gsz = (nM - fm) < WGM ? (nM - fm) : WGM;
        u.pm = fm + ((wgid % nig) % gsz); u.pn = (wgid % nig) / gsz; return true;
    }
    __device__ __forceinline__ size_t aofs(const Unit& u) const { return (size_t)u.pm * tA; }
    __device__ __forceinline__ size_t bofs(const Unit& u) const { return (size_t)u.pn * tB; }
    __device__ __forceinline__ int arow(const Unit& u, int r) const { return u.pm * BM + r; }
};
struct MoeOrder : StaticOrder {
    int ts[9]; size_t estride; const int* rowidx;
    __device__ __forceinline__ int expert(int pm) const { int e = 0;
#pragma unroll
        for (int j = 1; j < 8; ++j) e += (pm >= ts[j]) ? 1 : 0; return e; }
    __device__ __forceinline__ size_t bofs(const Unit& u) const { return (size_t)expert(u.pm) * estride + (size_t)u.pn * tB; }
    __device__ __forceinline__ int arow(const Unit& u, int r) const { return rowidx[u.pm * BM + r]; }
};

__device__ __forceinline__ unsigned cvt_pk_bf16(float lo, float hi) { unsigned r; asm volatile("v_cvt_pk_bf16_f32 %0, %1, %2" : "=v"(r) : "v"(lo), "v"(hi)); return r; }
__device__ __forceinline__ float fast_sigmoid(float x) { return __builtin_amdgcn_rcpf(1.0f + __builtin_amdgcn_exp2f(-1.4426950408889634f * x)); }
__device__ __forceinline__ float gelu_tanh(float x) { const float u = 0.7978845608028654f * (x + 0.044715f * x * x * x); return x * fast_sigmoid(2.0f * u); }

struct EpiF32 {
    static constexpr bool PERM = false;
    float* C; int ldc;
    __device__ __forceinline__ void operator()(const f32x4 (&acc)[2][2][4][2], const Unit& u, int wr, int wc, int fr, int fq) const {
        const int row0 = u.pm * BM + wr * 64 + fr, col0 = u.pn * BM + wc * 32 + 4 * fq;
#pragma unroll
        for (int ai = 0; ai < 2; ++ai)
#pragma unroll
            for (int m = 0; m < 4; ++m) { float* rowp = C + (size_t)(row0 + ai * HALF + m * 16) * ldc + col0;
#pragma unroll
                for (int bj = 0; bj < 2; ++bj)
#pragma unroll
                    for (int n = 0; n < 2; ++n) *(f32x4*)(rowp + bj * HALF + n * 16) = acc[ai][bj][m][n]; }
    }
};
template <int ACT  > struct EpiBf16 {
    static constexpr bool PERM = true;
    bf16_t* O; int ldc;
    __device__ __forceinline__ void operator()(const f32x4 (&acc)[2][2][4][2], const Unit& u, int wr, int wc, int fr, int fq) const {
        const int row0 = u.pm * BM + wr * 64 + fr, col0 = u.pn * BM + wc * 32 + 8 * fq;
#pragma unroll
        for (int ai = 0; ai < 2; ++ai)
#pragma unroll
            for (int m = 0; m < 4; ++m) { bf16_t* rowp = O + (size_t)(row0 + ai * HALF + m * 16) * ldc + col0;
#pragma unroll
                for (int bj = 0; bj < 2; ++bj) { f32x4 v0 = acc[ai][bj][m][0], v1 = acc[ai][bj][m][1];
                    if (ACT == 3) {
#pragma unroll
                        for (int j = 0; j < 4; ++j) { v0[j] = gelu_tanh(v0[j]); v1[j] = gelu_tanh(v1[j]); } }
                    u32x4 w; w.x = cvt_pk_bf16(v0[0], v0[1]); w.y = cvt_pk_bf16(v0[2], v0[3]); w.z = cvt_pk_bf16(v1[0], v1[1]); w.w = cvt_pk_bf16(v1[2], v1[3]);
                    *(u32x4*)(rowp + bj * HALF) = w; } }
    }
};
struct EpiRes {
    static constexpr bool PERM = false;
    float* X; const float* gate; int tile0;
    __device__ __forceinline__ void operator()(const f32x4 (&acc)[2][2][4][2], const Unit& u, int wr, int wc, int fr, int fq) const {
        const int row0 = u.pm * BM + wr * 64 + fr, col0 = u.pn * BM + wc * 32 + 4 * fq;
        const int tg = u.pm + tile0, cond = tg < 4 ? 4 : ((tg - 4) >> 4);
        const float* gp = gate + cond * 6144 + col0;
        f32x4 gv[2][2];
#pragma unroll
        for (int bj = 0; bj < 2; ++bj)
#pragma unroll
            for (int n = 0; n < 2; ++n) gv[bj][n] = *(const f32x4*)(gp + bj * HALF + n * 16);
#pragma unroll
        for (int ai = 0; ai < 2; ++ai)
#pragma unroll
            for (int m = 0; m < 4; ++m) { float* rowp = X + (size_t)(row0 + ai * HALF + m * 16) * 1024 + col0;
#pragma unroll
                for (int bj = 0; bj < 2; ++bj)
#pragma unroll
                    for (int n = 0; n < 2; ++n) { f32x4* p = (f32x4*)(rowp + bj * HALF + n * 16); const f32x4 x = *p; *p = x + gv[bj][n] * acc[ai][bj][m][n]; } }
    }
};
struct EpiSwiglu {
    static constexpr bool PERM = false;
    bf16_t* O; int ldo;
    __device__ __forceinline__ void operator()(const f32x4 (&acc)[2][2][4][2], const Unit& u, int wr, int wc, int fr, int fq) const {
        const int row0 = u.pm * BM + wr * 64 + fr, col0 = u.pn * HALF + wc * 16 + 4 * fq;
#pragma unroll
        for (int ai = 0; ai < 2; ++ai)
#pragma unroll
            for (int m = 0; m < 4; ++m) { bf16_t* rowp = O + (size_t)(row0 + ai * HALF + m * 16) * ldo + col0;
#pragma unroll
                for (int bj = 0; bj < 2; ++bj) { const f32x4 g = acc[ai][bj][m][0], uu = acc[ai][bj][m][1]; f32x4 h;
#pragma unroll
                    for (int j = 0; j < 4; ++j) h[j] = g[j] * fast_sigmoid(g[j]) * uu[j];
                    u32x2 w; w.x = cvt_pk_bf16(h[0], h[1]); w.y = cvt_pk_bf16(h[2], h[3]);
                    *(u32x2*)(rowp + bj * 64) = w; } }
    }
};

template <class Epi, class Sched, bool GATHER = false, bool ALIGN_EPI = true>
__device__ __forceinline__ void gemm_phase(PG8_LAS unsigned char* lds, const Gemm g, const Sched& S, const Epi& E) {
    const int tid = threadIdx.x, wid = __builtin_amdgcn_readfirstlane(tid >> 6), lane = tid & 63, wr = wid >> 2, wc = wid & 3, fr = lane & 15, fq = lane >> 4;
    const int K = g.K, nt = K / BK, lda = g.lda;
    unsigned voffA[2], voffB[2]; int sR[2], sC[2];
#pragma unroll
    for (int i = 0; i < 2; ++i) { int R, C; stage_rc(tid * 16 + i * 8192, R, C); const int Rb = Epi::PERM ? ((R & ~31) + perm32(R & 31)) : R;
        voffA[i] = (unsigned)(R * lda + C) * 2u; voffB[i] = (unsigned)(Rb * K + C) * 2u; sR[i] = R; sC[i] = C * 2; }
    const size_t kstep = (size_t)(BK * 2);
    const size_t hstepA = (size_t)HALF * lda * 2, hstepB = (size_t)HALF * K * 2;
    const unsigned ldsw = (unsigned)wid * 1024u;
    const int aoff = lds_byte(wr * 64 + fr, fq * 8), boff = lds_byte(wc * 32 + fr, fq * 8);
    unsigned ao[2][2], aon[2][2];
#define PG8_SA(b, h) (((b) * 2 + (h)) * HTB)
#define PG8_SB(b, h) ((4 + (b) * 2 + (h)) * HTB)
#define PG8_STAGE(bufoff, gbase, voff) do { _Pragma("unroll") for (int _i = 0; _i < 2; ++_i) \
        __builtin_amdgcn_global_load_lds((const unsigned*)((const char*)(gbase) + (voff)[_i]), (PG8_LAS unsigned*)(lds + (bufoff) + ldsw + _i * 8192), 16, 0, 0); } while (0)
#define PG8_STAGE_A(bufoff, h, ab, OA) do { if constexpr (GATHER) { PG8_STAGE(bufoff, ab, (OA)[h]); } else { PG8_STAGE(bufoff, (ab) + (h) * hstepA, voffA); } } while (0)
#define PG8_GOFFS(dst, uu) do { _Pragma("unroll") for (int _h = 0; _h < 2; ++_h) _Pragma("unroll") for (int _i = 0; _i < 2; ++_i) \
        (dst)[_h][_i] = (unsigned)S.arow(uu, _h * HALF + sR[_i]) * (unsigned)(lda * 2) + (unsigned)sC[_i]; } while (0)
#define PG8_LDA(dst, b, h) do { _Pragma("unroll") for (int m = 0; m < 4; ++m) _Pragma("unroll") for (int k = 0; k < 2; ++k) dst[m][k] = *(const PG8_LAS bf16x8*)(lds + PG8_SA(b, h) + aoff + m * 2048 + k * 1024); } while (0)
#define PG8_LDB(dst, b, h) do { _Pragma("unroll") for (int n = 0; n < 2; ++n) _Pragma("unroll") for (int k = 0; k < 2; ++k) dst[n][k] = *(const PG8_LAS bf16x8*)(lds + PG8_SB(b, h) + boff + n * 2048 + k * 1024); } while (0)
#define PG8_MMA(ai, bj, At, Bt) do { __builtin_amdgcn_s_setprio(1); _Pragma("unroll") for (int m = 0; m < 4; ++m) _Pragma("unroll") for (int n = 0; n < 2; ++n) _Pragma("unroll") for (int k = 0; k < 2; ++k) \
        acc[ai][bj][m][n] = __builtin_amdgcn_mfma_f32_16x16x32_bf16(Bt[n][k], At[m][k], acc[ai][bj][m][n], 0, 0, 0); __builtin_amdgcn_s_setprio(0); } while (0)
#define PG8_WAIT_V(n) asm volatile("s_waitcnt vmcnt(" #n ")" ::: "memory")
#define PG8_WAIT_L(n) asm volatile("s_waitcnt lgkmcnt(" #n ")" ::: "memory")
#define PG8_BAR __builtin_amdgcn_s_barrier()
#define PG8_SCHED __builtin_amdgcn_sched_barrier(0)
    Unit cur, nxt; int ui = 0;
    if (!S.next(0, cur)) return;
    f32x4 acc[2][2][4][2];
#pragma unroll
    for (int a = 0; a < 2; ++a)
#pragma unroll
        for (int b = 0; b < 2; ++b)
#pragma unroll
            for (int m = 0; m < 4; ++m)
#pragma unroll
                for (int n = 0; n < 2; ++n) acc[a][b][m][n] = (f32x4){0.f, 0.f, 0.f, 0.f};
    bf16x8 At[4][2], B0[2][2], B1[2][2];
    const char* cA = (const char*)g.A + (GATHER ? (size_t)0 : S.aofs(cur)); const char* cB = (const char*)g.Bt + S.bofs(cur);
    if constexpr (GATHER) { PG8_GOFFS(ao, cur);
#pragma unroll
        for (int h = 0; h < 2; ++h)
#pragma unroll
            for (int i = 0; i < 2; ++i) aon[h][i] = ao[h][i]; }
    PG8_STAGE(PG8_SB(0, 0), cB, voffB); PG8_STAGE(PG8_SB(0, 1), cB + hstepB, voffB); PG8_STAGE_A(PG8_SA(0, 0), 0, cA, ao); PG8_STAGE_A(PG8_SA(0, 1), 1, cA, ao);
    if (wr == 1) PG8_BAR;
    PG8_WAIT_V(2); PG8_BAR;
    PG8_STAGE(PG8_SB(1, 0), cB + kstep, voffB); PG8_STAGE_A(PG8_SA(1, 0), 0, cA + kstep, ao); PG8_STAGE(PG8_SB(1, 1), cB + hstepB + kstep, voffB);
    PG8_WAIT_V(6); PG8_BAR;
    for (;;) {
        const bool has_next = S.next(ui + 1, nxt);
        const char* nA = (GATHER || !has_next) ? cA : (const char*)g.A + S.aofs(nxt); const char* nB = has_next ? (const char*)g.Bt + S.bofs(nxt) : cB;
        for (int t = 0; t < nt; t += 2) {
            const bool last = (t == nt - 2);
            const char* a1 = cA + (size_t)(t + 1) * kstep;
            const char* a2 = last ? nA : cA + (size_t)(t + 2) * kstep; const char* b2 = last ? nB : cB + (size_t)(t + 2) * kstep;
            const char* a3 = a2 + kstep; const char* b3 = b2 + kstep;
            unsigned o2[2][2];
            if constexpr (GATHER) {
                if (last && has_next) PG8_GOFFS(aon, nxt);
#pragma unroll
                for (int h = 0; h < 2; ++h)
#pragma unroll
                    for (int i = 0; i < 2; ++i) o2[h][i] = last ? aon[h][i] : ao[h][i];
            }
            PG8_LDB(B0, 0, 0); PG8_LDB(B1, 0, 1); PG8_SCHED; PG8_LDA(At, 0, 0); PG8_STAGE_A(PG8_SA(1, 1), 1, a1, ao);
            PG8_WAIT_V(8); PG8_WAIT_L(0); PG8_BAR; PG8_MMA(0, 0, At, B0); PG8_MMA(0, 1, At, B1); PG8_BAR; PG8_SCHED;
            PG8_LDA(At, 0, 1); PG8_STAGE(PG8_SB(0, 0), b2, voffB); PG8_STAGE(PG8_SB(0, 1), b2 + hstepB, voffB); PG8_STAGE_A(PG8_SA(0, 0), 0, a2, o2);
            PG8_WAIT_V(8); PG8_WAIT_L(0); PG8_BAR; PG8_MMA(1, 0, At, B0); PG8_MMA(1, 1, At, B1); PG8_BAR; PG8_SCHED;
            PG8_LDB(B0, 1, 0); PG8_LDB(B1, 1, 1); PG8_SCHED; PG8_LDA(At, 1, 0); PG8_STAGE_A(PG8_SA(0, 1), 1, a2, o2);
            PG8_WAIT_V(8); PG8_WAIT_L(0); PG8_BAR; PG8_MMA(0, 0, At, B0); PG8_MMA(0, 1, At, B1); PG8_BAR; PG8_SCHED;
            PG8_LDA(At, 1, 1); PG8_STAGE(PG8_SB(1, 0), b3, voffB); PG8_STAGE(PG8_SB(1, 1), b3 + hstepB, voffB); PG8_STAGE_A(PG8_SA(1, 0), 0, a3, o2);
            PG8_WAIT_V(8); PG8_WAIT_L(0); PG8_BAR; PG8_MMA(1, 0, At, B0); PG8_MMA(1, 1, At, B1); PG8_BAR; PG8_SCHED;
        }
        if constexpr (ALIGN_EPI) { if (wr == 0) PG8_BAR; }
        E(acc, cur, wr, wc, fr, fq);
        if (!has_next) break;
#pragma unroll
        for (int a = 0; a < 2; ++a)
#pragma unroll
            for (int b = 0; b < 2; ++b)
#pragma unroll
                for (int m = 0; m < 4; ++m)
#pragma unroll
                    for (int n = 0; n < 2; ++n) acc[a][b][m][n] = (f32x4){0.f, 0.f, 0.f, 0.f};
        cur = nxt; cA = nA; cB = nB; ++ui;
        if constexpr (GATHER) {
#pragma unroll
            for (int h = 0; h < 2; ++h)
#pragma unroll
                for (int i = 0; i < 2; ++i) ao[h][i] = aon[h][i]; }
        if constexpr (ALIGN_EPI) { if (wr == 1) PG8_BAR; }
    }
    PG8_WAIT_V(0);
    if constexpr (!ALIGN_EPI) { if (wr == 0) PG8_BAR; }
    PG8_BAR;
#undef PG8_SA
#undef PG8_SB
#undef PG8_STAGE
#undef PG8_STAGE_A
#undef PG8_GOFFS
#undef PG8_LDA
#undef PG8_LDB
#undef PG8_MMA
#undef PG8_WAIT_V
#undef PG8_WAIT_L
#undef PG8_BAR
#undef PG8_SCHED
}
}

constexpr int D = 1024, NB = 4, SEQ = 4096, CTXL = 256, TT = CTXL + SEQ;
constexpr int NCTX = NB * CTXL;
constexpr int NLAT = NB * SEQ;
constexpr int NR = NCTX + NLAT;
constexpr int DFF = 2816, EFF = 3584, NEXP = 8;
constexpr int RET_NIN = 8192;
constexpr float EPS = 1e-6f;
constexpr int MOE_MAXROWS = 36864;

constexpr size_t MiB = 1u << 20;
constexpr size_t WS_CTL = 0, CTL_ZERO_BYTES = 1 * MiB;
constexpr size_t WS_MOD = 1 * MiB;
constexpr size_t WS_TOK = 2 * MiB;
constexpr size_t WS_ROWIDX = 3 * MiB;
constexpr size_t WS_RSTD = 4 * MiB;
constexpr size_t WS_WSB = 5 * MiB;
constexpr size_t WS_W = 6 * MiB;
constexpr size_t W_RETIN = WS_W;
constexpr size_t W_RETO = W_RETIN + 32 * MiB;
constexpr size_t W_MLAD = W_RETO + 8 * MiB;
constexpr size_t W_UQ = W_MLAD + 2 * MiB;
constexpr size_t W_UKV = W_UQ + 1 * MiB;
constexpr size_t W_MLAO = W_UKV + 1 * MiB;
constexpr size_t W_SGUIN = W_MLAO + 2 * MiB;
constexpr size_t W_SGUOUT = W_SGUIN + 12 * MiB;
constexpr size_t W_FFNGU = W_SGUOUT + 6 * MiB;
constexpr size_t W_FFND = W_FFNGU + 22 * MiB;
constexpr size_t W_MOEGU = W_FFND + 11 * MiB;
constexpr size_t W_MOED = W_MOEGU + 224 * MiB;
constexpr size_t WS_X = W_MOED + 112 * MiB;
constexpr size_t WS_H = WS_X + 68 * MiB;
constexpr size_t WS_BIG = WS_H + 34 * MiB;
constexpr size_t WS_PREP = WS_BIG + 272 * MiB;
constexpr size_t WS_OFB = WS_PREP + 170 * MiB;
constexpr size_t WS_MIX = WS_OFB + 136 * MiB;
constexpr size_t WS_END = WS_MIX + 68 * MiB;
constexpr size_t PREP_KTF = WS_PREP, PREP_KTB = PREP_KTF + 34 * MiB, PREP_VT = PREP_KTB + 34 * MiB, PREP_PF = PREP_VT + 68 * MiB, PREP_PB = PREP_PF + 17 * MiB;
constexpr size_t MLA_CKV = WS_BIG;
constexpr size_t MLA_CQN = MLA_CKV + 52 * MiB;
constexpr size_t MLA_CKVN = MLA_CQN + 9 * MiB;
constexpr size_t MLA_KR = MLA_CKVN + 9 * MiB;
constexpr size_t MLA_Q = MLA_KR + 3 * MiB;
constexpr int KVR_LD = 2112;
constexpr size_t MLA_KV = MLA_Q + 52 * MiB;
constexpr size_t MLA_O = MLA_KV + 71 * MiB;
static_assert(MLA_O + 34 * MiB <= WS_PREP, "MLA map");
constexpr size_t MOE_HID = WS_BIG;
constexpr size_t MOE_Y = WS_PREP;
constexpr size_t SGU_UV = WS_BIG;
constexpr size_t SGU_UZ = WS_PREP;
constexpr size_t FFN_HID = WS_BIG;
constexpr int CW_BAR = 4096;
constexpr int CW_MOECNT = 16384;

constexpr int RING_BYTES = 131072;
constexpr int LDSCTL_OFF = RING_BYTES, MISC_OFF = LDSCTL_OFF + 320;
constexpr int LDS_BYTES = 147456;
constexpr int NWAVES = 8;

#define GAS __attribute__((address_space(1)))
#define LAS __attribute__((address_space(3)))
typedef unsigned short bf16;
typedef unsigned v4u __attribute__((ext_vector_type(4)));
typedef unsigned v2u __attribute__((ext_vector_type(2)));
typedef float f32x4 __attribute__((ext_vector_type(4)));
typedef float f32x2 __attribute__((ext_vector_type(2)));
typedef short bf16x8 __attribute__((ext_vector_type(8)));
typedef GAS unsigned gu32;
#define RLX_AGENT __ATOMIC_RELAXED, __HIP_MEMORY_SCOPE_AGENT
#define LDS_WAIT() asm volatile("s_waitcnt lgkmcnt(0)" ::: "memory")
#define VM_WAIT() asm volatile("s_waitcnt vmcnt(0)" ::: "memory")
__device__ __forceinline__ unsigned f2bf(float f) { unsigned u = __builtin_bit_cast(unsigned, f); return (u + 0x7fffu + ((u >> 16) & 1u)) >> 16; }
__device__ __forceinline__ unsigned pk2(float lo, float hi) { return f2bf(lo) | (f2bf(hi) << 16); }
__device__ __forceinline__ float bf2f(unsigned short v) { return __builtin_bit_cast(float, (unsigned)v << 16); }
__device__ __forceinline__ float bflo(unsigned w) { return __builtin_bit_cast(float, w << 16); }
__device__ __forceinline__ float bfhi(unsigned w) { return __builtin_bit_cast(float, w & 0xffff0000u); }
__device__ __forceinline__ float sigmoidf_(float x) { return 1.0f / (1.0f + __expf(-x)); }

#define XB_TMO      128
#define XB_XCNT(j)  (256  + 64 * (j))
#define XB_XSUB(j)  (1280 + 64 * (j))
#define XB_XGEN(j)  (2304 + 64 * (j))
#define XB_TOP      3328
#define XB_TOPGEN   3392
#define XCD_BAR_WORDS 3456
#define XB_SPIN_CAP (1u << 18)

__device__ __forceinline__ unsigned xb_ld(unsigned* p)              { return __hip_atomic_load(p, __ATOMIC_RELAXED, __HIP_MEMORY_SCOPE_AGENT); }
__device__ __forceinline__ unsigned xb_add(unsigned* p, unsigned v) { return __hip_atomic_fetch_add(p, v, __ATOMIC_RELAXED, __HIP_MEMORY_SCOPE_AGENT); }
__device__ __forceinline__ unsigned xb_xcc_id() { return (unsigned)__builtin_amdgcn_s_getreg((3 << 11) | 20) & 0xFu; }
#define XB_SPIN(cond, bar) do { unsigned _sp = 0; while (cond) { __builtin_amdgcn_s_sleep(1); \
    if ((++_sp & 255u) == 0u) { if (xb_ld(&(bar)[XB_TMO])) break; if (_sp > XB_SPIN_CAP) { atomicAdd(&(bar)[XB_TMO], 1u); break; } } } } while (0)

struct XcdBarrier {
    unsigned* bar; unsigned x;
    volatile LAS unsigned* st;
};
__device__ __forceinline__ XcdBarrier xcd_barrier_post(unsigned* bar, volatile LAS unsigned* st) {
    XcdBarrier b; b.bar = bar; b.x = xb_xcc_id(); b.st = st;
    if (threadIdx.x == 0) (void)xb_add(&bar[XB_XCNT(b.x)], 1u);
    return b;
}
__device__ __forceinline__ void xcd_barrier_complete(unsigned* bar, unsigned x, unsigned& nloc, unsigned& nx) {
    const unsigned G = gridDim.x * gridDim.y * gridDim.z;
    unsigned sum, cnt, mine, sp = 0u;
    for (;;) {
        sum = 0u; cnt = 0u; mine = 0u;
#pragma unroll
        for (unsigned j = 0; j < 16; ++j) { const unsigned c = xb_ld(&bar[XB_XCNT(j)]); sum += c; cnt += (c > 0u) ? 1u : 0u; mine = (j == x) ? c : mine; }
        if (sum == G) break;
        __builtin_amdgcn_s_sleep(1);
        if ((++sp & 255u) == 0u) { if (xb_ld(&bar[XB_TMO])) break; if (sp > XB_SPIN_CAP) { atomicAdd(&bar[XB_TMO], 1u); break; } }
    }
    nloc = mine > 0u ? mine : 1u; nx = cnt > 0u ? cnt : 1u;
}
__device__ __forceinline__ void xcd_barrier(const XcdBarrier& b) {
    asm volatile("s_waitcnt vmcnt(0)" ::: "memory");
    __syncthreads();
    if (threadIdx.x == 0) {
        unsigned* bar = b.bar;
        __builtin_amdgcn_s_waitcnt(0);
        unsigned nloc = b.st[0], nx = b.st[1];
        if (nloc == 0u) { xcd_barrier_complete(bar, b.x, nloc, nx); b.st[0] = nloc; b.st[1] = nx; }
        const unsigned old = xb_add(&bar[XB_XSUB(b.x)], 1u);
        const unsigned gen = old / nloc;
        if (old + 1u == (gen + 1u) * nloc) {
            __builtin_amdgcn_fence(__ATOMIC_RELEASE, "agent");
            asm volatile("s_waitcnt vmcnt(0)" ::: "memory");
            const unsigned og = xb_add(&bar[XB_TOP], 1u);
            const unsigned tg = og / nx;
            if (og + 1u == (tg + 1u) * nx) xb_add(&bar[XB_TOPGEN], 1u);
            else XB_SPIN(xb_ld(&bar[XB_TOPGEN]) == tg, bar);
            __builtin_amdgcn_fence(__ATOMIC_ACQUIRE, "agent");
            xb_add(&bar[XB_XGEN(b.x)], 1u);
            asm volatile("s_waitcnt vmcnt(0)" ::: "memory");
        } else {
            XB_SPIN(xb_ld(&bar[XB_XGEN(b.x)]) == gen, bar);
            __builtin_amdgcn_fence(__ATOMIC_ACQUIRE, "agent");
            asm volatile("s_waitcnt vmcnt(0)" ::: "memory");
        }
    }
    __syncthreads();
}

struct Frame {
    LAS unsigned char* lds;
    gu32* ctl;
    unsigned char* ws;
    int tid, lane, wave;
    int vcu, G;
    const float* const* in;
};
__device__ __forceinline__ float wave_sum(float v) {
#pragma unroll
    for (int o = 1; o < 64; o <<= 1) v += __shfl_xor(v, o);
    return v;
}
__device__ __forceinline__ int row_cond(int row) { return row < NCTX ? 4 : ((row - NCTX) >> 12); }

enum { MAP_ID = 0, MAP_GU = 1, MAP_PAD = 2 };
template <int MAP>
__device__ __forceinline__ void tr_item(const float* W, int Nsrc, int K, bf16* WT, int Fdim, LAS float* scr, int item, int nblk, int lane) {
    const int kb = item / nblk, nb = item % nblk, k0 = 64 * kb, n0 = 32 * nb;
    const int nl = lane & 31; int sc;
    if (MAP == MAP_GU) sc = ((nl < 16) ? 0 : Fdim) + (n0 >> 1) + (nl & 15);
    else sc = n0 + nl;
    const bool valid = (MAP != MAP_PAD) || (sc < Nsrc);
#pragma unroll 8
    for (int i = 0; i < 32; ++i) { const int kk = 2 * i + (lane >> 5); scr[kk * 33 + nl] = valid ? W[(size_t)(k0 + kk) * Nsrc + sc] : 0.f; }
    LDS_WAIT(); asm volatile("" ::: "memory");
    const int c = lane & 7;
#pragma unroll
    for (int j = 0; j < 4; ++j) { const int n = (lane >> 3) + 8 * j; const LAS float* s = scr + (8 * c) * 33 + n;
        v4u o; o.x = pk2(s[0 * 33], s[1 * 33]); o.y = pk2(s[2 * 33], s[3 * 33]); o.z = pk2(s[4 * 33], s[5 * 33]); o.w = pk2(s[6 * 33], s[7 * 33]);
        *(GAS v4u*)(WT + (size_t)(n0 + n) * K + k0 + 8 * c) = o; }
    LDS_WAIT(); asm volatile("" ::: "memory");
}
template <int MAP>
__device__ __forceinline__ void conv_job(Frame& F, const float* W, int Nsrc, int K, bf16* WT, int Ndst, int Fdim, int nmat) {
    LAS float* scr = (LAS float*)(F.lds + F.wave * 16384);
    const int gw = F.vcu * NWAVES + F.wave, NGW = F.G * NWAVES, nblk = Ndst / 32, per = (K / 64) * nblk, nitems = per * nmat;
    for (int it = gw; it < nitems; it += NGW) { const int mat = it / per, loc = it - mat * per;
        tr_item<MAP>(W + (size_t)mat * K * Nsrc, Nsrc, K, WT + (size_t)mat * Ndst * K, Fdim, scr, loc, nblk, F.lane); }
}
constexpr size_t WS_ROPE = WS_WSB + 512 * 1024;
__device__ __forceinline__ void p0_prologue(Frame& F, const float* const* in) {
    unsigned char* ws = F.ws;
    conv_job<MAP_ID>(F, in[9], RET_NIN, 1024, (bf16*)(ws + W_RETIN), RET_NIN, 0, 2);
    conv_job<MAP_ID>(F, in[10], 1024, 2048, (bf16*)(ws + W_RETO), 1024, 0, 2);
    conv_job<MAP_PAD>(F, in[15], 576, 1024, (bf16*)(ws + W_MLAD), 768, 0, 1);
    conv_job<MAP_ID>(F, in[18], 1536, 256, (bf16*)(ws + W_UQ), 1536, 0, 1);
    conv_job<MAP_ID>(F, in[19], 2048, 256, (bf16*)(ws + W_UKV), 2048, 0, 1);
    conv_job<MAP_ID>(F, in[20], 1024, 1024, (bf16*)(ws + W_MLAO), 1024, 0, 1);
    conv_job<MAP_ID>(F, in[21], 6144, 1024, (bf16*)(ws + W_SGUIN), 6144, 0, 1);
    conv_job<MAP_ID>(F, in[25], 1024, 3072, (bf16*)(ws + W_SGUOUT), 1024, 0, 1);
    conv_job<MAP_GU>(F, in[26], 2 * DFF, 1024, (bf16*)(ws + W_FFNGU), 2 * DFF, DFF, 2);
    conv_job<MAP_ID>(F, in[27], 1024, DFF, (bf16*)(ws + W_FFND), 1024, 0, 2);
    conv_job<MAP_GU>(F, in[29], 2 * EFF, 1024, (bf16*)(ws + W_MOEGU), 2 * EFF, EFF, 16);
    conv_job<MAP_ID>(F, in[30], 1024, EFF, (bf16*)(ws + W_MOED), 1024, 0, 16);
    const size_t gt = (size_t)blockIdx.x * 512 + F.tid, NT = (size_t)F.G * 512;
    { const f32x4* s0 = (const f32x4*)in[2]; const f32x4* s1 = (const f32x4*)in[0]; f32x4* d = (f32x4*)(ws + WS_X);
      const size_t n0 = (size_t)NCTX * D / 4, n1 = (size_t)NLAT * D / 4;
      for (size_t i = gt; i < n0 + n1; i += NT) d[i] = (i < n0) ? s0[i] : s1[i - n0]; }
    { const float* s = in[23]; bf16* d = (bf16*)(ws + WS_WSB); for (size_t i = gt; i < 8 * 128 * 128; i += NT) d[i] = (bf16)f2bf(s[i]); }
    { f32x2* rr = (f32x2*)(ws + WS_ROPE); f32x2* rm = rr + 64 * 64;
      for (size_t i = gt; i < 64 * 64 + 64 * 16; i += NT) {
          if (i < 64 * 64) { const int pos = (int)i >> 6, fi = (int)i & 63; const float inv = powf(10000.0f, -(float)(2 * fi) / 128.0f); const float a = (float)pos * inv; rr[i] = (f32x2){cosf(a), sinf(a)}; }
          else { const int k = (int)i - 64 * 64, pos = k >> 4, fi = k & 15; const float inv = powf(10000.0f, -(float)(2 * fi) / 32.0f); const float a = (float)pos * inv; rm[k] = (f32x2){cosf(a), sinf(a)}; } } }
    __syncthreads();
    LAS float* sc = (LAS float*)F.lds;
    LAS float* red = (LAS float*)(F.lds + 20480);
    for (int i = F.tid; i < 5 * 1024; i += 512) { const int cond = i >> 10, k = i & 1023; const float v = cond < 4 ? in[1][cond * 1024 + k] : in[3][k]; sc[i] = v * sigmoidf_(v); }
    __syncthreads();
    float* mod = (float*)(ws + WS_MOD);
    for (int item = blockIdx.x; item < 4 * 96; item += F.G) {
        const int layer = item / 96, n0 = (item % 96) * 64, cg = F.tid & 15, ks = F.tid >> 4;
        float acc[5][4];
#pragma unroll
        for (int a = 0; a < 5; ++a)
#pragma unroll
            for (int q = 0; q < 4; ++q) acc[a][q] = 0.f;
        const float* w = in[4] + (size_t)layer * 1024 * 6144 + n0 + cg * 4;
#pragma unroll 4
        for (int j = 0; j < 32; ++j) { const int k = ks + 32 * j; const f32x4 wv = *(const f32x4*)(w + (size_t)k * 6144);
#pragma unroll
            for (int a = 0; a < 5; ++a) { const float s = sc[a * 1024 + k]; acc[a][0] += s * wv.x; acc[a][1] += s * wv.y; acc[a][2] += s * wv.z; acc[a][3] += s * wv.w; } }
#pragma unroll
        for (int a = 0; a < 5; ++a)
#pragma unroll
            for (int q = 0; q < 4; ++q) red[(ks * 5 + a) * 64 + cg * 4 + q] = acc[a][q];
        __syncthreads();
        if (F.tid < 320) { const int a = F.tid >> 6, col = F.tid & 63; float s = 0.f;
            for (int k2 = 0; k2 < 32; ++k2) s += red[(k2 * 5 + a) * 64 + col];
            mod[((size_t)layer * 5 + a) * 6144 + n0 + col] = s + in[5][layer * 6144 + n0 + col]; }
        __syncthreads();
    }
}

struct RowArgs {
    const float* normg;
    const float* shift;
    const float* scale;
    const float* gate_prev; const float* Y; const int* tok_slot; const float* tok_w;
    const float* w_router; int* tok_e; float* tok_wo; int* tok_rank; gu32* cnt;
    float* out;
    int row_lo, row_hi;
};
template <bool COMBINE, bool ROUTE, bool FINAL>
__device__ __forceinline__ void rows_phase(Frame& F, const RowArgs& a) {
    const int gw = F.vcu * NWAVES + F.wave, NGW = F.G * NWAVES, lane = F.lane;
    float* X = (float*)(F.ws + WS_X); bf16* H = (bf16*)(F.ws + WS_H);
    volatile LAS int* lcnt = (volatile LAS int*)(F.lds + LDSCTL_OFF);
    if (ROUTE) { if (F.tid < 16) lcnt[F.tid] = 0; __syncthreads(); }
    f32x4 ng[4];
#pragma unroll
    for (int j = 0; j < 4; ++j) ng[j] = *(const f32x4*)(a.normg + 4 * lane + 256 * j);
    for (int row = a.row_lo + gw; row < a.row_hi; row += NGW) {
        const int cond = row_cond(row);
        f32x4 v[4]; float* xr = X + (size_t)row * D + 4 * lane;
#pragma unroll
        for (int j = 0; j < 4; ++j) v[j] = *(const f32x4*)(xr + 256 * j);
        if (COMBINE) {
            const int s1 = a.tok_slot[row * 2], s2 = a.tok_slot[row * 2 + 1]; const float w1 = a.tok_w[row * 2], w2 = a.tok_w[row * 2 + 1];
            const float* y1 = a.Y + (size_t)s1 * D + 4 * lane; const float* y2 = a.Y + (size_t)s2 * D + 4 * lane; const float* gp = a.gate_prev + cond * 6144 + 4 * lane;
#pragma unroll
            for (int j = 0; j < 4; ++j) { const f32x4 p = *(const f32x4*)(y1 + 256 * j), q = *(const f32x4*)(y2 + 256 * j), g = *(const f32x4*)(gp + 256 * j);
                v[j] = v[j] + g * (p * w1 + q * w2); if (!FINAL) *(f32x4*)(xr + 256 * j) = v[j]; }
        }
        float ss = 0.f;
#pragma unroll
        for (int j = 0; j < 4; ++j) ss += (v[j].x * v[j].x + v[j].y * v[j].y) + (v[j].z * v[j].z + v[j].w * v[j].w);
        const float rstd = 1.0f / sqrtf(wave_sum(ss) * (1.0f / D) + EPS);
        if (FINAL) {
            float* o = a.out + (size_t)(row - NCTX) * D + 4 * lane;
#pragma unroll
            for (int j = 0; j < 4; ++j) *(f32x4*)(o + 256 * j) = v[j] * rstd * ng[j];
        } else {
            const float* sh = a.shift + cond * 6144 + 4 * lane; const float* scp = a.scale + cond * 6144 + 4 * lane;
            f32x4 h[4];
#pragma unroll
            for (int j = 0; j < 4; ++j) { const f32x4 s = *(const f32x4*)(sh + 256 * j), c1 = *(const f32x4*)(scp + 256 * j); h[j] = (v[j] * rstd * ng[j]) * (c1 + 1.0f) + s; }
            bf16* hr = H + (size_t)row * D + 4 * lane;
#pragma unroll
            for (int j = 0; j < 4; ++j) { v2u w; w.x = pk2(h[j].x, h[j].y); w.y = pk2(h[j].z, h[j].w); *(v2u*)(hr + 256 * j) = w; }
            if (ROUTE) {
                float lg[8];
#pragma unroll
                for (int e = 0; e < 8; ++e) lg[e] = 0.f;
#pragma unroll
                for (int j = 0; j < 4; ++j)
#pragma unroll
                    for (int q = 0; q < 4; ++q) { const float hv = h[j][q]; const float* wr = a.w_router + (size_t)(4 * lane + 256 * j + q) * 8; const f32x4 w0 = *(const f32x4*)wr, w1 = *(const f32x4*)(wr + 4);
                        lg[0] += hv * w0.x; lg[1] += hv * w0.y; lg[2] += hv * w0.z; lg[3] += hv * w0.w; lg[4] += hv * w1.x; lg[5] += hv * w1.y; lg[6] += hv * w1.z; lg[7] += hv * w1.w; }
#pragma unroll
                for (int e = 0; e < 8; ++e) lg[e] = wave_sum(lg[e]);
                int i1 = 0; float v1 = lg[0];
#pragma unroll
                for (int e = 1; e < 8; ++e) if (lg[e] > v1) { v1 = lg[e]; i1 = e; }
                int i2 = -1; float v2 = -3.0e38f;
#pragma unroll
                for (int e = 0; e < 8; ++e) if (e != i1 && lg[e] > v2) { v2 = lg[e]; i2 = e; }
                const float e2 = __expf(v2 - v1), w1 = 1.0f / (1.0f + e2), w2 = e2 * w1;
                if (lane == 0) { const int r1 = __hip_atomic_fetch_add((LAS int*)&lcnt[i1], 1, __ATOMIC_RELAXED, __HIP_MEMORY_SCOPE_WORKGROUP), r2 = __hip_atomic_fetch_add((LAS int*)&lcnt[i2], 1, __ATOMIC_RELAXED, __HIP_MEMORY_SCOPE_WORKGROUP);
                    a.tok_e[row * 2] = i1; a.tok_e[row * 2 + 1] = i2; a.tok_wo[row * 2] = w1; a.tok_wo[row * 2 + 1] = w2; a.tok_rank[row * 2] = r1; a.tok_rank[row * 2 + 1] = r2; }
            }
        }
    }
    if (ROUTE) {
        __syncthreads();
        if (F.tid < 8) lcnt[8 + F.tid] = (int)__hip_atomic_fetch_add(a.cnt + 64 * F.tid, (unsigned)lcnt[F.tid], RLX_AGENT);
        __syncthreads();
        for (int row = a.row_lo + gw; row < a.row_hi; row += NGW) if (lane < 2) { const int e = __hip_atomic_load(a.tok_e + row * 2 + lane, RLX_AGENT); const int rk = __hip_atomic_load(a.tok_rank + row * 2 + lane, RLX_AGENT); a.tok_rank[row * 2 + lane] = rk + lcnt[8 + e]; }
    }
}
__device__ __forceinline__ void moe_offsets(gu32* cnt, int (&ts)[9], int (&cn)[8]) {
    int t = 0;
#pragma unroll
    for (int e = 0; e < 8; ++e) { cn[e] = (int)__hip_atomic_load(cnt + 64 * e, RLX_AGENT); ts[e] = t; t += (cn[e] + 255) >> 8; }
    ts[8] = t;
}
__device__ __forceinline__ void moe_lists(Frame& F, gu32* cnt, int row_lo, int row_hi) {
    int ts[9], cn[8]; moe_offsets(cnt, ts, cn);
    const int* tok_e = (const int*)(F.ws + WS_TOK); const int* tok_rank = tok_e + 4 * NR; int* tok_slot = (int*)tok_e + 6 * NR; int* rowidx = (int*)(F.ws + WS_ROWIDX);
    const int gt = blockIdx.x * 512 + F.tid, NT = F.G * 512;
    for (int i = row_lo * 2 + gt; i < row_hi * 2; i += NT) { const int e = tok_e[i]; int t0 = 0;
#pragma unroll
        for (int j = 0; j < 8; ++j) t0 = (e == j) ? ts[j] : t0;
        const int slot = t0 * 256 + tok_rank[i]; tok_slot[i] = slot; rowidx[slot] = i >> 1; }
    for (int i = gt; i < 8 * 256; i += NT) { const int e = i >> 8, k = i & 255; int t0 = 0, c0 = 0, t1 = 0;
#pragma unroll
        for (int j = 0; j < 8; ++j) { t0 = (e == j) ? ts[j] : t0; c0 = (e == j) ? cn[j] : c0; t1 = (e == j) ? ts[j + 1] : t1; }
        const int s = t0 * 256 + c0 + k; if (s < t1 * 256) rowidx[s] = row_lo; }
}

__device__ __forceinline__ void ret_prep(Frame& F, int j_ret, const float* decay_f, const float* decay_b) {
    const int tid = F.tid, lane = F.lane, w = F.wave;
    bf16* BIG = (bf16*)(F.ws + WS_BIG);
    const f32x2* rope = (const f32x2*)(F.ws + WS_ROPE);
    LAS bf16* ks = (LAS bf16*)F.lds;
    LAS bf16* vs = (LAS bf16*)(F.lds + 67584);
    for (int u = blockIdx.x; u < 544; u += F.G) {
        const int cg = u >> 2, h = u & 3, row0 = cg * 128;
        const float gf = sigmoidf_(decay_f[j_ret * 4 + h]), gb = sigmoidf_(decay_b[j_ret * 4 + h]);
        const float lf = log2f(gf), lb = log2f(gb);
        const bool isctx = row0 < NCTX;
        for (int it = tid; it < 1024; it += 512) { const int j = it >> 3, i0 = (it & 7) * 8, row = row0 + j;
            const bf16* kp = BIG + (size_t)row * RET_NIN + 1024 + h * 256;
            const v4u a1 = *(const v4u*)(kp + i0), a2 = *(const v4u*)(kp + 64 + i0), b1 = *(const v4u*)(kp + 128 + i0), b2 = *(const v4u*)(kp + 192 + i0);
            const int p = (row - NCTX) & 4095, pr = p >> 6, pc = p & 63;
            unsigned o1[4], o2[4], o3[4], o4[4];
#pragma unroll
            for (int t = 0; t < 4; ++t) {
                float x1[2] = {bflo(a1[t]), bfhi(a1[t])}, x2[2] = {bflo(a2[t]), bfhi(a2[t])}, y1[2] = {bflo(b1[t]), bfhi(b1[t])}, y2[2] = {bflo(b2[t]), bfhi(b2[t])};
                float r1[2], r2[2], r3[2], r4[2];
#pragma unroll
                for (int q = 0; q < 2; ++q) { const int fi = i0 + 2 * t + q; f32x2 cr = (f32x2){1.f, 0.f}, cc = (f32x2){1.f, 0.f};
                    if (!isctx) { cr = rope[pr * 64 + fi]; cc = rope[pc * 64 + fi]; }
                    r1[q] = (x1[q] * cr.x - x2[q] * cr.y) * 0.0625f; r2[q] = (x2[q] * cr.x + x1[q] * cr.y) * 0.0625f;
                    r3[q] = (y1[q] * cc.x - y2[q] * cc.y) * 0.0625f; r4[q] = (y2[q] * cc.x + y1[q] * cc.y) * 0.0625f; }
                o1[t] = pk2(r1[0], r1[1]); o2[t] = pk2(r2[0], r2[1]); o3[t] = pk2(r3[0], r3[1]); o4[t] = pk2(r4[0], r4[1]); }
            LAS bf16* kd = ks + j * 264 + i0;
            *(LAS v4u*)(kd) = (v4u){o1[0], o1[1], o1[2], o1[3]}; *(LAS v4u*)(kd + 64) = (v4u){o2[0], o2[1], o2[2], o2[3]};
            *(LAS v4u*)(kd + 128) = (v4u){o3[0], o3[1], o3[2], o3[3]}; *(LAS v4u*)(kd + 192) = (v4u){o4[0], o4[1], o4[2], o4[3]}; }
        bf16x8 qf[8];
        { const int row = row0 + 16 * w + (lane & 15); bf16* qp = BIG + (size_t)row * RET_NIN + h * 256 + 8 * (lane >> 4);
          v4u raw[8];
#pragma unroll
          for (int s = 0; s < 8; ++s) raw[s] = *(const v4u*)(qp + 32 * s);
          const int p = (row - NCTX) & 4095, pr = p >> 6, pc = p & 63;
#pragma unroll
          for (int half = 0; half < 2; ++half)
#pragma unroll
              for (int s = 0; s < 2; ++s) { const int sa = 4 * half + s, sb = sa + 2; const int pos = half ? pc : pr; v4u oa, ob;
#pragma unroll
                  for (int t = 0; t < 4; ++t) { float xa[2] = {bflo(raw[sa][t]), bfhi(raw[sa][t])}, xb[2] = {bflo(raw[sb][t]), bfhi(raw[sb][t])}; float ra[2], rb[2];
#pragma unroll
                      for (int q = 0; q < 2; ++q) { const int fi = 32 * s + 8 * (lane >> 4) + 2 * t + q; f32x2 cs = (f32x2){1.f, 0.f}; if (!isctx) cs = rope[pos * 64 + fi];
                          ra[q] = xa[q] * cs.x - xb[q] * cs.y; rb[q] = xb[q] * cs.x + xa[q] * cs.y; }
                      oa[t] = pk2(ra[0], ra[1]); ob[t] = pk2(rb[0], rb[1]); }
                  raw[sa] = oa; raw[sb] = ob; }
#pragma unroll
          for (int s = 0; s < 8; ++s) { *(v4u*)(qp + 32 * s) = raw[s]; qf[s] = __builtin_bit_cast(bf16x8, raw[s]); } }
        __syncthreads();
        { f32x4 acc[8];
#pragma unroll
          for (int n = 0; n < 8; ++n) acc[n] = (f32x4){0.f, 0.f, 0.f, 0.f};
#pragma unroll
          for (int s = 0; s < 8; ++s)
#pragma unroll
              for (int n = 0; n < 8; ++n) { const bf16x8 kf = *(const LAS bf16x8*)(ks + (16 * n + (lane & 15)) * 264 + 32 * s + 8 * (lane >> 4));
                  acc[n] = __builtin_amdgcn_mfma_f32_16x16x32_bf16(kf, qf[s], acc[n], 0, 0, 0); }
          const int i = 16 * w + (lane & 15);
          bf16* pf = (bf16*)(F.ws + PREP_PF) + (size_t)u * 16384 + i * 128; bf16* pb = (bf16*)(F.ws + PREP_PB) + (size_t)u * 16384 + i * 128;
#pragma unroll
          for (int n = 0; n < 8; ++n) { const int j0 = 16 * n + 4 * (lane >> 4); float vf[4], vb[4];
#pragma unroll
              for (int r = 0; r < 4; ++r) { const int j = j0 + r, dd = i - j; vf[r] = dd >= 0 ? acc[n][r] * exp2f(lf * (float)dd) : 0.f; vb[r] = dd <= 0 ? acc[n][r] * exp2f(lb * (float)(-dd)) : 0.f; }
              *(v2u*)(pf + j0) = (v2u){pk2(vf[0], vf[1]), pk2(vf[2], vf[3])}; *(v2u*)(pb + j0) = (v2u){pk2(vb[0], vb[1]), pk2(vb[2], vb[3])}; } }
        { bf16* ktf = (bf16*)(F.ws + PREP_KTF) + (size_t)u * 32768; bf16* ktb = (bf16*)(F.ws + PREP_KTB) + (size_t)u * 32768;
          for (int it = tid; it < 4096; it += 512) { const int jg = it & 3, dl = (it >> 2) & 15, blk = it >> 6; const int d = (blk >> 2) * 16 + dl, j0 = ((blk & 3) * 4 + jg) * 8;
              float kv[8];
#pragma unroll
              for (int t = 0; t < 8; ++t) kv[t] = bf2f(ks[(j0 + t) * 264 + d]);
              v4u of, ob;
#pragma unroll
              for (int t = 0; t < 4; ++t) { const int ja = j0 + 2 * t, jb = ja + 1;
                  of[t] = pk2(kv[2 * t] * exp2f(lf * (float)(127 - ja)), kv[2 * t + 1] * exp2f(lf * (float)(127 - jb)));
                  ob[t] = pk2(kv[2 * t] * exp2f(lb * (float)ja), kv[2 * t + 1] * exp2f(lb * (float)jb)); }
              *(v4u*)(ktf + d * 128 + j0) = of; *(v4u*)(ktb + d * 128 + j0) = ob; } }
        { bf16* vt = (bf16*)(F.ws + PREP_VT) + (size_t)u * 65536;
          for (int qd = 0; qd < 4; ++qd) {
              __syncthreads();
              for (int it = tid; it < 2048; it += 512) { const int j = it >> 4, pc = it & 15;
                  const v4u x = *(const v4u*)(BIG + (size_t)(row0 + j) * RET_NIN + 2048 + h * 512 + qd * 128 + pc * 8); *(LAS v4u*)(vs + j * 136 + pc * 8) = x; }
              __syncthreads();
              for (int it = tid; it < 2048; it += 512) { const int jg = it & 3, el = (it >> 2) & 15, blk = it >> 6; const int e = (blk >> 2) * 16 + el, j0 = ((blk & 3) * 4 + jg) * 8;
                  unsigned short xv[8];
#pragma unroll
                  for (int t = 0; t < 8; ++t) xv[t] = vs[(j0 + t) * 136 + e];
                  v4u o; o.x = xv[0] | ((unsigned)xv[1] << 16); o.y = xv[2] | ((unsigned)xv[3] << 16); o.z = xv[4] | ((unsigned)xv[5] << 16); o.w = xv[6] | ((unsigned)xv[7] << 16);
                  *(v4u*)(vt + (size_t)(qd * 128 + e) * 128 + j0) = o; } } }
        __syncthreads();
    }
}
__device__ __forceinline__ void ret_scan(Frame& F, int j_ret, const float* decay_f, const float* decay_b, bool with_ctx) {
    const int lane = F.lane, w = F.wave, l15 = lane & 15, lq = lane >> 4;
    const bf16* BIG = (const bf16*)(F.ws + WS_BIG);
    LAS bf16* ST = (LAS bf16*)F.lds;
    for (int u = blockIdx.x; u < 256; u += F.G) {
        const int es = u & 7, dir = (u >> 3) & 1, h = (u >> 4) & 3, b = u >> 6;
        const float gam = sigmoidf_((dir ? decay_b : decay_f)[j_ret * 4 + h]), lg = log2f(gam), g128 = exp2f(lg * 128.f);
        const bf16* PD = (const bf16*)(F.ws + (dir ? PREP_PB : PREP_PF)); const bf16* KT = (const bf16*)(F.ws + (dir ? PREP_KTB : PREP_KTF)); const bf16* VTg = (const bf16*)(F.ws + PREP_VT);
        bf16* OUT = (bf16*)(F.ws + WS_OFB) + (dir ? (size_t)NR * 2048 : 0);
        f32x4 st[2][4];
#pragma unroll
        for (int dt = 0; dt < 2; ++dt)
#pragma unroll
            for (int et = 0; et < 4; ++et) st[dt][et] = (f32x4){0.f, 0.f, 0.f, 0.f};
        __syncthreads();
        for (int i = F.tid; i < 64 * 264 / 2; i += 512) ((LAS unsigned*)ST)[i] = 0u;
        __syncthreads();
        const int il = 16 * w + l15;
        const float qs = dir ? exp2f(lg * (float)(128 - il)) : exp2f(lg * (float)(il + 1));
        for (int s = 0; s < 34; ++s) {
            const int lc = dir ? (s == 0 ? 1 : (s == 1 ? 0 : 35 - s)) : s;
            const int cg = lc < 2 ? b * 2 + lc : 8 + b * 32 + (lc - 2);
            const int row0 = cg * 128, pu = cg * 4 + h;
            const bf16* vtp = VTg + (size_t)pu * 65536 + (size_t)(64 * es + l15) * 128 + 8 * lq;
            bf16x8 vf[4][4];
#pragma unroll
            for (int et = 0; et < 4; ++et)
#pragma unroll
                for (int s4 = 0; s4 < 4; ++s4) vf[et][s4] = *(const bf16x8*)(vtp + et * 16 * 128 + 32 * s4);
            if (with_ctx || lc >= 2) {
                f32x4 a1[4], a2[4];
#pragma unroll
                for (int et = 0; et < 4; ++et) { a1[et] = (f32x4){0.f, 0.f, 0.f, 0.f}; a2[et] = (f32x4){0.f, 0.f, 0.f, 0.f}; }
                const bf16* pp = PD + (size_t)pu * 16384 + il * 128 + 8 * lq;
#pragma unroll
                for (int s4 = 0; s4 < 4; ++s4) { const bf16x8 pf = *(const bf16x8*)(pp + 32 * s4);
#pragma unroll
                    for (int et = 0; et < 4; ++et) a1[et] = __builtin_amdgcn_mfma_f32_16x16x32_bf16(vf[et][s4], pf, a1[et], 0, 0, 0); }
                const bf16* qp = BIG + (size_t)(row0 + il) * RET_NIN + h * 256 + 8 * lq;
#pragma unroll
                for (int s8 = 0; s8 < 8; ++s8) { const bf16x8 qf = *(const bf16x8*)(qp + 32 * s8);
#pragma unroll
                    for (int et = 0; et < 4; ++et) { const bf16x8 sf = *(const LAS bf16x8*)(ST + (16 * et + l15) * 264 + 32 * s8 + 8 * lq);
                        a2[et] = __builtin_amdgcn_mfma_f32_16x16x32_bf16(sf, qf, a2[et], 0, 0, 0); } }
                bf16* op = OUT + (size_t)(row0 + il) * 2048 + h * 512 + 64 * es + 4 * lq;
#pragma unroll
                for (int et = 0; et < 4; ++et) { const f32x4 o = a1[et] + a2[et] * qs; *(v2u*)(op + 16 * et) = (v2u){pk2(o[0], o[1]), pk2(o[2], o[3])}; }
            }
            __syncthreads();
            const bf16* kp = KT + (size_t)pu * 32768 + (size_t)(32 * w + l15) * 128 + 8 * lq;
#pragma unroll
            for (int dt = 0; dt < 2; ++dt) {
#pragma unroll
                for (int et = 0; et < 4; ++et) st[dt][et] = st[dt][et] * g128;
#pragma unroll
                for (int s4 = 0; s4 < 4; ++s4) { const bf16x8 kf = *(const bf16x8*)(kp + dt * 16 * 128 + 32 * s4);
#pragma unroll
                    for (int et = 0; et < 4; ++et) st[dt][et] = __builtin_amdgcn_mfma_f32_16x16x32_bf16(kf, vf[et][s4], st[dt][et], 0, 0, 0); }
#pragma unroll
                for (int et = 0; et < 4; ++et) *(LAS v2u*)(ST + (16 * et + l15) * 264 + 32 * w + 16 * dt + 4 * lq) = (v2u){pk2(st[dt][et][0], st[dt][et][1]), pk2(st[dt][et][2], st[dt][et][3])};
            }
            __syncthreads();
        }
    }
}
__device__ __forceinline__ void ret_gate(Frame& F, const float* gnf, const float* gnb, int row_lo) {
    const int gw = F.vcu * NWAVES + F.wave, NGW = F.G * NWAVES, lane = F.lane;
    const bf16* BIG = (const bf16*)(F.ws + WS_BIG); const bf16* OFp = (const bf16*)(F.ws + WS_OFB); const bf16* OBp = OFp + (size_t)NR * 2048; bf16* MIX = (bf16*)(F.ws + WS_MIX);
    for (int row = row_lo + gw; row < NR; row += NGW) {
#pragma unroll
        for (int h = 0; h < 4; ++h) {
            const int col = h * 512 + 8 * lane;
            float y[2][8];
#pragma unroll
            for (int dir = 0; dir < 2; ++dir) {
                const v4u raw = *(const v4u*)((dir ? OBp : OFp) + (size_t)row * 2048 + col); float x[8];
#pragma unroll
                for (int t = 0; t < 4; ++t) { x[2 * t] = bflo(raw[t]); x[2 * t + 1] = bfhi(raw[t]); }
                float s = 0.f;
#pragma unroll
                for (int t = 0; t < 8; ++t) s += x[t];
                const float mu = wave_sum(s) * (1.0f / 512.0f); float q = 0.f;
#pragma unroll
                for (int t = 0; t < 8; ++t) { x[t] -= mu; q += x[t] * x[t]; }
                const float rstd = 1.0f / sqrtf(wave_sum(q) * (1.0f / 512.0f) + EPS);
                const float* gn = (dir ? gnb : gnf) + col; const f32x4 g0 = *(const f32x4*)gn, g1 = *(const f32x4*)(gn + 4);
#pragma unroll
                for (int t = 0; t < 8; ++t) y[dir][t] = x[t] * rstd * (t < 4 ? g0[t] : g1[t - 4]);
            }
            const v4u gfr = *(const v4u*)(BIG + (size_t)row * RET_NIN + 4096 + col), gbr = *(const v4u*)(BIG + (size_t)row * RET_NIN + 6144 + col);
            v4u o;
#pragma unroll
            for (int t = 0; t < 4; ++t) { const float f0 = bflo(gfr[t]), f1 = bfhi(gfr[t]), b0 = bflo(gbr[t]), b1 = bfhi(gbr[t]);
                const float m0 = f0 * sigmoidf_(f0) * y[0][2 * t] + b0 * sigmoidf_(b0) * y[1][2 * t], m1 = f1 * sigmoidf_(f1) * y[0][2 * t + 1] + b1 * sigmoidf_(b1) * y[1][2 * t + 1];
                o[t] = pk2(m0, m1); }
            *(v4u*)(MIX + (size_t)row * 2048 + col) = o;
        }
    }
}

__device__ __forceinline__ void mla_rows(Frame& F, const float* g_q, const float* g_kv) {
    const int gw = F.vcu * NWAVES + F.wave, NGW = F.G * NWAVES, lane = F.lane;
    const float* CKV = (const float*)(F.ws + MLA_CKV); bf16* CQN = (bf16*)(F.ws + MLA_CQN); bf16* CKVN = (bf16*)(F.ws + MLA_CKVN); bf16* KR = (bf16*)(F.ws + MLA_KV) + 2048;
    const f32x2* rm = (const f32x2*)(F.ws + WS_ROPE) + 64 * 64;
    const f32x4 gq = *(const f32x4*)(g_q + 4 * lane), gk = *(const f32x4*)(g_kv + 4 * lane);
    for (int row = gw; row < NR; row += NGW) {
        const float* r = CKV + (size_t)row * 768;
        const f32x4 a = *(const f32x4*)(r + 4 * lane), c = *(const f32x4*)(r + 256 + 4 * lane);
        const float sa = wave_sum((a.x * a.x + a.y * a.y) + (a.z * a.z + a.w * a.w)), sc = wave_sum((c.x * c.x + c.y * c.y) + (c.z * c.z + c.w * c.w));
        const float ra = 1.0f / sqrtf(sa * (1.0f / 256.0f) + EPS), rc = 1.0f / sqrtf(sc * (1.0f / 256.0f) + EPS);
        *(v2u*)(CQN + (size_t)row * 256 + 4 * lane) = (v2u){pk2(a.x * ra * gq.x, a.y * ra * gq.y), pk2(a.z * ra * gq.z, a.w * ra * gq.w)};
        *(v2u*)(CKVN + (size_t)row * 256 + 4 * lane) = (v2u){pk2(c.x * rc * gk.x, c.y * rc * gk.y), pk2(c.z * rc * gk.z, c.w * rc * gk.w)};
        if (lane < 32) { const int part = lane >> 4, i = lane & 15; const float x1 = r[512 + part * 32 + i], x2 = r[512 + part * 32 + 16 + i];
            f32x2 cs = (f32x2){1.f, 0.f};
            if (row >= NCTX) { const int p = (row - NCTX) & 4095; const int pos = part ? (p & 63) : (p >> 6); cs = rm[pos * 16 + i]; }
            KR[(size_t)row * KVR_LD + part * 32 + i] = (bf16)f2bf(x1 * cs.x - x2 * cs.y); KR[(size_t)row * KVR_LD + part * 32 + 16 + i] = (bf16)f2bf(x2 * cs.x + x1 * cs.y); }
    }
}

__device__ __forceinline__ void sgu_rstd(Frame& F) {
    const int gw = F.vcu * NWAVES + F.wave, NGW = F.G * NWAVES, lane = F.lane;
    const bf16* UV = (const bf16*)(F.ws + SGU_UV); float* rs = (float*)(F.ws + WS_RSTD);
    for (int row = gw; row < NR; row += NGW) { const bf16* v = UV + (size_t)row * 6144 + 3072; float s = 0.f;
#pragma unroll
        for (int j = 0; j < 6; ++j) { const v4u x = *(const v4u*)(v + 8 * lane + 512 * j);
#pragma unroll
            for (int t = 0; t < 4; ++t) { const float a = bflo(x[t]), b = bfhi(x[t]); s += a * a + b * b; } }
        s = wave_sum(s); if (lane == 0) rs[row] = 1.0f / sqrtf(s * (1.0f / 3072.0f) + EPS); }
}
__device__ __forceinline__ void sgu_spatial(Frame& F, const float* g_v, const float* b_s) {
    const int tid = F.tid, lane = F.lane, w = F.wave, l15 = lane & 15, lq = lane >> 4;
    const bf16* UV = (const bf16*)(F.ws + SGU_UV); bf16* UZ = (bf16*)(F.ws + SGU_UZ); const float* rs = (const float*)(F.ws + WS_RSTD); const bf16* WSB = (const bf16*)(F.ws + WS_WSB);
    LAS bf16* VT = (LAS bf16*)F.lds;
    LAS bf16* WL = (LAS bf16*)(F.lds + 52224);
    for (int u = F.vcu; u < 136 * 16; u += F.G) {
        const int cg = u >> 4, g = (u >> 1) & 7, half = u & 1, row0 = cg * 128, c0 = g * 384 + half * 192;
        __syncthreads();
        for (int it = tid; it < 2048; it += 512) { const int p = it >> 4, pc = it & 15; *(LAS v4u*)(WL + p * 136 + pc * 8) = *(const v4u*)(WSB + (size_t)g * 16384 + p * 128 + pc * 8); }
        for (int it = tid; it < 3072; it += 512) { const int q = it & 127, c8 = it >> 7; const float r = rs[row0 + q];
            const v4u x = *(const v4u*)(UV + (size_t)(row0 + q) * 6144 + 3072 + c0 + c8 * 8); const f32x4 g0 = *(const f32x4*)(g_v + c0 + c8 * 8), g1 = *(const f32x4*)(g_v + c0 + c8 * 8 + 4);
#pragma unroll
            for (int t = 0; t < 4; ++t) { const float a = bflo(x[t]) * r * (t < 2 ? g0[2 * t] : g1[2 * t - 4]), b = bfhi(x[t]) * r * (t < 2 ? g0[2 * t + 1] : g1[2 * t - 3]);
                VT[(c8 * 8 + 2 * t) * 136 + q] = (bf16)f2bf(a); VT[(c8 * 8 + 2 * t + 1) * 136 + q] = (bf16)f2bf(b); } }
        __syncthreads();
        f32x4 acc[12];
#pragma unroll
        for (int ct = 0; ct < 12; ++ct) acc[ct] = (f32x4){0.f, 0.f, 0.f, 0.f};
#pragma unroll
        for (int s4 = 0; s4 < 4; ++s4) { const bf16x8 wf = *(const LAS bf16x8*)(WL + (16 * w + l15) * 136 + 32 * s4 + 8 * lq);
#pragma unroll
            for (int ct = 0; ct < 12; ++ct) { const bf16x8 vf = *(const LAS bf16x8*)(VT + (16 * ct + l15) * 136 + 32 * s4 + 8 * lq);
                acc[ct] = __builtin_amdgcn_mfma_f32_16x16x32_bf16(vf, wf, acc[ct], 0, 0, 0); } }
        const int p = 16 * w + l15; const float bs = b_s[g * 128 + p];
        const bf16* up = UV + (size_t)(row0 + p) * 6144 + c0 + 4 * lq; bf16* zp = UZ + (size_t)(row0 + p) * 3072 + c0 + 4 * lq;
#pragma unroll
        for (int ct = 0; ct < 12; ++ct) { const v2u ur = *(const v2u*)(up + 16 * ct);
            const float z0 = (acc[ct][0] + bs) * bflo(ur.x), z1 = (acc[ct][1] + bs) * bfhi(ur.x), z2 = (acc[ct][2] + bs) * bflo(ur.y), z3 = (acc[ct][3] + bs) * bfhi(ur.y);
            *(v2u*)(zp + 16 * ct) = (v2u){pk2(z0, z1), pk2(z2, z3)}; }
    }
}

namespace att {
constexpr int NW = 8, QBLK = 32, KVBLK = 64;
constexpr float SCALE = 0.07216878364870322f;
constexpr float THR = 8.f;
constexpr int SHM_V = KVBLK * 128 * 2, SHM_K = KVBLK * 192 * 2;
constexpr int SHM_ATTN = 2 * SHM_V + 2 * SHM_K + NW * 64 * 4 + NW * 4096;
using s16x4  = __attribute__((ext_vector_type(4))) short;
using f32x16 = __attribute__((ext_vector_type(16))) float;
#define KSWZ(row, colB) ((row) * 384 + ((colB) ^ (((row) & 7) << 4)))
#define SBAR() __builtin_amdgcn_sched_barrier(0)
__device__ __forceinline__ int crow(int r, int hi) { return (r & 3) + 8 * (r >> 2) + 4 * hi; }
__device__ __forceinline__ unsigned cvtpk(float lo, float hi) { unsigned r; asm volatile("v_cvt_pk_bf16_f32 %0, %1, %2" : "=v"(r) : "v"(lo), "v"(hi)); return r; }

__device__ __forceinline__ void partialSM(f32x16& p0, f32x16& p1, float& m_reg, float& mn, float& alpha) {
  constexpr float C = SCALE * 1.4426950408889634f;
  float pmax = p0[0]; for (int r = 1; r < 16; ++r) pmax = fmaxf(pmax, p0[r]); for (int r = 0; r < 16; ++r) pmax = fmaxf(pmax, p1[r]);
  { auto rr = __builtin_amdgcn_permlane32_swap(__float_as_uint(pmax), __float_as_uint(pmax), false, false);
    pmax = fmaxf(__uint_as_float(rr[0]), __uint_as_float(rr[1])); }
  if (__builtin_expect(__all(pmax - m_reg <= THR / SCALE), 1)) { mn = m_reg; alpha = 1.f; }
  else { mn = fmaxf(m_reg, pmax); alpha = __builtin_amdgcn_exp2f((m_reg - mn) * C); m_reg = mn; }
  float mnC = -mn * C;
  for (int r = 0; r < 16; ++r) p0[r] = fmaf(p0[r], C, mnC); for (int r = 0; r < 16; ++r) p1[r] = fmaf(p1[r], C, mnC);
  for (int r = 0; r < 16; ++r) p0[r] = __builtin_amdgcn_exp2f(p0[r]);
}
__device__ __forceinline__ void finishSM(f32x16& p0, f32x16& p1, float alpha, float& l_reg, bf16x8& pa0, bf16x8& pa1, bf16x8& pa2, bf16x8& pa3) {
  for (int r = 0; r < 16; ++r) p1[r] = __builtin_amdgcn_exp2f(p1[r]);
  float ps = 0; for (int r = 0; r < 16; ++r) ps += p0[r]; for (int r = 0; r < 16; ++r) ps += p1[r];
  { auto rr = __builtin_amdgcn_permlane32_swap(__float_as_uint(ps), __float_as_uint(ps), false, false);
    ps = __uint_as_float(rr[0]) + __uint_as_float(rr[1]); }
  l_reg = l_reg * alpha + ps;
#define PK4(P, BASE, OUT) do { unsigned a0 = cvtpk(P[BASE + 0], P[BASE + 1]), a1 = cvtpk(P[BASE + 2], P[BASE + 3]);   \
    unsigned b0 = cvtpk(P[BASE + 4], P[BASE + 5]), b1 = cvtpk(P[BASE + 6], P[BASE + 7]);                              \
    auto r0 = __builtin_amdgcn_permlane32_swap(a0, b0, false, false); auto r1 = __builtin_amdgcn_permlane32_swap(a1, b1, false, false); \
    v4u w = {r0[0], r1[0], r0[1], r1[1]}; OUT = __builtin_bit_cast(bf16x8, w); } while (0)
  PK4(p0, 0, pa0); PK4(p0, 8, pa1); PK4(p1, 0, pa2); PK4(p1, 8, pa3);
#undef PK4
}
template <int BUF> __device__ __forceinline__ void qkt(f32x16& p0, f32x16& p1, const LAS char* const (&ka)[4], const bf16x8* qr, const LAS char* qrope) {
  p0 = f32x16{}; p1 = f32x16{};
#pragma unroll
  for (int d0 = 0; d0 < 12; ++d0) { const LAS char* a = ka[d0 & 3] + (d0 >> 2) * 128 + BUF * SHM_K;
    const bf16x8 b0 = *reinterpret_cast<const LAS bf16x8*>(a);
    const bf16x8 b1 = *reinterpret_cast<const LAS bf16x8*>(a + 32 * 384);
    const bf16x8 qv = d0 < 8 ? qr[d0] : *reinterpret_cast<const LAS bf16x8*>(qrope + (d0 - 8) * 1024);
    p0 = __builtin_amdgcn_mfma_f32_32x32x16_bf16(b0, qv, p0, 0, 0, 0);
    p1 = __builtin_amdgcn_mfma_f32_32x32x16_bf16(b1, qv, p1, 0, 0, 0); }
}
__device__ __forceinline__ int v_st(int k, int c) { const int kk = (k & ~0xC) | ((k & 4) << 1) | ((k & 8) >> 1); return ((kk >> 3) * 4 + (c >> 5)) * 512 + ((kk & 7) * 32 + (c & 31)) * 2; }
__device__ __forceinline__ int v_rd_base(int lane) { return ((lane & 3) << 3) | (((lane >> 2) & 3) << 6) | (((lane >> 4) & 1) << 5) | (((lane >> 5) & 1) << 8); }
constexpr int v_rd_off(int d0, int ks, int half) { return d0 * 512 + ks * 4096 + half * 2048; }
template <int OFF> __device__ __forceinline__ s16x4 tr_read(int vb) {
  s16x4 r; asm volatile("ds_read_b64_tr_b16 %0, %1 offset:%2" : "=&v"(r) : "v"(vb), "i"(OFF) : "memory"); return r;
}
template <int D0> __device__ __forceinline__ void pv_one(f32x16& od, int vb, bf16x8 pa0, bf16x8 pa1, bf16x8 pa2, bf16x8 pa3) {
  const s16x4 l0 = tr_read<v_rd_off(D0, 0, 0)>(vb), h0 = tr_read<v_rd_off(D0, 0, 1)>(vb), l1 = tr_read<v_rd_off(D0, 1, 0)>(vb), h1 = tr_read<v_rd_off(D0, 1, 1)>(vb);
  const s16x4 l2 = tr_read<v_rd_off(D0, 2, 0)>(vb), h2 = tr_read<v_rd_off(D0, 2, 1)>(vb), l3 = tr_read<v_rd_off(D0, 3, 0)>(vb), h3 = tr_read<v_rd_off(D0, 3, 1)>(vb);
  asm volatile("s_waitcnt lgkmcnt(0)" ::: "memory"); SBAR();
#define PK(L, H) (bf16x8){L[0], L[1], L[2], L[3], H[0], H[1], H[2], H[3]}
  od = __builtin_amdgcn_mfma_f32_32x32x16_bf16(pa0, PK(l0, h0), od, 0, 0, 0);
  od = __builtin_amdgcn_mfma_f32_32x32x16_bf16(pa1, PK(l1, h1), od, 0, 0, 0);
  od = __builtin_amdgcn_mfma_f32_32x32x16_bf16(pa2, PK(l2, h2), od, 0, 0, 0);
  od = __builtin_amdgcn_mfma_f32_32x32x16_bf16(pa3, PK(l3, h3), od, 0, 0, 0);
#undef PK
}
__device__ __forceinline__ void pv_d0(f32x16* o, int vb, bf16x8 pa0, bf16x8 pa1, bf16x8 pa2, bf16x8 pa3) {
  pv_one<0>(o[0], vb, pa0, pa1, pa2, pa3); pv_one<1>(o[1], vb, pa0, pa1, pa2, pa3); pv_one<2>(o[2], vb, pa0, pa1, pa2, pa3); pv_one<3>(o[3], vb, pa0, pa1, pa2, pa3);
}
__device__ __forceinline__ void attn_unit(const bf16* __restrict__ Q, const bf16* __restrict__ KVR, bf16* __restrict__ O, const f32x2* __restrict__ ropem,
                                          int qrow0, int h, int kc0, int kl0, int nk, LAS unsigned char* ldsL) {
  char* lds = (char*)ldsL;
  int tid_ = threadIdx.x; asm volatile("" : "+v"(tid_));
  const int tid = tid_, wid = __builtin_amdgcn_readfirstlane(tid >> 6), lane = tid & 63, r32 = lane & 31, hi = lane >> 5;
  char* V_lds = lds;
  float* wsf = (float*)(lds + 2 * SHM_V + 2 * SHM_K) + wid * 64; float* li_l = wsf; float* al_l = wsf + 32;
  LAS char* qrope = (LAS char*)ldsL + 2 * SHM_V + 2 * SHM_K + NW * 64 * 4 + wid * 4096 + lane * 16;
  const LAS char* ka[4];
#pragma unroll
  for (int dr = 0; dr < 4; ++dr) ka[dr] = (const LAS char*)ldsL + 2 * SHM_V + r32 * 384 + (((dr * 2 + hi) ^ (r32 & 7)) << 4);
  float m_reg = -1e30f, l_reg = 0; f32x16 o[4] = {}; bf16x8 qr[8];
  { const bf16* Qs = Q; asm volatile("" : "+s"(Qs));
    const int qrow = qrow0 + wid * QBLK + r32; const bf16* Qw = Qs + (size_t)qrow * 1536 + h * 192 + hi * 8;
#pragma unroll
    for (int d0 = 0; d0 < 8; ++d0) qr[d0] = *reinterpret_cast<const bf16x8*>(Qw + d0 * 16);
    bf16x8 qx[4];
#pragma unroll
    for (int d0 = 0; d0 < 4; ++d0) qx[d0] = *reinterpret_cast<const bf16x8*>(Qw + (8 + d0) * 16);
    if (qrow >= NCTX) {
      const int p = (qrow - NCTX) & 4095;
#pragma unroll
      for (int part = 0; part < 2; ++part) { const int pos = part ? (p & 63) : (p >> 6); const v4u xa = __builtin_bit_cast(v4u, qx[2 * part]), xb = __builtin_bit_cast(v4u, qx[1 + 2 * part]); v4u oa, ob;
#pragma unroll
        for (int t = 0; t < 4; ++t) { const f32x2 c0 = ropem[pos * 16 + hi * 8 + 2 * t], c1 = ropem[pos * 16 + hi * 8 + 2 * t + 1];
          const float a0 = bflo(xa[t]), a1 = bfhi(xa[t]), b0 = bflo(xb[t]), b1 = bfhi(xb[t]);
          oa[t] = pk2(a0 * c0.x - b0 * c0.y, a1 * c1.x - b1 * c1.y); ob[t] = pk2(b0 * c0.x + a0 * c0.y, b1 * c1.x + a1 * c1.y); }
        qx[2 * part] = __builtin_bit_cast(bf16x8, oa); qx[1 + 2 * part] = __builtin_bit_cast(bf16x8, ob); } }
#pragma unroll
    for (int d0 = 0; d0 < 4; ++d0) *reinterpret_cast<LAS bf16x8*>(qrope + d0 * 1024) = qx[d0]; }
  const int vb0 = (int)(uintptr_t)V_lds + v_rd_base(lane);
#define KROW(k) ((k) < 256 ? kc0 + (k) : kl0 + (k) - 256)
#define KDMA(k0, b) do { const char* _kb = (const char*)(KVR + (size_t)KROW(k0) * 2112); int _ln = lane; asm volatile("" : "+v"(_ln)); _Pragma("unroll") for (int _i = 0; _i < 3; ++_i) { \
    const int _ob = (wid * 3 + _i) * 1024 + _ln * 16, _row = _ob / 384, _cb = (_ob - _row * 384) ^ ((_row & 7) << 4), _pc = _cb >> 4; \
    const unsigned _off = 2u * (unsigned)(_row * 2112 + (_pc < 16 ? h * 256 + _pc * 8 : 2048 + (_pc - 16) * 8)); \
    __builtin_amdgcn_global_load_lds((const unsigned*)(_kb + _off), (LAS unsigned*)(ldsL + 2 * SHM_V + (b) * SHM_K + (wid * 3 + _i) * 1024), 16, 0, 0); } } while (0)
#define VDMA(k0, b) do { const char* _kb = (const char*)(KVR + (size_t)KROW(k0) * 2112); int _ln = lane; asm volatile("" : "+v"(_ln)); _Pragma("unroll") for (int _i = 0; _i < 2; ++_i) { \
    const int _ob = (wid * 2 + _i) * 1024 + _ln * 16, _sub = _ob >> 9, _within = (_ob & 511) >> 1, _kk = (_sub >> 2) * 8 + (_within >> 5); \
    const int _k = (_kk & ~0xC) | ((_kk & 4) << 1) | ((_kk & 8) >> 1), _c = (_sub & 3) * 32 + (_within & 31); \
    const unsigned _off = 2u * (unsigned)(_k * 2112 + h * 256 + 128 + _c); \
    __builtin_amdgcn_global_load_lds((const unsigned*)(_kb + _off), (LAS unsigned*)(ldsL + (b) * SHM_V + (wid * 2 + _i) * 1024), 16, 0, 0); } } while (0)
#define VMSYNC() do { asm volatile("s_waitcnt vmcnt(0)" ::: "memory"); __syncthreads(); } while (0)
#define RESC(a) do { if (__any((a) < 1.f)) { if (hi == 0) al_l[r32] = (a); asm volatile("s_waitcnt lgkmcnt(0)" ::: "memory"); \
    for (int d = 0; d < 4; ++d) for (int r = 0; r < 16; ++r) o[d][r] *= al_l[crow(r, hi)]; } } while (0)
  f32x16 pA0, pA1, pB0, pB1; float mnA, mnB, alA, alB; bf16x8 pa0, pa1, pa2, pa3; const int NT = nk / KVBLK;
  KDMA(0, 0); VDMA(0, 0); KDMA(KVBLK, 1); VDMA(KVBLK, 1); VMSYNC();
  qkt<0>(pA0, pA1, ka, qr, qrope); partialSM(pA0, pA1, m_reg, mnA, alA);
  for (int j = 1; j + 1 < NT; j += 2) {
    SBAR(); qkt<1>(pB0, pB1, ka, qr, qrope);
    finishSM(pA0, pA1, alA, l_reg, pa0, pa1, pa2, pa3); SBAR();
    KDMA((j + 1) * KVBLK, 0); SBAR();
    pv_d0(o, vb0, pa0, pa1, pa2, pa3); partialSM(pB0, pB1, m_reg, mnB, alB);
    VMSYNC();
    VDMA((j + 1) * KVBLK, 0);
    RESC(alB);
    SBAR(); qkt<0>(pA0, pA1, ka, qr, qrope);
    finishSM(pB0, pB1, alB, l_reg, pa0, pa1, pa2, pa3); SBAR();
    KDMA((j + 2) * KVBLK, 1); SBAR();
    pv_d0(o, vb0 + SHM_V, pa0, pa1, pa2, pa3); partialSM(pA0, pA1, m_reg, mnA, alA);
    VMSYNC();
    VDMA((j + 2) * KVBLK, 1);
    RESC(alA);
  }
  SBAR(); qkt<1>(pB0, pB1, ka, qr, qrope);
  finishSM(pA0, pA1, alA, l_reg, pa0, pa1, pa2, pa3); SBAR();
  pv_d0(o, vb0, pa0, pa1, pa2, pa3); partialSM(pB0, pB1, m_reg, mnB, alB);
  VMSYNC(); RESC(alB);
  finishSM(pB0, pB1, alB, l_reg, pa0, pa1, pa2, pa3); SBAR();
  pv_d0(o, vb0 + SHM_V, pa0, pa1, pa2, pa3);
  if (hi == 0) li_l[r32] = l_reg; asm volatile("s_waitcnt lgkmcnt(0)" ::: "memory");
  float rli[16];
#pragma unroll
  for (int r = 0; r < 16; ++r) rli[r] = __builtin_amdgcn_rcpf(li_l[crow(r, hi)]);
  bf16* Ow = O + (size_t)(qrow0 + wid * QBLK) * 1024 + h * 128;
#pragma unroll
  for (int r = 0; r < 16; ++r) { const int orow = crow(r, hi);
#pragma unroll
    for (int d0 = 0; d0 < 4; ++d0) Ow[(size_t)orow * 1024 + d0 * 32 + r32] = (bf16)f2bf(o[d0][r] * rli[r]); }
  __syncthreads();
#undef KROW
#undef KDMA
#undef VDMA
#undef VMSYNC
#undef RESC
}
#undef KSWZ
}

enum Phase { P_PRO, P0_MOD, P0_WIN, P0_PREP, P0_SCAN, P0_GATE, P0_WO, P0_MOD2, P0_GU, P0_DOWN, P1_MOD, P1_WD, P1_ROWS, P1_UQ, P1_UKV, P1_ATT, P1_WO, P1_MOD2, P1_LIST, P1_MGU, P1_MDN, P2_MOD, P2_WIN, P2_RSTD, P2_SPA, P2_WOUT, P2_MOD2, P2_GU, P2_DOWN, P3_MOD, P3_WIN, P3_PREP, P3_SCAN, P3_GATE, P3_WO, P3_MOD2, P3_LIST, P3_MGU, P3_MDN, P3_FIN, NPH };
struct Args { const float* in[31]; float* out; unsigned char* ws; int ph_lo, ph_hi, li, pad; };

template <class Epi>
__device__ __forceinline__ void run_gemm(Frame& F, const bf16* A, int lda, const bf16* Bt, int K, int nM, int nN, const Epi& E) {
    pg8::Gemm g{A, Bt, K, lda}; pg8::StaticOrder S; S.init(nM, nN, F.G, (int)blockIdx.x, K, lda);
    pg8::gemm_phase<Epi, pg8::StaticOrder, false, true>(F.lds, g, S, E);
}
__device__ __forceinline__ void moe_gemms_gu(Frame& F, gu32* cnt, const bf16* Wgu) {
    int ts[9], cn[8]; moe_offsets(cnt, ts, cn);
    pg8::MoeOrder S; S.init(ts[8], 2 * EFF / 256, F.G, (int)blockIdx.x, 1024, 1024);
#pragma unroll
    for (int j = 0; j < 9; ++j) S.ts[j] = ts[j];
    S.estride = (size_t)2 * EFF * 1024 * 2; S.rowidx = (const int*)(F.ws + WS_ROWIDX);
    pg8::Gemm g{(const bf16*)(F.ws + WS_H), Wgu, 1024, 1024};
    pg8::EpiSwiglu E{(bf16*)(F.ws + MOE_HID), EFF};
    pg8::gemm_phase<pg8::EpiSwiglu, pg8::MoeOrder, true, true>(F.lds, g, S, E);
}
__device__ __forceinline__ void moe_gemms_down(Frame& F, gu32* cnt, const bf16* Wd) {
    int ts[9], cn[8]; moe_offsets(cnt, ts, cn);
    pg8::MoeOrder S; S.init(ts[8], 4, F.G, (int)blockIdx.x, EFF, EFF);
#pragma unroll
    for (int j = 0; j < 9; ++j) S.ts[j] = ts[j];
    S.estride = (size_t)1024 * EFF * 2; S.rowidx = nullptr;
    pg8::Gemm g{(const bf16*)(F.ws + MOE_HID), Wd, EFF, EFF};
    pg8::EpiF32 E{(float*)(F.ws + MOE_Y), 1024};
    pg8::gemm_phase<pg8::EpiF32, pg8::MoeOrder, false, true>(F.lds, g, S, E);
}
__device__ __forceinline__ void attn_phase(Frame& F) {
    const bf16* Q = (const bf16*)(F.ws + MLA_Q); const bf16* KV = (const bf16*)(F.ws + MLA_KV); bf16* O = (bf16*)(F.ws + MLA_O);
    const f32x2* ropem = (const f32x2*)(F.ws + WS_ROPE) + 64 * 64;
    for (int i = 0;; ++i) { const int L = i * F.G + F.vcu; if (L >= 544) break;
        int qrow0, hh, b, nk;
        if (L < 512) { const int qb = L & 15; hh = (L >> 4) & 7; b = L >> 7; qrow0 = NCTX + b * SEQ + qb * 256; nk = TT; }
        else { const int Lc = L - 512; hh = Lc & 7; b = Lc >> 3; qrow0 = b * CTXL; nk = CTXL; }
        att::attn_unit(Q, KV, O, ropem, qrow0, hh, b * CTXL, NCTX + b * SEQ, nk, F.lds); }
}

__global__ void __launch_bounds__(NWAVES * 64, 2) mega_fwd(Args args) {
    extern __shared__ __attribute__((aligned(16))) unsigned char lds[];
    Frame F;
    F.lds = (LAS unsigned char*)lds; F.ws = args.ws;
    F.tid = threadIdx.x; F.lane = F.tid & 63; F.wave = __builtin_amdgcn_readfirstlane(F.tid >> 6);
    F.G = gridDim.x; { const int bx = blockIdx.x; F.vcu = (F.G % 8 == 0) ? (bx % 8) * (F.G / 8) + bx / 8 : bx; }
    F.ctl = (gu32*)(args.ws + WS_CTL);
    for (int u = F.tid; u < (LDS_BYTES - LDSCTL_OFF) / 4; u += NWAVES * 64) ((LAS unsigned*)(F.lds + LDSCTL_OFF))[u] = 0u;
    __syncthreads();
    const int lo = args.ph_lo, hi = args.ph_hi;
    XcdBarrier bar; bar.bar = (unsigned*)(F.ctl + CW_BAR) + args.li * XCD_BAR_WORDS; bar.x = 0; bar.st = (volatile LAS unsigned*)(F.lds + MISC_OFF + 32);
    if (hi - lo > 1) bar = xcd_barrier_post((unsigned*)(F.ctl + CW_BAR) + args.li * XCD_BAR_WORDS, (volatile LAS unsigned*)(F.lds + MISC_OFF + 32));
    const float* const* in = args.in; unsigned char* ws = args.ws;
    float* mod = (float*)(ws + WS_MOD); float* X = (float*)(ws + WS_X); bf16* H = (bf16*)(ws + WS_H); bf16* BIG = (bf16*)(ws + WS_BIG); bf16* MIX = (bf16*)(ws + WS_MIX);
    int* tok_e = (int*)(ws + WS_TOK); float* tok_w = (float*)(tok_e + 2 * NR); int* tok_rank = tok_e + 4 * NR; int* tok_slot = tok_e + 6 * NR;
#ifndef PH_MASK
#define PH_MASK 0xFFFFFFFFFFFFFFFFull
#endif
#define IN(k) ((((PH_MASK) >> (k)) & 1ull) && lo <= (k) && (k) < hi)
#define SEAM(k) do { if ((k) + 1 < hi) xcd_barrier(bar); } while (0)
#define MODP(layer, k) (mod + (size_t)(layer) * 5 * 6144 + (k) * 1024)
#define WB(off) ((const bf16*)(ws + (off)))

    if (IN(P_PRO)) { p0_prologue(F, in); SEAM(P_PRO); }
    if (IN(P0_MOD)) { RowArgs a{}; a.normg = in[6]; a.shift = MODP(0, 0); a.scale = MODP(0, 1); a.row_lo = 0; a.row_hi = NR; rows_phase<false, false, false>(F, a); SEAM(P0_MOD); }
    if (IN(P0_WIN)) { run_gemm(F, H, 1024, WB(W_RETIN), 1024, 68, 32, pg8::EpiBf16<0>{BIG, RET_NIN}); SEAM(P0_WIN); }
    if (IN(P0_PREP)) { ret_prep(F, 0, in[11], in[12]); SEAM(P0_PREP); }
    if (IN(P0_SCAN)) { ret_scan(F, 0, in[11], in[12], true); SEAM(P0_SCAN); }
    if (IN(P0_GATE)) { ret_gate(F, in[13], in[14], 0); SEAM(P0_GATE); }
    if (IN(P0_WO)) { run_gemm(F, MIX, 2048, WB(W_RETO), 2048, 68, 4, pg8::EpiRes{X, MODP(0, 2), 0}); SEAM(P0_WO); }
    if (IN(P0_MOD2)) { RowArgs a{}; a.normg = in[7]; a.shift = MODP(0, 3); a.scale = MODP(0, 4); a.row_lo = 0; a.row_hi = NR; rows_phase<false, false, false>(F, a); SEAM(P0_MOD2); }
    if (IN(P0_GU)) { run_gemm(F, H, 1024, WB(W_FFNGU), 1024, 68, 22, pg8::EpiSwiglu{(bf16*)(ws + FFN_HID), DFF}); SEAM(P0_GU); }
    if (IN(P0_DOWN)) { run_gemm(F, WB(FFN_HID), DFF, WB(W_FFND), DFF, 68, 4, pg8::EpiRes{X, MODP(0, 5), 0}); SEAM(P0_DOWN); }
    if (IN(P1_MOD)) { RowArgs a{}; a.normg = in[6] + 1024; a.shift = MODP(1, 0); a.scale = MODP(1, 1); a.row_lo = 0; a.row_hi = NR; rows_phase<false, false, false>(F, a); SEAM(P1_MOD); }
    if (IN(P1_WD)) { run_gemm(F, H, 1024, WB(W_MLAD), 1024, 68, 3, pg8::EpiF32{(float*)(ws + MLA_CKV), 768}); SEAM(P1_WD); }
    if (IN(P1_ROWS)) { mla_rows(F, in[16], in[17]); SEAM(P1_ROWS); }
    if (IN(P1_UQ)) { run_gemm(F, WB(MLA_CQN), 256, WB(W_UQ), 256, 68, 6, pg8::EpiBf16<0>{(bf16*)(ws + MLA_Q), 1536}); SEAM(P1_UQ); }
    if (IN(P1_UKV)) { run_gemm(F, WB(MLA_CKVN), 256, WB(W_UKV), 256, 68, 8, pg8::EpiBf16<0>{(bf16*)(ws + MLA_KV), KVR_LD}); SEAM(P1_UKV); }
    if (IN(P1_ATT)) { attn_phase(F); SEAM(P1_ATT); }
    if (IN(P1_WO)) { run_gemm(F, WB(MLA_O), 1024, WB(W_MLAO), 1024, 68, 4, pg8::EpiRes{X, MODP(1, 2), 0}); SEAM(P1_WO); }
    if (IN(P1_MOD2)) { RowArgs a{}; a.normg = in[7] + 1024; a.shift = MODP(1, 3); a.scale = MODP(1, 4); a.row_lo = 0; a.row_hi = NR;
                  a.w_router = in[28]; a.tok_e = tok_e; a.tok_wo = tok_w; a.tok_rank = tok_rank; a.cnt = F.ctl + CW_MOECNT; rows_phase<false, true, false>(F, a); SEAM(P1_MOD2); }
    if (IN(P1_LIST)) { moe_lists(F, F.ctl + CW_MOECNT, 0, NR); SEAM(P1_LIST); }
    if (IN(P1_MGU)) { moe_gemms_gu(F, F.ctl + CW_MOECNT, WB(W_MOEGU)); SEAM(P1_MGU); }
    if (IN(P1_MDN)) { moe_gemms_down(F, F.ctl + CW_MOECNT, WB(W_MOED)); SEAM(P1_MDN); }
    if (IN(P2_MOD)) { RowArgs a{}; a.normg = in[6] + 2048; a.shift = MODP(2, 0); a.scale = MODP(2, 1); a.row_lo = 0; a.row_hi = NR;
                  a.gate_prev = MODP(1, 5); a.Y = (const float*)(ws + MOE_Y); a.tok_slot = tok_slot; a.tok_w = tok_w; rows_phase<true, false, false>(F, a); SEAM(P2_MOD); }
    if (IN(P2_WIN)) { run_gemm(F, H, 1024, WB(W_SGUIN), 1024, 68, 24, pg8::EpiBf16<3>{(bf16*)(ws + SGU_UV), 6144}); SEAM(P2_WIN); }
    if (IN(P2_RSTD)) { sgu_rstd(F); SEAM(P2_RSTD); }
    if (IN(P2_SPA)) { sgu_spatial(F, in[22], in[24]); SEAM(P2_SPA); }
    if (IN(P2_WOUT)) { run_gemm(F, WB(SGU_UZ), 3072, WB(W_SGUOUT), 3072, 68, 4, pg8::EpiRes{X, MODP(2, 2), 0}); SEAM(P2_WOUT); }
    if (IN(P2_MOD2)) { RowArgs a{}; a.normg = in[7] + 2048; a.shift = MODP(2, 3); a.scale = MODP(2, 4); a.row_lo = 0; a.row_hi = NR; rows_phase<false, false, false>(F, a); SEAM(P2_MOD2); }
    if (IN(P2_GU)) { run_gemm(F, H, 1024, WB(W_FFNGU + (size_t)2 * DFF * 1024 * 2), 1024, 68, 22, pg8::EpiSwiglu{(bf16*)(ws + FFN_HID), DFF}); SEAM(P2_GU); }
    if (IN(P2_DOWN)) { run_gemm(F, WB(FFN_HID), DFF, WB(W_FFND + (size_t)1024 * DFF * 2), DFF, 68, 4, pg8::EpiRes{X, MODP(2, 5), 0}); SEAM(P2_DOWN); }
    if (IN(P3_MOD)) { RowArgs a{}; a.normg = in[6] + 3072; a.shift = MODP(3, 0); a.scale = MODP(3, 1); a.row_lo = 0; a.row_hi = NR; rows_phase<false, false, false>(F, a); SEAM(P3_MOD); }
    if (IN(P3_WIN)) { run_gemm(F, H, 1024, WB(W_RETIN + (size_t)RET_NIN * 1024 * 2), 1024, 68, 32, pg8::EpiBf16<0>{BIG, RET_NIN}); SEAM(P3_WIN); }
    if (IN(P3_PREP)) { ret_prep(F, 1, in[11], in[12]); SEAM(P3_PREP); }
    if (IN(P3_SCAN)) { ret_scan(F, 1, in[11], in[12], false); SEAM(P3_SCAN); }
    if (IN(P3_GATE)) { ret_gate(F, in[13] + 2048, in[14] + 2048, NCTX); SEAM(P3_GATE); }
    if (IN(P3_WO)) { run_gemm(F, MIX + (size_t)NCTX * 2048, 2048, WB(W_RETO + (size_t)1024 * 2048 * 2), 2048, 64, 4, pg8::EpiRes{X + (size_t)NCTX * 1024, MODP(3, 2), 4}); SEAM(P3_WO); }
    if (IN(P3_MOD2)) { RowArgs a{}; a.normg = in[7] + 3072; a.shift = MODP(3, 3); a.scale = MODP(3, 4); a.row_lo = NCTX; a.row_hi = NR;
                  a.w_router = in[28] + 8192; a.tok_e = tok_e; a.tok_wo = tok_w; a.tok_rank = tok_rank; a.cnt = F.ctl + CW_MOECNT + 512; rows_phase<false, true, false>(F, a); SEAM(P3_MOD2); }
    if (IN(P3_LIST)) { moe_lists(F, F.ctl + CW_MOECNT + 512, NCTX, NR); SEAM(P3_LIST); }
    if (IN(P3_MGU)) { moe_gemms_gu(F, F.ctl + CW_MOECNT + 512, WB(W_MOEGU + (size_t)8 * 2 * EFF * 1024 * 2)); SEAM(P3_MGU); }
    if (IN(P3_MDN)) { moe_gemms_down(F, F.ctl + CW_MOECNT + 512, WB(W_MOED + (size_t)8 * 1024 * EFF * 2)); SEAM(P3_MDN); }
    if (IN(P3_FIN)) { RowArgs a{}; a.normg = in[8]; a.row_lo = NCTX; a.row_hi = NR; a.gate_prev = MODP(3, 5); a.Y = (const float*)(ws + MOE_Y); a.tok_slot = tok_slot; a.tok_w = tok_w; a.out = args.out;
                  rows_phase<true, false, true>(F, a); }
#undef IN
#undef SEAM
#undef MODP
#undef WB
}

#ifndef MK_PER_PHASE
#define MK_PER_PHASE 1
#endif
extern "C" void kernel_launch(void* const* d_in, const int* in_sizes, int n_in, void* d_out, int out_size, void* d_ws, size_t ws_size, hipStream_t stream) {
    static int grid = 0;
    if (grid == 0) {
        if (n_in != 31 || out_size != NLAT * D || ws_size < WS_END) { fprintf(stderr, "kernel_launch: unexpected shapes: n_in %d out %d ws %zu (need %zu)\n", n_in, out_size, ws_size, (size_t)WS_END); grid = -1; return; }
        int dev = 0, cus = 0, per_cu = 0;
        if (hipGetDevice(&dev) != hipSuccess || hipDeviceGetAttribute(&cus, hipDeviceAttributeMultiprocessorCount, dev) != hipSuccess) { grid = -1; return; }
        if (hipFuncSetAttribute((const void*)mega_fwd, hipFuncAttributeMaxDynamicSharedMemorySize, LDS_BYTES) != hipSuccess) { fprintf(stderr, "kernel_launch: hipFuncSetAttribute failed\n"); grid = -1; return; }
        if (hipOccupancyMaxActiveBlocksPerMultiprocessor(&per_cu, (const void*)mega_fwd, NWAVES * 64, LDS_BYTES) != hipSuccess || per_cu < 1)
            fprintf(stderr, "kernel_launch: note: occupancy query reports %d workgroups per CU\n", per_cu);
        (void)hipGetLastError();
        grid = cus;
    }
    if (grid < 0) return;
    if (hipMemsetAsync((char*)d_ws + WS_CTL, 0, CTL_ZERO_BYTES, stream) != hipSuccess) return;
    Args a{};
    for (int i = 0; i < 31; ++i) a.in[i] = (const float*)d_in[i];
    a.out = (float*)d_out; a.ws = (unsigned char*)d_ws; a.pad = 0;
#if MK_PER_PHASE
    for (int p = 0; p < NPH; ++p) { a.ph_lo = p; a.ph_hi = p + 1; a.li = 0; hipLaunchKernelGGL(mega_fwd, dim3(grid), dim3(NWAVES * 64), LDS_BYTES, stream, a); }
#else
    a.ph_lo = 0; a.ph_hi = NPH; a.li = 0; hipLaunchKernelGGL(mega_fwd, dim3(grid), dim3(NWAVES * 64), LDS_BYTES, stream, a);
#endif
    const hipError_t le = hipPeekAtLastError();
    if (le != hipSuccess) fprintf(stderr, "kernel_launch: launch failed: %s\n", hipGetErrorName(le));
}
```

```cpp
#include <hip/hip_runtime.h>
#include <cstdio>
#include <cstdint>

namespace pg8 {
#define PG8_LAS __attribute__((address_space(3)))
typedef unsigned short bf16_t;
typedef short bf16x8 __attribute__((ext_vector_type(8)));
typedef float f32x4 __attribute__((ext_vector_type(4)));
typedef float f32x2 __attribute__((ext_vector_type(2)));
typedef unsigned u32x4 __attribute__((ext_vector_type(4)));
typedef unsigned u32x2 __attribute__((ext_vector_type(2)));
constexpr int BM = 256, BK = 64, HALF = 128, HTB = HALF * BK * 2  , STAGE_BYTES = 8 * HTB, NXCD = 8, WGM = 8;

__host__ __device__ __forceinline__ int lds_byte(int r, int c) { const int st = (r >> 4) * 2 + (c >> 5), rr = r & 15, cc = c & 31, ob = rr * 64 + cc * 2; return st * 1024 + (ob ^ (((ob >> 9) & 1) << 5)); }
__host__ __device__ __forceinline__ void stage_rc(int b, int& R, int& C) { const int st = b / 1024, sb = b % 1024, swz = sb ^ (((sb >> 9) & 1) << 5); R = (st >> 1) * 16 + swz / 64; C = (st & 1) * 32 + (swz % 64) / 2; }
__host__ __device__ __forceinline__ int perm32(int rho) { const int n = rho >> 4, i = rho & 15; return 8 * (i >> 2) + 4 * n + (i & 3); }

struct Unit { int pm, pn; };
struct Gemm { const bf16_t* A; const bf16_t* Bt; int K, lda; };

struct StaticOrder {
    int nM, nN, nwg, G, c; size_t tA, tB;
    __device__ void init(int nM_, int nN_, int G_, int c_, int K, int lda) { nM = nM_; nN = nN_; nwg = nM * nN; G = G_; c = c_; tA = (size_t)BM * lda * 2; tB = (size_t)BM * K * 2; }
    __device__ bool next(int i, Unit& u) const {
        const long L = (long)i * G + c; if (L >= nwg) return false;
        int wgid = (int)L; { const int q = nwg / NXCD, r = nwg % NXCD, xcd = wgid % NXCD, off = wgid / NXCD; wgid = (xcd < r ? xcd * (q + 1) : r * (q + 1) + (xcd - r) * q) + off; }
        const int nig = WGM * nN, gid = wgid / nig, fm = gid * WGM, gsz = (nM - fm) < WGM ? (nM - fm) : WGM;
        u.pm = fm + ((wgid % nig) % gsz); u.pn = (wgid % nig) / gsz; return true;
    }
    __device__ __forceinline__ size_t aofs(const Unit& u) const { return (size_t)u.pm * tA; }
    __device__ __forceinline__ size_t bofs(const Unit& u) const { return (size_t)u.pn * tB; }
    __device__ __forceinline__ int arow(const Unit& u, int r) const { return u.pm * BM + r; }
};
struct MoeOrder : StaticOrder {
    int ts[9]; size_t estride; const int* rowidx;
    __device__ __forceinline__ int expert(int pm) const { int e = 0;
#pragma unroll
        for (int j = 1; j < 8; ++j) e += (pm >= ts[j]) ? 1 : 0; return e; }
    __device__ __forceinline__ size_t bofs(const Unit& u) const { return (size_t)expert(u.pm) * estride + (size_t)u.pn * tB; }
    __device__ __forceinline__ int arow(const Unit& u, int r) const { return rowidx[u.pm * BM + r]; }
};

__device__ __forceinline__ unsigned cvt_pk_bf16(float lo, float hi) { unsigned r; asm volatile("v_cvt_pk_bf16_f32 %0, %1, %2" : "=v"(r) : "v"(lo), "v"(hi)); return r; }
__device__ __forceinline__ float fast_sigmoid(float x) { return __builtin_amdgcn_rcpf(1.0f + __builtin_amdgcn_exp2f(-1.4426950408889634f * x)); }
__device__ __forceinline__ float gelu_tanh(float x) { const float u = 0.7978845608028654f * (x + 0.044715f * x * x * x); return x * fast_sigmoid(2.0f * u); }

struct EpiF32 {
    static constexpr bool PERM = false;
    float* C; int ldc;
    __device__ __forceinline__ void operator()(const f32x4 (&acc)[2][2][4][2], const Unit& u, int wr, int wc, int fr, int fq) const {
        const int row0 = u.pm * BM + wr * 64 + fr, col0 = u.pn * BM + wc * 32 + 4 * fq;
#pragma unroll
        for (int ai = 0; ai < 2; ++ai)
#pragma unroll
            for (int m = 0; m < 4; ++m) { float* rowp = C + (size_t)(row0 + ai * HALF + m * 16) * ldc + col0;
#pragma unroll
                for (int bj = 0; bj < 2; ++bj)
#pragma unroll
                    for (int n = 0; n < 2; ++n) *(f32x4*)(rowp + bj * HALF + n * 16) = acc[ai][bj][m][n]; }
    }
};
template <int ACT  > struct EpiBf16 {
    static constexpr bool PERM = true;
    bf16_t* O; int ldc;
    __device__ __forceinline__ void operator()(const f32x4 (&acc)[2][2][4][2], const Unit& u, int wr, int wc, int fr, int fq) const {
        const int row0 = u.pm * BM + wr * 64 + fr, col0 = u.pn * BM + wc * 32 + 8 * fq;
#pragma unroll
        for (int ai = 0; ai < 2; ++ai)
#pragma unroll
            for (int m = 0; m < 4; ++m) { bf16_t* rowp = O + (size_t)(row0 + ai * HALF + m * 16) * ldc + col0;
#pragma unroll
                for (int bj = 0; bj < 2; ++bj) { f32x4 v0 = acc[ai][bj][m][0], v1 = acc[ai][bj][m][1];
                    if (ACT == 3) {
#pragma unroll
                        for (int j = 0; j < 4; ++j) { v0[j] = gelu_tanh(v0[j]); v1[j] = gelu_tanh(v1[j]); } }
                    u32x4 w; w.x = cvt_pk_bf16(v0[0], v0[1]); w.y = cvt_pk_bf16(v0[2], v0[3]); w.z = cvt_pk_bf16(v1[0], v1[1]); w.w = cvt_pk_bf16(v1[2], v1[3]);
                    *(u32x4*)(rowp + bj * HALF) = w; } }
    }
};
struct EpiRes {
    static constexpr bool PERM = false;
    float* X; const float* gate; int tile0;
    __device__ __forceinline__ void operator()(const f32x4 (&acc)[2][2][4][2], const Unit& u, int wr, int wc, int fr, int fq) const {
        const int row0 = u.pm * BM + wr * 64 + fr, col0 = u.pn * BM + wc * 32 + 4 * fq;
        const int tg = u.pm + tile0, cond = tg < 4 ? 4 : ((tg - 4) >> 4);
        const float* gp = gate + cond * 6144 + col0;
        f32x4 gv[2][2];
#pragma unroll
        for (int bj = 0; bj < 2; ++bj)
#pragma unroll
            for (int n = 0; n < 2; ++n) gv[bj][n] = *(const f32x4*)(gp + bj * HALF + n * 16);
#pragma unroll
        for (int ai = 0; ai < 2; ++ai)
#pragma unroll
            for (int m = 0; m < 4; ++m) { float* rowp = X + (size_t)(row0 + ai * HALF + m * 16) * 1024 + col0;
#pragma unroll
                for (int bj = 0; bj < 2; ++bj)
#pragma unroll
                    for (int n = 0; n < 2; ++n) { f32x4* p = (f32x4*)(rowp + bj * HALF + n * 16); const f32x4 x = *p; *p = x + gv[bj][n] * acc[ai][bj][m][n]; } }
    }
};
struct EpiSwiglu {
    static constexpr bool PERM = false;
    bf16_t* O; int ldo;
    __device__ __forceinline__ void operator()(const f32x4 (&acc)[2][2][4][2], const Unit& u, int wr, int wc, int fr, int fq) const {
        const int row0 = u.pm * BM + wr * 64 + fr, col0 = u.pn * HALF + wc * 16 + 4 * fq;
#pragma unroll
        for (int ai = 0; ai < 2; ++ai)
#pragma unroll
            for (int m = 0; m < 4; ++m) { bf16_t* rowp = O + (size_t)(row0 + ai * HALF + m * 16) * ldo + col0;
#pragma unroll
                for (int bj = 0; bj < 2; ++bj) { const f32x4 g = acc[ai][bj][m][0], uu = acc[ai][bj][m][1]; f32x4 h;
#pragma unroll
                    for (int j = 0; j < 4; ++j) h[j] = g[j] * fast_sigmoid(g[j]) * uu[j];
                    u32x2 w; w.x = cvt_pk_bf16(h[0], h[1]); w.y = cvt_pk_bf16(h[2], h[3]);
                    *(u32x2*)(rowp + bj * 64) = w; } }
    }
};

template <class Epi, class Sched, bool GATHER = false, bool ALIGN_EPI = true>
__device__ __forceinline__ void gemm_phase(PG8_LAS unsigned char* lds, const Gemm g, const Sched& S, const Epi& E) {
    const int tid = threadIdx.x, wid = __builtin_amdgcn_readfirstlane(tid >> 6), lane = tid & 63, wr = wid >> 2, wc = wid & 3, fr = lane & 15, fq = lane >> 4;
    const int K = g.K, nt = K / BK, lda = g.lda;
    unsigned voffA[2], voffB[2]; int sR[2], sC[2];
#pragma unroll
    for (int i = 0; i < 2; ++i) { int R, C; stage_rc(tid * 16 + i * 8192, R, C); const int Rb = Epi::PERM ? ((R & ~31) + perm32(R & 31)) : R;
        voffA[i] = (unsigned)(R * lda + C) * 2u; voffB[i] = (unsigned)(Rb * K + C) * 2u; sR[i] = R; sC[i] = C * 2; }
    const size_t kstep = (size_t)(BK * 2);
    const size_t hstepA = (size_t)HALF * lda * 2, hstepB = (size_t)HALF * K * 2;
    const unsigned ldsw = (unsigned)wid * 1024u;
    const int aoff = lds_byte(wr * 64 + fr, fq * 8), boff = lds_byte(wc * 32 + fr, fq * 8);
    unsigned ao[2][2], aon[2][2];
#define PG8_SA(b, h) (((b) * 2 + (h)) * HTB)
#define PG8_SB(b, h) ((4 + (b) * 2 + (h)) * HTB)
#define PG8_STAGE(bufoff, gbase, voff) do { _Pragma("unroll") for (int _i = 0; _i < 2; ++_i) \
        __builtin_amdgcn_global_load_lds((const unsigned*)((const char*)(gbase) + (voff)[_i]), (PG8_LAS unsigned*)(lds + (bufoff) + ldsw + _i * 8192), 16, 0, 0); } while (0)
#define PG8_STAGE_A(bufoff, h, ab, OA) do { if constexpr (GATHER) { PG8_STAGE(bufoff, ab, (OA)[h]); } else { PG8_STAGE(bufoff, (ab) + (h) * hstepA, voffA); } } while (0)
#define PG8_GOFFS(dst, uu) do { _Pragma("unroll") for (int _h = 0; _h < 2; ++_h) _Pragma("unroll") for (int _i = 0; _i < 2; ++_i) \
        (dst)[_h][_i] = (unsigned)S.arow(uu, _h * HALF + sR[_i]) * (unsigned)(lda * 2) + (unsigned)sC[_i]; } while (0)
#define PG8_LDA(dst, b, h) do { _Pragma("unroll") for (int m = 0; m < 4; ++m) _Pragma("unroll") for (int k = 0; k < 2; ++k) dst[m][k] = *(const PG8_LAS bf16x8*)(lds + PG8_SA(b, h) + aoff + m * 2048 + k * 1024); } while (0)
#define PG8_LDB(dst, b, h) do { _Pragma("unroll") for (int n = 0; n < 2; ++n) _Pragma("unroll") for (int k = 0; k < 2; ++k) dst[n][k] = *(const PG8_LAS bf16x8*)(lds + PG8_SB(b, h) + boff + n * 2048 + k * 1024); } while (0)
#define PG8_MMA(ai, bj, At, Bt) do { __builtin_amdgcn_s_setprio(1); _Pragma("unroll") for (int m = 0; m < 4; ++m) _Pragma("unroll") for (int n = 0; n < 2; ++n) _Pragma("unroll") for (int k = 0; k < 2; ++k) \
        acc[ai][bj][m][n] = __builtin_amdgcn_mfma_f32_16x16x32_bf16(Bt[n][k], At[m][k], acc[ai][bj][m][n], 0, 0, 0); __builtin_amdgcn_s_setprio(0); } while (0)
#define PG8_WAIT_V(n) asm volatile("s_waitcnt vmcnt(" #n ")" ::: "memory")
#define PG8_WAIT_L(n) asm volatile("s_waitcnt lgkmcnt(" #n ")" ::: "memory")
#define PG8_BAR __builtin_amdgcn_s_barrier()
#define PG8_SCHED __builtin_amdgcn_sched_barrier(0)
    Unit cur, nxt; int ui = 0;
    if (!S.next(0, cur)) return;
    f32x4 acc[2][2][4][2];
#pragma unroll
    for (int a = 0; a < 2; ++a)
#pragma unroll
        for (int b = 0; b < 2; ++b)
#pragma unroll
            for (int m = 0; m < 4; ++m)
#pragma unroll
                for (int n = 0; n < 2; ++n) acc[a][b][m][n] = (f32x4){0.f, 0.f, 0.f, 0.f};
    bf16x8 At[4][2], B0[2][2], B1[2][2];
    const char* cA = (const char*)g.A + (GATHER ? (size_t)0 : S.aofs(cur)); const char* cB = (const char*)g.Bt + S.bofs(cur);
    if constexpr (GATHER) { PG8_GOFFS(ao, cur);
#pragma unroll
        for (int h = 0; h < 2; ++h)
#pragma unroll
            for (int i = 0; i < 2; ++i) aon[h][i] = ao[h][i]; }
    PG8_STAGE(PG8_SB(0, 0), cB, voffB); PG8_STAGE(PG8_SB(0, 1), cB + hstepB, voffB); PG8_STAGE_A(PG8_SA(0, 0), 0, cA, ao); PG8_STAGE_A(PG8_SA(0, 1), 1, cA, ao);
    if (wr == 1) PG8_BAR;
    PG8_WAIT_V(2); PG8_BAR;
    PG8_STAGE(PG8_SB(1, 0), cB + kstep, voffB); PG8_STAGE_A(PG8_SA(1, 0), 0, cA + kstep, ao); PG8_STAGE(PG8_SB(1, 1), cB + hstepB + kstep, voffB);
    PG8_WAIT_V(6); PG8_BAR;
    for (;;) {
        const bool has_next = S.next(ui + 1, nxt);
        const char* nA = (GATHER || !has_next) ? cA : (const char*)g.A + S.aofs(nxt); const char* nB = has_next ? (const char*)g.Bt + S.bofs(nxt) : cB;
        for (int t = 0; t < nt; t += 2) {
            const bool last = (t == nt - 2);
            const char* a1 = cA + (size_t)(t + 1) * kstep;
            const char* a2 = last ? nA : cA + (size_t)(t + 2) * kstep; const char* b2 = last ? nB : cB + (size_t)(t + 2) * kstep;
            const char* a3 = a2 + kstep; const char* b3 = b2 + kstep;
            unsigned o2[2][2];
            if constexpr (GATHER) {
                if (last && has_next) PG8_GOFFS(aon, nxt);
#pragma unroll
                for (int h = 0; h < 2; ++h)
#pragma unroll
                    for (int i = 0; i < 2; ++i) o2[h][i] = last ? aon[h][i] : ao[h][i];
            }
            PG8_LDB(B0, 0, 0); PG8_LDB(B1, 0, 1); PG8_SCHED; PG8_LDA(At, 0, 0); PG8_STAGE_A(PG8_SA(1, 1), 1, a1, ao);
            PG8_WAIT_V(8); PG8_WAIT_L(0); PG8_BAR; PG8_MMA(0, 0, At, B0); PG8_MMA(0, 1, At, B1); PG8_BAR; PG8_SCHED;
            PG8_LDA(At, 0, 1); PG8_STAGE(PG8_SB(0, 0), b2, voffB); PG8_STAGE(PG8_SB(0, 1), b2 + hstepB, voffB); PG8_STAGE_A(PG8_SA(0, 0), 0, a2, o2);
            PG8_WAIT_V(8); PG8_WAIT_L(0); PG8_BAR; PG8_MMA(1, 0, At, B0); PG8_MMA(1, 1, At, B1); PG8_BAR; PG8_SCHED;
            PG8_LDB(B0, 1, 0); PG8_LDB(B1, 1, 1); PG8_SCHED; PG8_LDA(At, 1, 0); PG8_STAGE_A(PG8_SA(0, 1), 1, a2, o2);
            PG8_WAIT_V(8); PG8_WAIT_L(0); PG8_BAR; PG8_MMA(0, 0, At, B0); PG8_MMA(0, 1, At, B1); PG8_BAR; PG8_SCHED;
            PG8_LDA(At, 1, 1); PG8_STAGE(PG8_SB(1, 0), b3, voffB); PG8_STAGE(PG8_SB(1, 1), b3 + hstepB, voffB); PG8_STAGE_A(PG8_SA(1, 0), 0, a3, o2);
            PG8_WAIT_V(8); PG8_WAIT_L(0); PG8_BAR; PG8_MMA(1, 0, At, B0); PG8_MMA(1, 1, At, B1); PG8_BAR; PG8_SCHED;
        }
        if constexpr (ALIGN_EPI) { if (wr == 0) PG8_BAR; }
        E(acc, cur, wr, wc, fr, fq);
        if (!has_next) break;
#pragma unroll
        for (int a = 0; a < 2; ++a)
#pragma unroll
            for (int b = 0; b < 2; ++b)
#pragma unroll
                for (int m = 0; m < 4; ++m)
#pragma unroll
                    for (int n = 0; n < 2; ++n) acc[a][b][m][n] = (f32x4){0.f, 0.f, 0.f, 0.f};
        cur = nxt; cA = nA; cB = nB; ++ui;
        if constexpr (GATHER) {
#pragma unroll
            for (int h = 0; h < 2; ++h)
#pragma unroll
                for (int i = 0; i < 2; ++i) ao[h][i] = aon[h][i]; }
        if constexpr (ALIGN_EPI) { if (wr == 1) PG8_BAR; }
    }
    PG8_WAIT_V(0);
    if constexpr (!ALIGN_EPI) { if (wr == 0) PG8_BAR; }
    PG8_BAR;
#undef PG8_SA
#undef PG8_SB
#undef PG8_STAGE
#undef PG8_STAGE_A
#undef PG8_GOFFS
#undef PG8_LDA
#undef PG8_LDB
#undef PG8_MMA
#undef PG8_WAIT_V
#undef PG8_WAIT_L
#undef PG8_BAR
#undef PG8_SCHED
}
}

constexpr int D = 1024, NB = 4, SEQ = 4096, CTXL = 256, TT = CTXL + SEQ;
constexpr int NCTX = NB * CTXL;
constexpr int NLAT = NB * SEQ;
constexpr int NR = NCTX + NLAT;
constexpr int DFF = 2816, EFF = 3584, NEXP = 8;
constexpr int RET_NIN = 8192;
constexpr float EPS = 1e-6f;
constexpr int MOE_MAXROWS = 36864;

constexpr size_t MiB = 1u << 20;
constexpr size_t WS_CTL = 0, CTL_ZERO_BYTES = 1 * MiB;
constexpr size_t WS_MOD = 1 * MiB;
constexpr size_t WS_TOK = 2 * MiB;
constexpr size_t WS_ROWIDX = 3 * MiB;
constexpr size_t WS_RSTD = 4 * MiB;
constexpr size_t WS_WSB = 5 * MiB;
constexpr size_t WS_W = 6 * MiB;
constexpr size_t W_RETIN = WS_W;
constexpr size_t W_RETO = W_RETIN + 32 * MiB;
constexpr size_t W_MLAD = W_RETO + 8 * MiB;
constexpr size_t W_UQ = W_MLAD + 2 * MiB;
constexpr size_t W_UKV = W_UQ + 1 * MiB;
constexpr size_t W_MLAO = W_UKV + 1 * MiB;
constexpr size_t W_SGUIN = W_MLAO + 2 * MiB;
constexpr size_t W_SGUOUT = W_SGUIN + 12 * MiB;
constexpr size_t W_FFNGU = W_SGUOUT + 6 * MiB;
constexpr size_t W_FFND = W_FFNGU + 22 * MiB;
constexpr size_t W_MOEGU = W_FFND + 11 * MiB;
constexpr size_t W_MOED = W_MOEGU + 224 * MiB;
constexpr size_t WS_X = W_MOED + 112 * MiB;
constexpr size_t WS_H = WS_X + 68 * MiB;
constexpr size_t WS_BIG = WS_H + 34 * MiB;
constexpr size_t WS_PREP = WS_BIG + 272 * MiB;
constexpr size_t WS_OFB = WS_PREP + 170 * MiB;
constexpr size_t WS_MIX = WS_OFB + 136 * MiB;
constexpr size_t WS_END = WS_MIX + 68 * MiB;
constexpr size_t PREP_KTF = WS_PREP, PREP_KTB = PREP_KTF + 34 * MiB, PREP_VT = PREP_KTB + 34 * MiB, PREP_PF = PREP_VT + 68 * MiB, PREP_PB = PREP_PF + 17 * MiB;
constexpr size_t MLA_CKV = WS_BIG;
constexpr size_t MLA_CQN = MLA_CKV + 52 * MiB;
constexpr size_t MLA_CKVN = MLA_CQN + 9 * MiB;
constexpr size_t MLA_KR = MLA_CKVN + 9 * MiB;
constexpr size_t MLA_Q = MLA_KR + 3 * MiB;
constexpr int KVR_LD = 2112;
constexpr size_t MLA_KV = MLA_Q + 52 * MiB;
constexpr size_t MLA_O = MLA_KV + 71 * MiB;
static_assert(MLA_O + 34 * MiB <= WS_PREP, "MLA map");
constexpr size_t MOE_HID = WS_BIG;
constexpr size_t MOE_Y = WS_PREP;
constexpr size_t SGU_UV = WS_BIG;
constexpr size_t SGU_UZ = WS_PREP;
constexpr size_t FFN_HID = WS_BIG;
constexpr int CW_BAR = 4096;
constexpr int CW_MOECNT = 16384;

constexpr int RING_BYTES = 131072;
constexpr int LDSCTL_OFF = RING_BYTES, MISC_OFF = LDSCTL_OFF + 320;
constexpr int LDS_BYTES = 147456;
constexpr int NWAVES = 8;

#define GAS __attribute__((address_space(1)))
#define LAS __attribute__((address_space(3)))
typedef unsigned short bf16;
typedef unsigned v4u __attribute__((ext_vector_type(4)));
typedef unsigned v2u __attribute__((ext_vector_type(2)));
typedef float f32x4 __attribute__((ext_vector_type(4)));
typedef float f32x2 __attribute__((ext_vector_type(2)));
typedef short bf16x8 __attribute__((ext_vector_type(8)));
typedef GAS unsigned gu32;
#define RLX_AGENT __ATOMIC_RELAXED, __HIP_MEMORY_SCOPE_AGENT
#define LDS_WAIT() asm volatile("s_waitcnt lgkmcnt(0)" ::: "memory")
#define VM_WAIT() asm volatile("s_waitcnt vmcnt(0)" ::: "memory")
__device__ __forceinline__ unsigned f2bf(float f) { unsigned u = __builtin_bit_cast(unsigned, f); return (u + 0x7fffu + ((u >> 16) & 1u)) >> 16; }
__device__ __forceinline__ unsigned pk2(float lo, float hi) { return f2bf(lo) | (f2bf(hi) << 16); }
__device__ __forceinline__ float bf2f(unsigned short v) { return __builtin_bit_cast(float, (unsigned)v << 16); }
__device__ __forceinline__ float bflo(unsigned w) { return __builtin_bit_cast(float, w << 16); }
__device__ __forceinline__ float bfhi(unsigned w) { return __builtin_bit_cast(float, w & 0xffff0000u); }
__device__ __forceinline__ float sigmoidf_(float x) { return 1.0f / (1.0f + __expf(-x)); }

#define XB_TMO      128
#define XB_XCNT(j)  (256  + 64 * (j))
#define XB_XSUB(j)  (1280 + 64 * (j))
#define XB_XGEN(j)  (2304 + 64 * (j))
#define XB_TOP      3328
#define XB_TOPGEN   3392
#define XCD_BAR_WORDS 3456
#define XB_SPIN_CAP (1u << 18)

__device__ __forceinline__ unsigned xb_ld(unsigned* p)              { return __hip_atomic_load(p, __ATOMIC_RELAXED, __HIP_MEMORY_SCOPE_AGENT); }
__device__ __forceinline__ unsigned xb_add(unsigned* p, unsigned v) { return __hip_atomic_fetch_add(p, v, __ATOMIC_RELAXED, __HIP_MEMORY_SCOPE_AGENT); }
__device__ __forceinline__ unsigned xb_xcc_id() { return (unsigned)__builtin_amdgcn_s_getreg((3 << 11) | 20) & 0xFu; }
#define XB_SPIN(cond, bar) do { unsigned _sp = 0; while (cond) { __builtin_amdgcn_s_sleep(1); \
    if ((++_sp & 255u) == 0u) { if (xb_ld(&(bar)[XB_TMO])) break; if (_sp > XB_SPIN_CAP) { atomicAdd(&(bar)[XB_TMO], 1u); break; } } } } while (0)

struct XcdBarrier {
    unsigned* bar; unsigned x;
    volatile LAS unsigned* st;
};
__device__ __forceinline__ XcdBarrier xcd_barrier_post(unsigned* bar, volatile LAS unsigned* st) {
    XcdBarrier b; b.bar = bar; b.x = xb_xcc_id(); b.st = st;
    if (threadIdx.x == 0) (void)xb_add(&bar[XB_XCNT(b.x)], 1u);
    return b;
}
__device__ __forceinline__ void xcd_barrier_complete(unsigned* bar, unsigned x, unsigned& nloc, unsigned& nx) {
    const unsigned G = gridDim.x * gridDim.y * gridDim.z;
    unsigned sum, cnt, mine, sp = 0u;
    for (;;) {
        sum = 0u; cnt = 0u; mine = 0u;
#pragma unroll
        for (unsigned j = 0; j < 16; ++j) { const unsigned c = xb_ld(&bar[XB_XCNT(j)]); sum += c; cnt += (c > 0u) ? 1u : 0u; mine = (j == x) ? c : mine; }
        if (sum == G) break;
        __builtin_amdgcn_s_sleep(1);
        if ((++sp & 255u) == 0u) { if (xb_ld(&bar[XB_TMO])) break; if (sp > XB_SPIN_CAP) { atomicAdd(&bar[XB_TMO], 1u); break; } }
    }
    nloc = mine > 0u ? mine : 1u; nx = cnt > 0u ? cnt : 1u;
}
__device__ __forceinline__ void xcd_barrier(const XcdBarrier& b) {
    asm volatile("s_waitcnt vmcnt(0)" ::: "memory");
    __syncthreads();
    if (threadIdx.x == 0) {
        unsigned* bar = b.bar;
        __builtin_amdgcn_s_waitcnt(0);
        unsigned nloc = b.st[0], nx = b.st[1];
        if (nloc == 0u) { xcd_barrier_complete(bar, b.x, nloc, nx); b.st[0] = nloc; b.st[1] = nx; }
        const unsigned old = xb_add(&bar[XB_XSUB(b.x)], 1u);
        const unsigned gen = old / nloc;
        if (old + 1u == (gen + 1u) * nloc) {
            __builtin_amdgcn_fence(__ATOMIC_RELEASE, "agent");
            asm volatile("s_waitcnt vmcnt(0)" ::: "memory");
            const unsigned og = xb_add(&bar[XB_TOP], 1u);
            const unsigned tg = og / nx;
            if (og + 1u == (tg + 1u) * nx) xb_add(&bar[XB_TOPGEN], 1u);
            else XB_SPIN(xb_ld(&bar[XB_TOPGEN]) == tg, bar);
            __builtin_amdgcn_fence(__ATOMIC_ACQUIRE, "agent");
            xb_add(&bar[XB_XGEN(b.x)], 1u);
            asm volatile("s_waitcnt vmcnt(0)" ::: "memory");
        } else {
            XB_SPIN(xb_ld(&bar[XB_XGEN(b.x)]) == gen, bar);
            __builtin_amdgcn_fence(__ATOMIC_ACQUIRE, "agent");
            asm volatile("s_waitcnt vmcnt(0)" ::: "memory");
        }
    }
    __syncthreads();
}

struct Frame {
    LAS unsigned char* lds;
    gu32* ctl;
    unsigned char* ws;
    int tid, lane, wave;
    int vcu, G;
    const float* const* in;
};
__device__ __forceinline__ float wave_sum(float v) {
#pragma unroll
    for (int o = 1; o < 64; o <<= 1) v += __shfl_xor(v, o);
    return v;
}
__device__ __forceinline__ int row_cond(int row) { return row < NCTX ? 4 : ((row - NCTX) >> 12); }

enum { MAP_ID = 0, MAP_GU = 1, MAP_PAD = 2 };
template <int MAP>
__device__ __forceinline__ void tr_item(const float* W, int Nsrc, int K, bf16* WT, int Fdim, LAS float* scr, int item, int nblk, int lane) {
    const int kb = item / nblk, nb = item % nblk, k0 = 64 * kb, n0 = 32 * nb;
    const int nl = lane & 31; int sc;
    if (MAP == MAP_GU) sc = ((nl < 16) ? 0 : Fdim) + (n0 >> 1) + (nl & 15);
    else sc = n0 + nl;
    const bool valid = (MAP != MAP_PAD) || (sc < Nsrc);
#pragma unroll 8
    for (int i = 0; i < 32; ++i) { const int kk = 2 * i + (lane >> 5); scr[kk * 33 + nl] = valid ? W[(size_t)(k0 + kk) * Nsrc + sc] : 0.f; }
    LDS_WAIT(); asm volatile("" ::: "memory");
    const int c = lane & 7;
#pragma unroll
    for (int j = 0; j < 4; ++j) { const int n = (lane >> 3) + 8 * j; const LAS float* s = scr + (8 * c) * 33 + n;
        v4u o; o.x = pk2(s[0 * 33], s[1 * 33]); o.y = pk2(s[2 * 33], s[3 * 33]); o.z = pk2(s[4 * 33], s[5 * 33]); o.w = pk2(s[6 * 33], s[7 * 33]);
        *(GAS v4u*)(WT + (size_t)(n0 + n) * K + k0 + 8 * c) = o; }
    LDS_WAIT(); asm volatile("" ::: "memory");
}
template <int MAP>
__device__ __forceinline__ void conv_job(Frame& F, const float* W, int Nsrc, int K, bf16* WT, int Ndst, int Fdim, int nmat) {
    LAS float* scr = (LAS float*)(F.lds + F.wave * 16384);
    const int gw = F.vcu * NWAVES + F.wave, NGW = F.G * NWAVES, nblk = Ndst / 32, per = (K / 64) * nblk, nitems = per * nmat;
    for (int it = gw; it < nitems; it += NGW) { const int mat = it / per, loc = it - mat * per;
        tr_item<MAP>(W + (size_t)mat * K * Nsrc, Nsrc, K, WT + (size_t)mat * Ndst * K, Fdim, scr, loc, nblk, F.lane); }
}
constexpr size_t WS_ROPE = WS_WSB + 512 * 1024;
__device__ __forceinline__ void p0_prologue(Frame& F, const float* const* in) {
    unsigned char* ws = F.ws;
    conv_job<MAP_ID>(F, in[9], RET_NIN, 1024, (bf16*)(ws + W_RETIN), RET_NIN, 0, 2);
    conv_job<MAP_ID>(F, in[10], 1024, 2048, (bf16*)(ws + W_RETO), 1024, 0, 2);
    conv_job<MAP_PAD>(F, in[15], 576, 1024, (bf16*)(ws + W_MLAD), 768, 0, 1);
    conv_job<MAP_ID>(F, in[18], 1536, 256, (bf16*)(ws + W_UQ), 1536, 0, 1);
    conv_job<MAP_ID>(F, in[19], 2048, 256, (bf16*)(ws + W_UKV), 2048, 0, 1);
    conv_job<MAP_ID>(F, in[20], 1024, 1024, (bf16*)(ws + W_MLAO), 1024, 0, 1);
    conv_job<MAP_ID>(F, in[21], 6144, 1024, (bf16*)(ws + W_SGUIN), 6144, 0, 1);
    conv_job<MAP_ID>(F, in[25], 1024, 3072, (bf16*)(ws + W_SGUOUT), 1024, 0, 1);
    conv_job<MAP_GU>(F, in[26], 2 * DFF, 1024, (bf16*)(ws + W_FFNGU), 2 * DFF, DFF, 2);
    conv_job<MAP_ID>(F, in[27], 1024, DFF, (bf16*)(ws + W_FFND), 1024, 0, 2);
    conv_job<MAP_GU>(F, in[29], 2 * EFF, 1024, (bf16*)(ws + W_MOEGU), 2 * EFF, EFF, 16);
    conv_job<MAP_ID>(F, in[30], 1024, EFF, (bf16*)(ws + W_MOED), 1024, 0, 16);
    const size_t gt = (size_t)blockIdx.x * 512 + F.tid, NT = (size_t)F.G * 512;
    { const f32x4* s0 = (const f32x4*)in[2]; const f32x4* s1 = (const f32x4*)in[0]; f32x4* d = (f32x4*)(ws + WS_X);
      const size_t n0 = (size_t)NCTX * D / 4, n1 = (size_t)NLAT * D / 4;
      for (size_t i = gt; i < n0 + n1; i += NT) d[i] = (i < n0) ? s0[i] : s1[i - n0]; }
    { const float* s = in[23]; bf16* d = (bf16*)(ws + WS_WSB); for (size_t i = gt; i < 8 * 128 * 128; i += NT) d[i] = (bf16)f2bf(s[i]); }
    { f32x2* rr = (f32x2*)(ws + WS_ROPE); f32x2* rm = rr + 64 * 64;
      for (size_t i = gt; i < 64 * 64 + 64 * 16; i += NT) {
          if (i < 64 * 64) { const int pos = (int)i >> 6, fi = (int)i & 63; const float inv = powf(10000.0f, -(float)(2 * fi) / 128.0f); const float a = (float)pos * inv; rr[i] = (f32x2){cosf(a), sinf(a)}; }
          else { const int k = (int)i - 64 * 64, pos = k >> 4, fi = k & 15; const float inv = powf(10000.0f, -(float)(2 * fi) / 32.0f); const float a = (float)pos * inv; rm[k] = (f32x2){cosf(a), sinf(a)}; } } }
    __syncthreads();
    LAS float* sc = (LAS float*)F.lds;
    LAS float* red = (LAS float*)(F.lds + 20480);
    for (int i = F.tid; i < 5 * 1024; i += 512) { const int cond = i >> 10, k = i & 1023; const float v = cond < 4 ? in[1][cond * 1024 + k] : in[3][k]; sc[i] = v * sigmoidf_(v); }
    __syncthreads();
    float* mod = (float*)(ws + WS_MOD);
    for (int item = blockIdx.x; item < 4 * 96; item += F.G) {
        const int layer = item / 96, n0 = (item % 96) * 64, cg = F.tid & 15, ks = F.tid >> 4;
        float acc[5][4];
#pragma unroll
        for (int a = 0; a < 5; ++a)
#pragma unroll
            for (int q = 0; q < 4; ++q) acc[a][q] = 0.f;
        const float* w = in[4] + (size_t)layer * 1024 * 6144 + n0 + cg * 4;
#pragma unroll 4
        for (int j = 0; j < 32; ++j) { const int k = ks + 32 * j; const f32x4 wv = *(const f32x4*)(w + (size_t)k * 6144);
#pragma unroll
            for (int a = 0; a < 5; ++a) { const float s = sc[a * 1024 + k]; acc[a][0] += s * wv.x; acc[a][1] += s * wv.y; acc[a][2] += s * wv.z; acc[a][3] += s * wv.w; } }
#pragma unroll
        for (int a = 0; a < 5; ++a)
#pragma unroll
            for (int q = 0; q < 4; ++q) red[(ks * 5 + a) * 64 + cg * 4 + q] = acc[a][q];
        __syncthreads();
        if (F.tid < 320) { const int a = F.tid >> 6, col = F.tid & 63; float s = 0.f;
            for (int k2 = 0; k2 < 32; ++k2) s += red[(k2 * 5 + a) * 64 + col];
            mod[((size_t)layer * 5 + a) * 6144 + n0 + col] = s + in[5][layer * 6144 + n0 + col]; }
        __syncthreads();
    }
}

struct RowArgs {
    const float* normg;
    const float* shift;
    const float* scale;
    const float* gate_prev; const float* Y; const int* tok_slot; const float* tok_w;
    const float* w_router; int* tok_e; float* tok_wo; int* tok_rank; gu32* cnt;
    float* out;
    int row_lo, row_hi;
};
template <bool COMBINE, bool ROUTE, bool FINAL>
__device__ __forceinline__ void rows_phase(Frame& F, const RowArgs& a) {
    const int gw = F.vcu * NWAVES + F.wave, NGW = F.G * NWAVES, lane = F.lane;
    float* X = (float*)(F.ws + WS_X); bf16* H = (bf16*)(F.ws + WS_H);
    volatile LAS int* lcnt = (volatile LAS int*)(F.lds + LDSCTL_OFF);
    if (ROUTE) { if (F.tid < 16) lcnt[F.tid] = 0; __syncthreads(); }
    f32x4 ng[4];
#pragma unroll
    for (int j = 0; j < 4; ++j) ng[j] = *(const f32x4*)(a.normg + 4 * lane + 256 * j);
    for (int row = a.row_lo + gw; row < a.row_hi; row += NGW) {
        const int cond = row_cond(row);
        f32x4 v[4]; float* xr = X + (size_t)row * D + 4 * lane;
#pragma unroll
        for (int j = 0; j < 4; ++j) v[j] = *(const f32x4*)(xr + 256 * j);
        if (COMBINE) {
            const int s1 = a.tok_slot[row * 2], s2 = a.tok_slot[row * 2 + 1]; const float w1 = a.tok_w[row * 2], w2 = a.tok_w[row * 2 + 1];
            const float* y1 = a.Y + (size_t)s1 * D + 4 * lane; const float* y2 = a.Y + (size_t)s2 * D + 4 * lane; const float* gp = a.gate_prev + cond * 6144 + 4 * lane;
#pragma unroll
            for (int j = 0; j < 4; ++j) { const f32x4 p = *(const f32x4*)(y1 + 256 * j), q = *(const f32x4*)(y2 + 256 * j), g = *(const f32x4*)(gp + 256 * j);
                v[j] = v[j] + g * (p * w1 + q * w2); if (!FINAL) *(f32x4*)(xr + 256 * j) = v[j]; }
        }
        float ss = 0.f;
#pragma unroll
        for (int j = 0; j < 4; ++j) ss += (v[j].x * v[j].x + v[j].y * v[j].y) + (v[j].z * v[j].z + v[j].w * v[j].w);
        const float rstd = 1.0f / sqrtf(wave_sum(ss) * (1.0f / D) + EPS);
        if (FINAL) {
            float* o = a.out + (size_t)(row - NCTX) * D + 4 * lane;
#pragma unroll
            for (int j = 0; j < 4; ++j) *(f32x4*)(o + 256 * j) = v[j] * rstd * ng[j];
        } else {
            const float* sh = a.shift + cond * 6144 + 4 * lane; const float* scp = a.scale + cond * 6144 + 4 * lane;
            f32x4 h[4];
#pragma unroll
            for (int j = 0; j < 4; ++j) { const f32x4 s = *(const f32x4*)(sh + 256 * j), c1 = *(const f32x4*)(scp + 256 * j); h[j] = (v[j] * rstd * ng[j]) * (c1 + 1.0f) + s; }
            bf16* hr = H + (size_t)row * D + 4 * lane;
#pragma unroll
            for (int j = 0; j < 4; ++j) { v2u w; w.x = pk2(h[j].x, h[j].y); w.y = pk2(h[j].z, h[j].w); *(v2u*)(hr + 256 * j) = w; }
            if (ROUTE) {
                float lg[8];
#pragma unroll
                for (int e = 0; e < 8; ++e) lg[e] = 0.f;
#pragma unroll
                for (int j = 0; j < 4; ++j)
#pragma unroll
                    for (int q = 0; q < 4; ++q) { const float hv = h[j][q]; const float* wr = a.w_router + (size_t)(4 * lane + 256 * j + q) * 8; const f32x4 w0 = *(const f32x4*)wr, w1 = *(const f32x4*)(wr + 4);
                        lg[0] += hv * w0.x; lg[1] += hv * w0.y; lg[2] += hv * w0.z; lg[3] += hv * w0.w; lg[4] += hv * w1.x; lg[5] += hv * w1.y; lg[6] += hv * w1.z; lg[7] += hv * w1.w; }
#pragma unroll
                for (int e = 0; e < 8; ++e) lg[e] = wave_sum(lg[e]);
                int i1 = 0; float v1 = lg[0];
#pragma unroll
                for (int e = 1; e < 8; ++e) if (lg[e] > v1) { v1 = lg[e]; i1 = e; }
                int i2 = -1; float v2 = -3.0e38f;
#pragma unroll
                for (int e = 0; e < 8; ++e) if (e != i1 && lg[e] > v2) { v2 = lg[e]; i2 = e; }
                const float e2 = __expf(v2 - v1), w1 = 1.0f / (1.0f + e2), w2 = e2 * w1;
                if (lane == 0) { const int r1 = __hip_atomic_fetch_add((LAS int*)&lcnt[i1], 1, __ATOMIC_RELAXED, __HIP_MEMORY_SCOPE_WORKGROUP), r2 = __hip_atomic_fetch_add((LAS int*)&lcnt[i2], 1, __ATOMIC_RELAXED, __HIP_MEMORY_SCOPE_WORKGROUP);
                    a.tok_e[row * 2] = i1; a.tok_e[row * 2 + 1] = i2; a.tok_wo[row * 2] = w1; a.tok_wo[row * 2 + 1] = w2; a.tok_rank[row * 2] = r1; a.tok_rank[row * 2 + 1] = r2; }
            }
        }
    }
    if (ROUTE) {
        __syncthreads();
        if (F.tid < 8) lcnt[8 + F.tid] = (int)__hip_atomic_fetch_add(a.cnt + 64 * F.tid, (unsigned)lcnt[F.tid], RLX_AGENT);
        __syncthreads();
        for (int row = a.row_lo + gw; row < a.row_hi; row += NGW) if (lane < 2) { const int e = __hip_atomic_load(a.tok_e + row * 2 + lane, RLX_AGENT); const int rk = __hip_atomic_load(a.tok_rank + row * 2 + lane, RLX_AGENT); a.tok_rank[row * 2 + lane] = rk + lcnt[8 + e]; }
    }
}
__device__ __forceinline__ void moe_offsets(gu32* cnt, int (&ts)[9], int (&cn)[8]) {
    int t = 0;
#pragma unroll
    for (int e = 0; e < 8; ++e) { cn[e] = (int)__hip_atomic_load(cnt + 64 * e, RLX_AGENT); ts[e] = t; t += (cn[e] + 255) >> 8; }
    ts[8] = t;
}
__device__ __forceinline__ void moe_lists(Frame& F, gu32* cnt, int row_lo, int row_hi) {
    int ts[9], cn[8]; moe_offsets(cnt, ts, cn);
    const int* tok_e = (const int*)(F.ws + WS_TOK); const int* tok_rank = tok_e + 4 * NR; int* tok_slot = (int*)tok_e + 6 * NR; int* rowidx = (int*)(F.ws + WS_ROWIDX);
    const int gt = blockIdx.x * 512 + F.tid, NT = F.G * 512;
    for (int i = row_lo * 2 + gt; i < row_hi * 2; i += NT) { const int e = tok_e[i]; int t0 = 0;
#pragma unroll
        for (int j = 0; j < 8; ++j) t0 = (e == j) ? ts[j] : t0;
        const int slot = t0 * 256 + tok_rank[i]; tok_slot[i] = slot; rowidx[slot] = i >> 1; }
    for (int i = gt; i < 8 * 256; i += NT) { const int e = i >> 8, k = i & 255; int t0 = 0, c0 = 0, t1 = 0;
#pragma unroll
        for (int j = 0; j < 8; ++j) { t0 = (e == j) ? ts[j] : t0; c0 = (e == j) ? cn[j] : c0; t1 = (e == j) ? ts[j + 1] : t1; }
        const int s = t0 * 256 + c0 + k; if (s < t1 * 256) rowidx[s] = row_lo; }
}

__device__ __forceinline__ void ret_prep(Frame& F, int j_ret, const float* decay_f, const float* decay_b) {
    const int tid = F.tid, lane = F.lane, w = F.wave;
    bf16* BIG = (bf16*)(F.ws + WS_BIG);
    const f32x2* rope = (const f32x2*)(F.ws + WS_ROPE);
    LAS bf16* ks = (LAS bf16*)F.lds;
    LAS bf16* vs = (LAS bf16*)(F.lds + 67584);
    for (int u = blockIdx.x; u < 544; u += F.G) {
        const int cg = u >> 2, h = u & 3, row0 = cg * 128;
        const float gf = sigmoidf_(decay_f[j_ret * 4 + h]), gb = sigmoidf_(decay_b[j_ret * 4 + h]);
        const float lf = log2f(gf), lb = log2f(gb);
        const bool isctx = row0 < NCTX;
        for (int it = tid; it < 1024; it += 512) { const int j = it >> 3, i0 = (it & 7) * 8, row = row0 + j;
            const bf16* kp = BIG + (size_t)row * RET_NIN + 1024 + h * 256;
            const v4u a1 = *(const v4u*)(kp + i0), a2 = *(const v4u*)(kp + 64 + i0), b1 = *(const v4u*)(kp + 128 + i0), b2 = *(const v4u*)(kp + 192 + i0);
            const int p = (row - NCTX) & 4095, pr = p >> 6, pc = p & 63;
            unsigned o1[4], o2[4], o3[4], o4[4];
#pragma unroll
            for (int t = 0; t < 4; ++t) {
                float x1[2] = {bflo(a1[t]), bfhi(a1[t])}, x2[2] = {bflo(a2[t]), bfhi(a2[t])}, y1[2] = {bflo(b1[t]), bfhi(b1[t])}, y2[2] = {bflo(b2[t]), bfhi(b2[t])};
                float r1[2], r2[2], r3[2], r4[2];
#pragma unroll
                for (int q = 0; q < 2; ++q) { const int fi = i0 + 2 * t + q; f32x2 cr = (f32x2){1.f, 0.f}, cc = (f32x2){1.f, 0.f};
                    if (!isctx) { cr = rope[pr * 64 + fi]; cc = rope[pc * 64 + fi]; }
                    r1[q] = (x1[q] * cr.x - x2[q] * cr.y) * 0.0625f; r2[q] = (x2[q] * cr.x + x1[q] * cr.y) * 0.0625f;
                    r3[q] = (y1[q] * cc.x - y2[q] * cc.y) * 0.0625f; r4[q] = (y2[q] * cc.x + y1[q] * cc.y) * 0.0625f; }
                o1[t] = pk2(r1[0], r1[1]); o2[t] = pk2(r2[0], r2[1]); o3[t] = pk2(r3[0], r3[1]); o4[t] = pk2(r4[0], r4[1]); }
            LAS bf16* kd = ks + j * 264 + i0;
            *(LAS v4u*)(kd) = (v4u){o1[0], o1[1], o1[2], o1[3]}; *(LAS v4u*)(kd + 64) = (v4u){o2[0], o2[1], o2[2], o2[3]};
            *(LAS v4u*)(kd + 128) = (v4u){o3[0], o3[1], o3[2], o3[3]}; *(LAS v4u*)(kd + 192) = (v4u){o4[0], o4[1], o4[2], o4[3]}; }
        bf16x8 qf[8];
        { const int row = row0 + 16 * w + (lane & 15); bf16* qp = BIG + (size_t)row * RET_NIN + h * 256 + 8 * (lane >> 4);
          v4u raw[8];
#pragma unroll
          for (int s = 0; s < 8; ++s) raw[s] = *(const v4u*)(qp + 32 * s);
          const int p = (row - NCTX) & 4095, pr = p >> 6, pc = p & 63;
#pragma unroll
          for (int half = 0; half < 2; ++half)
#pragma unroll
              for (int s = 0; s < 2; ++s) { const int sa = 4 * half + s, sb = sa + 2; const int pos = half ? pc : pr; v4u oa, ob;
#pragma unroll
                  for (int t = 0; t < 4; ++t) { float xa[2] = {bflo(raw[sa][t]), bfhi(raw[sa][t])}, xb[2] = {bflo(raw[sb][t]), bfhi(raw[sb][t])}; float ra[2], rb[2];
#pragma unroll
                      for (int q = 0; q < 2; ++q) { const int fi = 32 * s + 8 * (lane >> 4) + 2 * t + q; f32x2 cs = (f32x2){1.f, 0.f}; if (!isctx) cs = rope[pos * 64 + fi];
                          ra[q] = xa[q] * cs.x - xb[q] * cs.y; rb[q] = xb[q] * cs.x + xa[q] * cs.y; }
                      oa[t] = pk2(ra[0], ra[1]); ob[t] = pk2(rb[0], rb[1]); }
                  raw[sa] = oa; raw[sb] = ob; }
#pragma unroll
          for (int s = 0; s < 8; ++s) { *(v4u*)(qp + 32 * s) = raw[s]; qf[s] = __builtin_bit_cast(bf16x8, raw[s]); } }
        __syncthreads();
        { f32x4 acc[8];
#pragma unroll
          for (int n = 0; n < 8; ++n) acc[n] = (f32x4){0.f, 0.f, 0.f, 0.f};
#pragma unroll
          for (int s = 0; s < 8; ++s)
#pragma unroll
              for (int n = 0; n < 8; ++n) { const bf16x8 kf = *(const LAS bf16x8*)(ks + (16 * n + (lane & 15)) * 264 + 32 * s + 8 * (lane >> 4));
                  acc[n] = __builtin_amdgcn_mfma_f32_16x16x32_bf16(kf, qf[s], acc[n], 0, 0, 0); }
          const int i = 16 * w + (lane & 15);
          bf16* pf = (bf16*)(F.ws + PREP_PF) + (size_t)u * 16384 + i * 128; bf16* pb = (bf16*)(F.ws + PREP_PB) + (size_t)u * 16384 + i * 128;
#pragma unroll
          for (int n = 0; n < 8; ++n) { const int j0 = 16 * n + 4 * (lane >> 4); float vf[4], vb[4];
#pragma unroll
              for (int r = 0; r < 4; ++r) { const int j = j0 + r, dd = i - j; vf[r] = dd >= 0 ? acc[n][r] * exp2f(lf * (float)dd) : 0.f; vb[r] = dd <= 0 ? acc[n][r] * exp2f(lb * (float)(-dd)) : 0.f; }
              *(v2u*)(pf + j0) = (v2u){pk2(vf[0], vf[1]), pk2(vf[2], vf[3])}; *(v2u*)(pb + j0) = (v2u){pk2(vb[0], vb[1]), pk2(vb[2], vb[3])}; } }
        { bf16* ktf = (bf16*)(F.ws + PREP_KTF) + (size_t)u * 32768; bf16* ktb = (bf16*)(F.ws + PREP_KTB) + (size_t)u * 32768;
          for (int it = tid; it < 4096; it += 512) { const int jg = it & 3, dl = (it >> 2) & 15, blk = it >> 6; const int d = (blk >> 2) * 16 + dl, j0 = ((blk & 3) * 4 + jg) * 8;
              float kv[8];
#pragma unroll
              for (int t = 0; t < 8; ++t) kv[t] = bf2f(ks[(j0 + t) * 264 + d]);
              v4u of, ob;
#pragma unroll
              for (int t = 0; t < 4; ++t) { const int ja = j0 + 2 * t, jb = ja + 1;
                  of[t] = pk2(kv[2 * t] * exp2f(lf * (float)(127 - ja)), kv[2 * t + 1] * exp2f(lf * (float)(127 - jb)));
                  ob[t] = pk2(kv[2 * t] * exp2f(lb * (float)ja), kv[2 * t + 1] * exp2f(lb * (float)jb)); }
              *(v4u*)(ktf + d * 128 + j0) = of; *(v4u*)(ktb + d * 128 + j0) = ob; } }
        { bf16* vt = (bf16*)(F.ws + PREP_VT) + (size_t)u * 65536;
          for (int qd = 0; qd < 4; ++qd) {
              __syncthreads();
              for (int it = tid; it < 2048; it += 512) { const int j = it >> 4, pc = it & 15;
                  const v4u x = *(const v4u*)(BIG + (size_t)(row0 + j) * RET_NIN + 2048 + h * 512 + qd * 128 + pc * 8); *(LAS v4u*)(vs + j * 136 + pc * 8) = x; }
              __syncthreads();
              for (int it = tid; it < 2048; it += 512) { const int jg = it & 3, el = (it >> 2) & 15, blk = it >> 6; const int e = (blk >> 2) * 16 + el, j0 = ((blk & 3) * 4 + jg) * 8;
                  unsigned short xv[8];
#pragma unroll
                  for (int t = 0; t < 8; ++t) xv[t] = vs[(j0 + t) * 136 + e];
                  v4u o; o.x = xv[0] | ((unsigned)xv[1] << 16); o.y = xv[2] | ((unsigned)xv[3] << 16); o.z = xv[4] | ((unsigned)xv[5] << 16); o.w = xv[6] | ((unsigned)xv[7] << 16);
                  *(v4u*)(vt + (size_t)(qd * 128 + e) * 128 + j0) = o; } } }
        __syncthreads();
    }
}
__device__ __forceinline__ void ret_scan(Frame& F, int j_ret, const float* decay_f, const float* decay_b, bool with_ctx) {
    const int lane = F.lane, w = F.wave, l15 = lane & 15, lq = lane >> 4;
    const bf16* BIG = (const bf16*)(F.ws + WS_BIG);
    LAS bf16* ST = (LAS bf16*)F.lds;
    for (int u = blockIdx.x; u < 256; u += F.G) {
        const int es = u & 7, dir = (u >> 3) & 1, h = (u >> 4) & 3, b = u >> 6;
        const float gam = sigmoidf_((dir ? decay_b : decay_f)[j_ret * 4 + h]), lg = log2f(gam), g128 = exp2f(lg * 128.f);
        const bf16* PD = (const bf16*)(F.ws + (dir ? PREP_PB : PREP_PF)); const bf16* KT = (const bf16*)(F.ws + (dir ? PREP_KTB : PREP_KTF)); const bf16* VTg = (const bf16*)(F.ws + PREP_VT);
        bf16* OUT = (bf16*)(F.ws + WS_OFB) + (dir ? (size_t)NR * 2048 : 0);
        f32x4 st[2][4];
#pragma unroll
        for (int dt = 0; dt < 2; ++dt)
#pragma unroll
            for (int et = 0; et < 4; ++et) st[dt][et] = (f32x4){0.f, 0.f, 0.f, 0.f};
        __syncthreads();
        for (int i = F.tid; i < 64 * 264 / 2; i += 512) ((LAS unsigned*)ST)[i] = 0u;
        __syncthreads();
        const int il = 16 * w + l15;
        const float qs = dir ? exp2f(lg * (float)(128 - il)) : exp2f(lg * (float)(il + 1));
        for (int s = 0; s < 34; ++s) {
            const int lc = dir ? (s == 0 ? 1 : (s == 1 ? 0 : 35 - s)) : s;
            const int cg = lc < 2 ? b * 2 + lc : 8 + b * 32 + (lc - 2);
            const int row0 = cg * 128, pu = cg * 4 + h;
            const bf16* vtp = VTg + (size_t)pu * 65536 + (size_t)(64 * es + l15) * 128 + 8 * lq;
            bf16x8 vf[4][4];
#pragma unroll
            for (int et = 0; et < 4; ++et)
#pragma unroll
                for (int s4 = 0; s4 < 4; ++s4) vf[et][s4] = *(const bf16x8*)(vtp + et * 16 * 128 + 32 * s4);
            if (with_ctx || lc >= 2) {
                f32x4 a1[4], a2[4];
#pragma unroll
                for (int et = 0; et < 4; ++et) { a1[et] = (f32x4){0.f, 0.f, 0.f, 0.f}; a2[et] = (f32x4){0.f, 0.f, 0.f, 0.f}; }
                const bf16* pp = PD + (size_t)pu * 16384 + il * 128 + 8 * lq;
#pragma unroll
                for (int s4 = 0; s4 < 4; ++s4) { const bf16x8 pf = *(const bf16x8*)(pp + 32 * s4);
#pragma unroll
                    for (int et = 0; et < 4; ++et) a1[et] = __builtin_amdgcn_mfma_f32_16x16x32_bf16(vf[et][s4], pf, a1[et], 0, 0, 0); }
                const bf16* qp = BIG + (size_t)(row0 + il) * RET_NIN + h * 256 + 8 * lq;
#pragma unroll
                for (int s8 = 0; s8 < 8; ++s8) { const bf16x8 qf = *(const bf16x8*)(qp + 32 * s8);
#pragma unroll
                    for (int et = 0; et < 4; ++et) { const bf16x8 sf = *(const LAS bf16x8*)(ST + (16 * et + l15) * 264 + 32 * s8 + 8 * lq);
                        a2[et] = __builtin_amdgcn_mfma_f32_16x16x32_bf16(sf, qf, a2[et], 0, 0, 0); } }
                bf16* op = OUT + (size_t)(row0 + il) * 2048 + h * 512 + 64 * es + 4 * lq;
#pragma unroll
                for (int et = 0; et < 4; ++et) { const f32x4 o = a1[et] + a2[et] * qs; *(v2u*)(op + 16 * et) = (v2u){pk2(o[0], o[1]), pk2(o[2], o[3])}; }
            }
            __syncthreads();
            const bf16* kp = KT + (size_t)pu * 32768 + (size_t)(32 * w + l15) * 128 + 8 * lq;
#pragma unroll
            for (int dt = 0; dt < 2; ++dt) {
#pragma unroll
                for (int et = 0; et < 4; ++et) st[dt][et] = st[dt][et] * g128;
#pragma unroll
                for (int s4 = 0; s4 < 4; ++s4) { const bf16x8 kf = *(const bf16x8*)(kp + dt * 16 * 128 + 32 * s4);
#pragma unroll
                    for (int et = 0; et < 4; ++et) st[dt][et] = __builtin_amdgcn_mfma_f32_16x16x32_bf16(kf, vf[et][s4], st[dt][et], 0, 0, 0); }
#pragma unroll
                for (int et = 0; et < 4; ++et) *(LAS v2u*)(ST + (16 * et + l15) * 264 + 32 * w + 16 * dt + 4 * lq) = (v2u){pk2(st[dt][et][0], st[dt][et][1]), pk2(st[dt][et][2], st[dt][et][3])};
            }
            __syncthreads();
        }
    }
}
__device__ __forceinline__ void ret_gate(Frame& F, const float* gnf, const float* gnb, int row_lo) {
    const int gw = F.vcu * NWAVES + F.wave, NGW = F.G * NWAVES, lane = F.lane;
    const bf16* BIG = (const bf16*)(F.ws + WS_BIG); const bf16* OFp = (const bf16*)(F.ws + WS_OFB); const bf16* OBp = OFp + (size_t)NR * 2048; bf16* MIX = (bf16*)(F.ws + WS_MIX);
    for (int row = row_lo + gw; row < NR; row += NGW) {
#pragma unroll
        for (int h = 0; h < 4; ++h) {
            const int col = h * 512 + 8 * lane;
            float y[2][8];
#pragma unroll
            for (int dir = 0; dir < 2; ++dir) {
                const v4u raw = *(const v4u*)((dir ? OBp : OFp) + (size_t)row * 2048 + col); float x[8];
#pragma unroll
                for (int t = 0; t < 4; ++t) { x[2 * t] = bflo(raw[t]); x[2 * t + 1] = bfhi(raw[t]); }
                float s = 0.f;
#pragma unroll
                for (int t = 0; t < 8; ++t) s += x[t];
                const float mu = wave_sum(s) * (1.0f / 512.0f); float q = 0.f;
#pragma unroll
                for (int t = 0; t < 8; ++t) { x[t] -= mu; q += x[t] * x[t]; }
                const float rstd = 1.0f / sqrtf(wave_sum(q) * (1.0f / 512.0f) + EPS);
                const float* gn = (dir ? gnb : gnf) + col; const f32x4 g0 = *(const f32x4*)gn, g1 = *(const f32x4*)(gn + 4);
#pragma unroll
                for (int t = 0; t < 8; ++t) y[dir][t] = x[t] * rstd * (t < 4 ? g0[t] : g1[t - 4]);
            }
            const v4u gfr = *(const v4u*)(BIG + (size_t)row * RET_NIN + 4096 + col), gbr = *(const v4u*)(BIG + (size_t)row * RET_NIN + 6144 + col);
            v4u o;
#pragma unroll
            for (int t = 0; t < 4; ++t) { const float f0 = bflo(gfr[t]), f1 = bfhi(gfr[t]), b0 = bflo(gbr[t]), b1 = bfhi(gbr[t]);
                const float m0 = f0 * sigmoidf_(f0) * y[0][2 * t] + b0 * sigmoidf_(b0) * y[1][2 * t], m1 = f1 * sigmoidf_(f1) * y[0][2 * t + 1] + b1 * sigmoidf_(b1) * y[1][2 * t + 1];
                o[t] = pk2(m0, m1); }
            *(v4u*)(MIX + (size_t)row * 2048 + col) = o;
        }
    }
}

__device__ __forceinline__ void mla_rows(Frame& F, const float* g_q, const float* g_kv) {
    const int gw = F.vcu * NWAVES + F.wave, NGW = F.G * NWAVES, lane = F.lane;
    const float* CKV = (const float*)(F.ws + MLA_CKV); bf16* CQN = (bf16*)(F.ws + MLA_CQN); bf16* CKVN = (bf16*)(F.ws + MLA_CKVN); bf16* KR = (bf16*)(F.ws + MLA_KV) + 2048;
    const f32x2* rm = (const f32x2*)(F.ws + WS_ROPE) + 64 * 64;
    const f32x4 gq = *(const f32x4*)(g_q + 4 * lane), gk = *(const f32x4*)(g_kv + 4 * lane);
    for (int row = gw; row < NR; row += NGW) {
        const float* r = CKV + (size_t)row * 768;
        const f32x4 a = *(const f32x4*)(r + 4 * lane), c = *(const f32x4*)(r + 256 + 4 * lane);
        const float sa = wave_sum((a.x * a.x + a.y * a.y) + (a.z * a.z + a.w * a.w)), sc = wave_sum((c.x * c.x + c.y * c.y) + (c.z * c.z + c.w * c.w));
        const float ra = 1.0f / sqrtf(sa * (1.0f / 256.0f) + EPS), rc = 1.0f / sqrtf(sc * (1.0f / 256.0f) + EPS);
        *(v2u*)(CQN + (size_t)row * 256 + 4 * lane) = (v2u){pk2(a.x * ra * gq.x, a.y * ra * gq.y), pk2(a.z * ra * gq.z, a.w * ra * gq.w)};
        *(v2u*)(CKVN + (size_t)row * 256 + 4 * lane) = (v2u){pk2(c.x * rc * gk.x, c.y * rc * gk.y), pk2(c.z * rc * gk.z, c.w * rc * gk.w)};
        if (lane < 32) { const int part = lane >> 4, i = lane & 15; const float x1 = r[512 + part * 32 + i], x2 = r[512 + part * 32 + 16 + i];
            f32x2 cs = (f32x2){1.f, 0.f};
            if (row >= NCTX) { const int p = (row - NCTX) & 4095; const int pos = part ? (p & 63) : (p >> 6); cs = rm[pos * 16 + i]; }
            KR[(size_t)row * KVR_LD + part * 32 + i] = (bf16)f2bf(x1 * cs.x - x2 * cs.y); KR[(size_t)row * KVR_LD + part * 32 + 16 + i] = (bf16)f2bf(x2 * cs.x + x1 * cs.y); }
    }
}

__device__ __forceinline__ void sgu_rstd(Frame& F) {
    const int gw = F.vcu * NWAVES + F.wave, NGW = F.G * NWAVES, lane = F.lane;
    const bf16* UV = (const bf16*)(F.ws + SGU_UV); float* rs = (float*)(F.ws + WS_RSTD);
    for (int row = gw; row < NR; row += NGW) { const bf16* v = UV + (size_t)row * 6144 + 3072; float s = 0.f;
#pragma unroll
        for (int j = 0; j < 6; ++j) { const v4u x = *(const v4u*)(v + 8 * lane + 512 * j);
#pragma unroll
            for (int t = 0; t < 4; ++t) { const float a = bflo(x[t]), b = bfhi(x[t]); s += a * a + b * b; } }
        s = wave_sum(s); if (lane == 0) rs[row] = 1.0f / sqrtf(s * (1.0f / 3072.0f) + EPS); }
}
__device__ __forceinline__ void sgu_spatial(Frame& F, const float* g_v, const float* b_s) {
    const int tid = F.tid, lane = F.lane, w = F.wave, l15 = lane & 15, lq = lane >> 4;
    const bf16* UV = (const bf16*)(F.ws + SGU_UV); bf16* UZ = (bf16*)(F.ws + SGU_UZ); const float* rs = (const float*)(F.ws + WS_RSTD); const bf16* WSB = (const bf16*)(F.ws + WS_WSB);
    LAS bf16* VT = (LAS bf16*)F.lds;
    LAS bf16* WL = (LAS bf16*)(F.lds + 52224);
    for (int u = F.vcu; u < 136 * 16; u += F.G) {
        const int cg = u >> 4, g = (u >> 1) & 7, half = u & 1, row0 = cg * 128, c0 = g * 384 + half * 192;
        __syncthreads();
        for (int it = tid; it < 2048; it += 512) { const int p = it >> 4, pc = it & 15; *(LAS v4u*)(WL + p * 136 + pc * 8) = *(const v4u*)(WSB + (size_t)g * 16384 + p * 128 + pc * 8); }
        for (int it = tid; it < 3072; it += 512) { const int q = it & 127, c8 = it >> 7; const float r = rs[row0 + q];
            const v4u x = *(const v4u*)(UV + (size_t)(row0 + q) * 6144 + 3072 + c0 + c8 * 8); const f32x4 g0 = *(const f32x4*)(g_v + c0 + c8 * 8), g1 = *(const f32x4*)(g_v + c0 + c8 * 8 + 4);
#pragma unroll
            for (int t = 0; t < 4; ++t) { const float a = bflo(x[t]) * r * (t < 2 ? g0[2 * t] : g1[2 * t - 4]), b = bfhi(x[t]) * r * (t < 2 ? g0[2 * t + 1] : g1[2 * t - 3]);
                VT[(c8 * 8 + 2 * t) * 136 + q] = (bf16)f2bf(a); VT[(c8 * 8 + 2 * t + 1) * 136 + q] = (bf16)f2bf(b); } }
        __syncthreads();
        f32x4 acc[12];
#pragma unroll
        for (int ct = 0; ct < 12; ++ct) acc[ct] = (f32x4){0.f, 0.f, 0.f, 0.f};
#pragma unroll
        for (int s4 = 0; s4 < 4; ++s4) { const bf16x8 wf = *(const LAS bf16x8*)(WL + (16 * w + l15) * 136 + 32 * s4 + 8 * lq);
#pragma unroll
            for (int ct = 0; ct < 12; ++ct) { const bf16x8 vf = *(const LAS bf16x8*)(VT + (16 * ct + l15) * 136 + 32 * s4 + 8 * lq);
                acc[ct] = __builtin_amdgcn_mfma_f32_16x16x32_bf16(vf, wf, acc[ct], 0, 0, 0); } }
        const int p = 16 * w + l15; const float bs = b_s[g * 128 + p];
        const bf16* up = UV + (size_t)(row0 + p) * 6144 + c0 + 4 * lq; bf16* zp = UZ + (size_t)(row0 + p) * 3072 + c0 + 4 * lq;
#pragma unroll
        for (int ct = 0; ct < 12; ++ct) { const v2u ur = *(const v2u*)(up + 16 * ct);
            const float z0 = (acc[ct][0] + bs) * bflo(ur.x), z1 = (acc[ct][1] + bs) * bfhi(ur.x), z2 = (acc[ct][2] + bs) * bflo(ur.y), z3 = (acc[ct][3] + bs) * bfhi(ur.y);
            *(v2u*)(zp + 16 * ct) = (v2u){pk2(z0, z1), pk2(z2, z3)}; }
    }
}

namespace att {
constexpr int NW = 8, QBLK = 32, KVBLK = 64;
constexpr float SCALE = 0.07216878364870322f;
constexpr float THR = 8.f;
constexpr int SHM_V = KVBLK * 128 * 2, SHM_K = KVBLK * 192 * 2;
constexpr int SHM_ATTN = 2 * SHM_V + 2 * SHM_K + NW * 64 * 4 + NW * 4096;
using s16x4  = __attribute__((ext_vector_type(4))) short;
using f32x16 = __attribute__((ext_vector_type(16))) float;
#define KSWZ(row, colB) ((row) * 384 + ((colB) ^ (((row) & 7) << 4)))
#define SBAR() __builtin_amdgcn_sched_barrier(0)
__device__ __forceinline__ int crow(int r, int hi) { return (r & 3) + 8 * (r >> 2) + 4 * hi; }
__device__ __forceinline__ unsigned cvtpk(float lo, float hi) { unsigned r; asm volatile("v_cvt_pk_bf16_f32 %0, %1, %2" : "=v"(r) : "v"(lo), "v"(hi)); return r; }

__device__ __forceinline__ void partialSM(f32x16& p0, f32x16& p1, float& m_reg, float& mn, float& alpha) {
  constexpr float C = SCALE * 1.4426950408889634f;
  float pmax = p0[0]; for (int r = 1; r < 16; ++r) pmax = fmaxf(pmax, p0[r]); for (int r = 0; r < 16; ++r) pmax = fmaxf(pmax, p1[r]);
  { auto rr = __builtin_amdgcn_permlane32_swap(__float_as_uint(pmax), __float_as_uint(pmax), false, false);
    pmax = fmaxf(__uint_as_float(rr[0]), __uint_as_float(rr[1])); }
  if (__builtin_expect(__all(pmax - m_reg <= THR / SCALE), 1)) { mn = m_reg; alpha = 1.f; }
  else { mn = fmaxf(m_reg, pmax); alpha = __builtin_amdgcn_exp2f((m_reg - mn) * C); m_reg = mn; }
  float mnC = -mn * C;
  for (int r = 0; r < 16; ++r) p0[r] = fmaf(p0[r], C, mnC); for (int r = 0; r < 16; ++r) p1[r] = fmaf(p1[r], C, mnC);
  for (int r = 0; r < 16; ++r) p0[r] = __builtin_amdgcn_exp2f(p0[r]);
}
__device__ __forceinline__ void finishSM(f32x16& p0, f32x16& p1, float alpha, float& l_reg, bf16x8& pa0, bf16x8& pa1, bf16x8& pa2, bf16x8& pa3) {
  for (int r = 0; r < 16; ++r) p1[r] = __builtin_amdgcn_exp2f(p1[r]);
  float ps = 0; for (int r = 0; r < 16; ++r) ps += p0[r]; for (int r = 0; r < 16; ++r) ps += p1[r];
  { auto rr = __builtin_amdgcn_permlane32_swap(__float_as_uint(ps), __float_as_uint(ps), false, false);
    ps = __uint_as_float(rr[0]) + __uint_as_float(rr[1]); }
  l_reg = l_reg * alpha + ps;
#define PK4(P, BASE, OUT) do { unsigned a0 = cvtpk(P[BASE + 0], P[BASE + 1]), a1 = cvtpk(P[BASE + 2], P[BASE + 3]);   \
    unsigned b0 = cvtpk(P[BASE + 4], P[BASE + 5]), b1 = cvtpk(P[BASE + 6], P[BASE + 7]);                              \
    auto r0 = __builtin_amdgcn_permlane32_swap(a0, b0, false, false); auto r1 = __builtin_amdgcn_permlane32_swap(a1, b1, false, false); \
    v4u w = {r0[0], r1[0], r0[1], r1[1]}; OUT = __builtin_bit_cast(bf16x8, w); } while (0)
  PK4(p0, 0, pa0); PK4(p0, 8, pa1); PK4(p1, 0, pa2); PK4(p1, 8, pa3);
#undef PK4
}
template <int BUF> __device__ __forceinline__ void qkt(f32x16& p0, f32x16& p1, const LAS char* const (&ka)[4], const bf16x8* qr, const LAS char* qrope) {
  p0 = f32x16{}; p1 = f32x16{};
#pragma unroll
  for (int d0 = 0; d0 < 12; ++d0) { const LAS char* a = ka[d0 & 3] + (d0 >> 2) * 128 + BUF * SHM_K;
    const bf16x8 b0 = *reinterpret_cast<const LAS bf16x8*>(a);
    const bf16x8 b1 = *reinterpret_cast<const LAS bf16x8*>(a + 32 * 384);
    const bf16x8 qv = d0 < 8 ? qr[d0] : *reinterpret_cast<const LAS bf16x8*>(qrope + (d0 - 8) * 1024);
    p0 = __builtin_amdgcn_mfma_f32_32x32x16_bf16(b0, qv, p0, 0, 0, 0);
    p1 = __builtin_amdgcn_mfma_f32_32x32x16_bf16(b1, qv, p1, 0, 0, 0); }
}
__device__ __forceinline__ int v_st(int k, int c) { const int kk = (k & ~0xC) | ((k & 4) << 1) | ((k & 8) >> 1); return ((kk >> 3) * 4 + (c >> 5)) * 512 + ((kk & 7) * 32 + (c & 31)) * 2; }
__device__ __forceinline__ int v_rd_base(int lane) { return ((lane & 3) << 3) | (((lane >> 2) & 3) << 6) | (((lane >> 4) & 1) << 5) | (((lane >> 5) & 1) << 8); }
constexpr int v_rd_off(int d0, int ks, int half) { return d0 * 512 + ks * 4096 + half * 2048; }
template <int OFF> __device__ __forceinline__ s16x4 tr_read(int vb) {
  s16x4 r; asm volatile("ds_read_b64_tr_b16 %0, %1 offset:%2" : "=&v"(r) : "v"(vb), "i"(OFF) : "memory"); return r;
}
template <int D0> __device__ __forceinline__ void pv_one(f32x16& od, int vb, bf16x8 pa0, bf16x8 pa1, bf16x8 pa2, bf16x8 pa3) {
  const s16x4 l0 = tr_read<v_rd_off(D0, 0, 0)>(vb), h0 = tr_read<v_rd_off(D0, 0, 1)>(vb), l1 = tr_read<v_rd_off(D0, 1, 0)>(vb), h1 = tr_read<v_rd_off(D0, 1, 1)>(vb);
  const s16x4 l2 = tr_read<v_rd_off(D0, 2, 0)>(vb), h2 = tr_read<v_rd_off(D0, 2, 1)>(vb), l3 = tr_read<v_rd_off(D0, 3, 0)>(vb), h3 = tr_read<v_rd_off(D0, 3, 1)>(vb);
  asm volatile("s_waitcnt lgkmcnt(0)" ::: "memory"); SBAR();
#define PK(L, H) (bf16x8){L[0], L[1], L[2], L[3], H[0], H[1], H[2], H[3]}
  od = __builtin_amdgcn_mfma_f32_32x32x16_bf16(pa0, PK(l0, h0), od, 0, 0, 0);
  od = __builtin_amdgcn_mfma_f32_32x32x16_bf16(pa1, PK(l1, h1), od, 0, 0, 0);
  od = __builtin_amdgcn_mfma_f32_32x32x16_bf16(pa2, PK(l2, h2), od, 0, 0, 0);
  od = __builtin_amdgcn_mfma_f32_32x32x16_bf16(pa3, PK(l3, h3), od, 0, 0, 0);
#undef PK
}
__device__ __forceinline__ void pv_d0(f32x16* o, int vb, bf16x8 pa0, bf16x8 pa1, bf16x8 pa2, bf16x8 pa3) {
  pv_one<0>(o[0], vb, pa0, pa1, pa2, pa3); pv_one<1>(o[1], vb, pa0, pa1, pa2, pa3); pv_one<2>(o[2], vb, pa0, pa1, pa2, pa3); pv_one<3>(o[3], vb, pa0, pa1, pa2, pa3);
}
__device__ __forceinline__ void attn_unit(const bf16* __restrict__ Q, const bf16* __restrict__ KVR, bf16* __restrict__ O, const f32x2* __restrict__ ropem,
                                          int qrow0, int h, int kc0, int kl0, int nk, LAS unsigned char* ldsL) {
  char* lds = (char*)ldsL;
  int tid_ = threadIdx.x; asm volatile("" : "+v"(tid_));
  const int tid = tid_, wid = __builtin_amdgcn_readfirstlane(tid >> 6), lane = tid & 63, r32 = lane & 31, hi = lane >> 5;
  char* V_lds = lds;
  float* wsf = (float*)(lds + 2 * SHM_V + 2 * SHM_K) + wid * 64; float* li_l = wsf; float* al_l = wsf + 32;
  LAS char* qrope = (LAS char*)ldsL + 2 * SHM_V + 2 * SHM_K + NW * 64 * 4 + wid * 4096 + lane * 16;
  const LAS char* ka[4];
#pragma unroll
  for (int dr = 0; dr < 4; ++dr) ka[dr] = (const LAS char*)ldsL + 2 * SHM_V + r32 * 384 + (((dr * 2 + hi) ^ (r32 & 7)) << 4);
  float m_reg = -1e30f, l_reg = 0; f32x16 o[4] = {}; bf16x8 qr[8];
  { const bf16* Qs = Q; asm volatile("" : "+s"(Qs));
    const int qrow = qrow0 + wid * QBLK + r32; const bf16* Qw = Qs + (size_t)qrow * 1536 + h * 192 + hi * 8;
#pragma unroll
    for (int d0 = 0; d0 < 8; ++d0) qr[d0] = *reinterpret_cast<const bf16x8*>(Qw + d0 * 16);
    bf16x8 qx[4];
#pragma unroll
    for (int d0 = 0; d0 < 4; ++d0) qx[d0] = *reinterpret_cast<const bf16x8*>(Qw + (8 + d0) * 16);
    if (qrow >= NCTX) {
      const int p = (qrow - NCTX) & 4095;
#pragma unroll
      for (int part = 0; part < 2; ++part) { const int pos = part ? (p & 63) : (p >> 6); const v4u xa = __builtin_bit_cast(v4u, qx[2 * part]), xb = __builtin_bit_cast(v4u, qx[1 + 2 * part]); v4u oa, ob;
#pragma unroll
        for (int t = 0; t < 4; ++t) { const f32x2 c0 = ropem[pos * 16 + hi * 8 + 2 * t], c1 = ropem[pos * 16 + hi * 8 + 2 * t + 1];
          const float a0 = bflo(xa[t]), a1 = bfhi(xa[t]), b0 = bflo(xb[t]), b1 = bfhi(xb[t]);
          oa[t] = pk2(a0 * c0.x - b0 * c0.y, a1 * c1.x - b1 * c1.y); ob[t] = pk2(b0 * c0.x + a0 * c0.y, b1 * c1.x + a1 * c1.y); }
        qx[2 * part] = __builtin_bit_cast(bf16x8, oa); qx[1 + 2 * part] = __builtin_bit_cast(bf16x8, ob); } }
#pragma unroll
    for (int d0 = 0; d0 < 4; ++d0) *reinterpret_cast<LAS bf16x8*>(qrope + d0 * 1024) = qx[d0]; }
  const int vb0 = (int)(uintptr_t)V_lds + v_rd_base(lane);
#define KROW(k) ((k) < 256 ? kc0 + (k) : kl0 + (k) - 256)
#define KDMA(k0, b) do { const char* _kb = (const char*)(KVR + (size_t)KROW(k0) * 2112); int _ln = lane; asm volatile("" : "+v"(_ln)); _Pragma("unroll") for (int _i = 0; _i < 3; ++_i) { \
    const int _ob = (wid * 3 + _i) * 1024 + _ln * 16, _row = _ob / 384, _cb = (_ob - _row * 384) ^ ((_row & 7) << 4), _pc = _cb >> 4; \
    const unsigned _off = 2u * (unsigned)(_row * 2112 + (_pc < 16 ? h * 256 + _pc * 8 : 2048 + (_pc - 16) * 8)); \
    __builtin_amdgcn_global_load_lds((const unsigned*)(_kb + _off), (LAS unsigned*)(ldsL + 2 * SHM_V + (b) * SHM_K + (wid * 3 + _i) * 1024), 16, 0, 0); } } while (0)
#define VDMA(k0, b) do { const char* _kb = (const char*)(KVR + (size_t)KROW(k0) * 2112); int _ln = lane; asm volatile("" : "+v"(_ln)); _Pragma("unroll") for (int _i = 0; _i < 2; ++_i) { \
    const int _ob = (wid * 2 + _i) * 1024 + _ln * 16, _sub = _ob >> 9, _within = (_ob & 511) >> 1, _kk = (_sub >> 2) * 8 + (_within >> 5); \
    const int _k = (_kk & ~0xC) | ((_kk & 4) << 1) | ((_kk & 8) >> 1), _c = (_sub & 3) * 32 + (_within & 31); \
    const unsigned _off = 2u * (unsigned)(_k * 2112 + h * 256 + 128 + _c); \
    __builtin_amdgcn_global_load_lds((const unsigned*)(_kb + _off), (LAS unsigned*)(ldsL + (b) * SHM_V + (wid * 2 + _i) * 1024), 16, 0, 0); } } while (0)
#define VMSYNC() do { asm volatile("s_waitcnt vmcnt(0)" ::: "memory"); __syncthreads(); } while (0)
#define RESC(a) do { if (__any((a) < 1.f)) { if (hi == 0) al_l[r32] = (a); asm volatile("s_waitcnt lgkmcnt(0)" ::: "memory"); \
    for (int d = 0; d < 4; ++d) for (int r = 0; r < 16; ++r) o[d][r] *= al_l[crow(r, hi)]; } } while (0)
  f32x16 pA0, pA1, pB0, pB1; float mnA, mnB, alA, alB; bf16x8 pa0, pa1, pa2, pa3; const int NT = nk / KVBLK;
  KDMA(0, 0); VDMA(0, 0); KDMA(KVBLK, 1); VDMA(KVBLK, 1); VMSYNC();
  qkt<0>(pA0, pA1, ka, qr, qrope); partialSM(pA0, pA1, m_reg, mnA, alA);
  for (int j = 1; j + 1 < NT; j += 2) {
    SBAR(); qkt<1>(pB0, pB1, ka, qr, qrope);
    finishSM(pA0, pA1, alA, l_reg, pa0, pa1, pa2, pa3); SBAR();
    KDMA((j + 1) * KVBLK, 0); SBAR();
    pv_d0(o, vb0, pa0, pa1, pa2, pa3); partialSM(pB0, pB1, m_reg, mnB, alB);
    VMSYNC();
    VDMA((j + 1) * KVBLK, 0);
    RESC(alB);
    SBAR(); qkt<0>(pA0, pA1, ka, qr, qrope);
    finishSM(pB0, pB1, alB, l_reg, pa0, pa1, pa2, pa3); SBAR();
    KDMA((j + 2) * KVBLK, 1); SBAR();
    pv_d0(o, vb0 + SHM_V, pa0, pa1, pa2, pa3); partialSM(pA0, pA1, m_reg, mnA, alA);
    VMSYNC();
    VDMA((j + 2) * KVBLK, 1);
    RESC(alA);
  }
  SBAR(); qkt<1>(pB0, pB1, ka, qr, qrope);
  finishSM(pA0, pA1, alA, l_reg, pa0, pa1, pa2, pa3); SBAR();
  pv_d0(o, vb0, pa0, pa1, pa2, pa3); partialSM(pB0, pB1, m_reg, mnB, alB);
  VMSYNC(); RESC(alB);
  finishSM(pB0, pB1, alB, l_reg, pa0, pa1, pa2, pa3); SBAR();
  pv_d0(o, vb0 + SHM_V, pa0, pa1, pa2, pa3);
  if (hi == 0) li_l[r32] = l_reg; asm volatile("s_waitcnt lgkmcnt(0)" ::: "memory");
  float rli[16];
#pragma unroll
  for (int r = 0; r < 16; ++r) rli[r] = __builtin_amdgcn_rcpf(li_l[crow(r, hi)]);
  bf16* Ow = O + (size_t)(qrow0 + wid * QBLK) * 1024 + h * 128;
#pragma unroll
  for (int r = 0; r < 16; ++r) { const int orow = crow(r, hi);
#pragma unroll
    for (int d0 = 0; d0 < 4; ++d0) Ow[(size_t)orow * 1024 + d0 * 32 + r32] = (bf16)f2bf(o[d0][r] * rli[r]); }
  __syncthreads();
#undef KROW
#undef KDMA
#undef VDMA
#undef VMSYNC
#undef RESC
}
#undef KSWZ
}

enum Phase { P_PRO, P0_MOD, P0_WIN, P0_PREP, P0_SCAN, P0_GATE, P0_WO, P0_MOD2, P0_GU, P0_DOWN, P1_MOD, P1_WD, P1_ROWS, P1_UQ, P1_UKV, P1_ATT, P1_WO, P1_MOD2, P1_LIST, P1_MGU, P1_MDN, P2_MOD, P2_WIN, P2_RSTD, P2_SPA, P2_WOUT, P2_MOD2, P2_GU, P2_DOWN, P3_MOD, P3_WIN, P3_PREP, P3_SCAN, P3_GATE, P3_WO, P3_MOD2, P3_LIST, P3_MGU, P3_MDN, P3_FIN, NPH };
struct Args { const float* in[31]; float* out; unsigned char* ws; int ph_lo, ph_hi, li, pad; };

template <class Epi>
__device__ __forceinline__ void run_gemm(Frame& F, const bf16* A, int lda, const bf16* Bt, int K, int nM, int nN, const Epi& E) {
    pg8::Gemm g{A, Bt, K, lda}; pg8::StaticOrder S; S.init(nM, nN, F.G, (int)blockIdx.x, K, lda);
    pg8::gemm_phase<Epi, pg8::StaticOrder, false, true>(F.lds, g, S, E);
}
__device__ __forceinline__ void moe_gemms_gu(Frame& F, gu32* cnt, const bf16* Wgu) {
    int ts[9], cn[8]; moe_offsets(cnt, ts, cn);
    pg8::MoeOrder S; S.init(ts[8], 2 * EFF / 256, F.G, (int)blockIdx.x, 1024, 1024);
#pragma unroll
    for (int j = 0; j < 9; ++j) S.ts[j] = ts[j];
    S.estride = (size_t)2 * EFF * 1024 * 2; S.rowidx = (const int*)(F.ws + WS_ROWIDX);
    pg8::Gemm g{(const bf16*)(F.ws + WS_H), Wgu, 1024, 1024};
    pg8::EpiSwiglu E{(bf16*)(F.ws + MOE_HID), EFF};
    pg8::gemm_phase<pg8::EpiSwiglu, pg8::MoeOrder, true, true>(F.lds, g, S, E);
}
__device__ __forceinline__ void moe_gemms_down(Frame& F, gu32* cnt, const bf16* Wd) {
    int ts[9], cn[8]; moe_offsets(cnt, ts, cn);
    pg8::MoeOrder S; S.init(ts[8], 4, F.G, (int)blockIdx.x, EFF, EFF);
#pragma unroll
    for (int j = 0; j < 9; ++j) S.ts[j] = ts[j];
    S.estride = (size_t)1024 * EFF * 2; S.rowidx = nullptr;
    pg8::Gemm g{(const bf16*)(F.ws + MOE_HID), Wd, EFF, EFF};
    pg8::EpiF32 E{(float*)(F.ws + MOE_Y), 1024};
    pg8::gemm_phase<pg8::EpiF32, pg8::MoeOrder, false, true>(F.lds, g, S, E);
}
__device__ __forceinline__ void attn_phase(Frame& F) {
    const bf16* Q = (const bf16*)(F.ws + MLA_Q); const bf16* KV = (const bf16*)(F.ws + MLA_KV); bf16* O = (bf16*)(F.ws + MLA_O);
    const f32x2* ropem = (const f32x2*)(F.ws + WS_ROPE) + 64 * 64;
    for (int i = 0;; ++i) { const int L = i * F.G + F.vcu; if (L >= 544) break;
        int qrow0, hh, b, nk;
        if (L < 512) { const int qb = L & 15; hh = (L >> 4) & 7; b = L >> 7; qrow0 = NCTX + b * SEQ + qb * 256; nk = TT; }
        else { const int Lc = L - 512; hh = Lc & 7; b = Lc >> 3; qrow0 = b * CTXL; nk = CTXL; }
        att::attn_unit(Q, KV, O, ropem, qrow0, hh, b * CTXL, NCTX + b * SEQ, nk, F.lds); }
}

__global__ void __launch_bounds__(NWAVES * 64, 2) mega_fwd(Args args) {
    extern __shared__ __attribute__((aligned(16))) unsigned char lds[];
    Frame F;
    F.lds = (LAS unsigned char*)lds; F.ws = args.ws;
    F.tid = threadIdx.x; F.lane = F.tid & 63; F.wave = __builtin_amdgcn_readfirstlane(F.tid >> 6);
    F.G = gridDim.x; { const int bx = blockIdx.x; F.vcu = (F.G % 8 == 0) ? (bx % 8) * (F.G / 8) + bx / 8 : bx; }
    F.ctl = (gu32*)(args.ws + WS_CTL);
    for (int u = F.tid; u < (LDS_BYTES - LDSCTL_OFF) / 4; u += NWAVES * 64) ((LAS unsigned*)(F.lds + LDSCTL_OFF))[u] = 0u;
    __syncthreads();
    const int lo = args.ph_lo, hi = args.ph_hi;
    XcdBarrier bar; bar.bar = (unsigned*)(F.ctl + CW_BAR) + args.li * XCD_BAR_WORDS; bar.x = 0; bar.st = (volatile LAS unsigned*)(F.lds + MISC_OFF + 32);
    if (hi - lo > 1) bar = xcd_barrier_post((unsigned*)(F.ctl + CW_BAR) + args.li * XCD_BAR_WORDS, (volatile LAS unsigned*)(F.lds + MISC_OFF + 32));
    const float* const* in = args.in; unsigned char* ws = args.ws;
    float* mod = (float*)(ws + WS_MOD); float* X = (float*)(ws + WS_X); bf16* H = (bf16*)(ws + WS_H); bf16* BIG = (bf16*)(ws + WS_BIG); bf16* MIX = (bf16*)(ws + WS_MIX);
    int* tok_e = (int*)(ws + WS_TOK); float* tok_w = (float*)(tok_e + 2 * NR); int* tok_rank = tok_e + 4 * NR; int* tok_slot = tok_e + 6 * NR;
#ifndef PH_MASK
#define PH_MASK 0xFFFFFFFFFFFFFFFFull
#endif
#define IN(k) ((((PH_MASK) >> (k)) & 1ull) && lo <= (k) && (k) < hi)
#define SEAM(k) do { if ((k) + 1 < hi) xcd_barrier(bar); } while (0)
#define MODP(layer, k) (mod + (size_t)(layer) * 5 * 6144 + (k) * 1024)
#define WB(off) ((const bf16*)(ws + (off)))

    if (IN(P_PRO)) { p0_prologue(F, in); SEAM(P_PRO); }
    if (IN(P0_MOD)) { RowArgs a{}; a.normg = in[6]; a.shift = MODP(0, 0); a.scale = MODP(0, 1); a.row_lo = 0; a.row_hi = NR; rows_phase<false, false, false>(F, a); SEAM(P0_MOD); }
    if (IN(P0_WIN)) { run_gemm(F, H, 1024, WB(W_RETIN), 1024, 68, 32, pg8::EpiBf16<0>{BIG, RET_NIN}); SEAM(P0_WIN); }
    if (IN(P0_PREP)) { ret_prep(F, 0, in[11], in[12]); SEAM(P0_PREP); }
    if (IN(P0_SCAN)) { ret_scan(F, 0, in[11], in[12], true); SEAM(P0_SCAN); }
    if (IN(P0_GATE)) { ret_gate(F, in[13], in[14], 0); SEAM(P0_GATE); }
    if (IN(P0_WO)) { run_gemm(F, MIX, 2048, WB(W_RETO), 2048, 68, 4, pg8::EpiRes{X, MODP(0, 2), 0}); SEAM(P0_WO); }
    if (IN(P0_MOD2)) { RowArgs a{}; a.normg = in[7]; a.shift = MODP(0, 3); a.scale = MODP(0, 4); a.row_lo = 0; a.row_hi = NR; rows_phase<false, false, false>(F, a); SEAM(P0_MOD2); }
    if (IN(P0_GU)) { run_gemm(F, H, 1024, WB(W_FFNGU), 1024, 68, 22, pg8::EpiSwiglu{(bf16*)(ws + FFN_HID), DFF}); SEAM(P0_GU); }
    if (IN(P0_DOWN)) { run_gemm(F, WB(FFN_HID), DFF, WB(W_FFND), DFF, 68, 4, pg8::EpiRes{X, MODP(0, 5), 0}); SEAM(P0_DOWN); }
    if (IN(P1_MOD)) { RowArgs a{}; a.normg = in[6] + 1024; a.shift = MODP(1, 0); a.scale = MODP(1, 1); a.row_lo = 0; a.row_hi = NR; rows_phase<false, false, false>(F, a); SEAM(P1_MOD); }
    if (IN(P1_WD)) { run_gemm(F, H, 1024, WB(W_MLAD), 1024, 68, 3, pg8::EpiF32{(float*)(ws + MLA_CKV), 768}); SEAM(P1_WD); }
    if (IN(P1_ROWS)) { mla_rows(F, in[16], in[17]); SEAM(P1_ROWS); }
    if (IN(P1_UQ)) { run_gemm(F, WB(MLA_CQN), 256, WB(W_UQ), 256, 68, 6, pg8::EpiBf16<0>{(bf16*)(ws + MLA_Q), 1536}); SEAM(P1_UQ); }
    if (IN(P1_UKV)) { run_gemm(F, WB(MLA_CKVN), 256, WB(W_UKV), 256, 68, 8, pg8::EpiBf16<0>{(bf16*)(ws + MLA_KV), KVR_LD}); SEAM(P1_UKV); }
    if (IN(P1_ATT)) { attn_phase(F); SEAM(P1_ATT); }
    if (IN(P1_WO)) { run_gemm(F, WB(MLA_O), 1024, WB(W_MLAO), 1024, 68, 4, pg8::EpiRes{X, MODP(1, 2), 0}); SEAM(P1_WO); }
    if (IN(P1_MOD2)) { RowArgs a{}; a.normg = in[7] + 1024; a.shift = MODP(1, 3); a.scale = MODP(1, 4); a.row_lo = 0; a.row_hi = NR;
                  a.w_router = in[28]; a.tok_e = tok_e; a.tok_wo = tok_w; a.tok_rank = tok_rank; a.cnt = F.ctl + CW_MOECNT; rows_phase<false, true, false>(F, a); SEAM(P1_MOD2); }
    if (IN(P1_LIST)) { moe_lists(F, F.ctl + CW_MOECNT, 0, NR); SEAM(P1_LIST); }
    if (IN(P1_MGU)) { moe_gemms_gu(F, F.ctl + CW_MOECNT, WB(W_MOEGU)); SEAM(P1_MGU); }
    if (IN(P1_MDN)) { moe_gemms_down(F, F.ctl + CW_MOECNT, WB(W_MOED)); SEAM(P1_MDN); }
    if (IN(P2_MOD)) { RowArgs a{}; a.normg = in[6] + 2048; a.shift = MODP(2, 0); a.scale = MODP(2, 1); a.row_lo = 0; a.row_hi = NR;
                  a.gate_prev = MODP(1, 5); a.Y = (const float*)(ws + MOE_Y); a.tok_slot = tok_slot; a.tok_w = tok_w; rows_phase<true, false, false>(F, a); SEAM(P2_MOD); }
    if (IN(P2_WIN)) { run_gemm(F, H, 1024, WB(W_SGUIN), 1024, 68, 24, pg8::EpiBf16<3>{(bf16*)(ws + SGU_UV), 6144}); SEAM(P2_WIN); }
    if (IN(P2_RSTD)) { sgu_rstd(F); SEAM(P2_RSTD); }
    if (IN(P2_SPA)) { sgu_spatial(F, in[22], in[24]); SEAM(P2_SPA); }
    if (IN(P2_WOUT)) { run_gemm(F, WB(SGU_UZ), 3072, WB(W_SGUOUT), 3072, 68, 4, pg8::EpiRes{X, MODP(2, 2), 0}); SEAM(P2_WOUT); }
    if (IN(P2_MOD2)) { RowArgs a{}; a.normg = in[7] + 2048; a.shift = MODP(2, 3); a.scale = MODP(2, 4); a.row_lo = 0; a.row_hi = NR; rows_phase<false, false, false>(F, a); SEAM(P2_MOD2); }
    if (IN(P2_GU)) { run_gemm(F, H, 1024, WB(W_FFNGU + (size_t)2 * DFF * 1024 * 2), 1024, 68, 22, pg8::EpiSwiglu{(bf16*)(ws + FFN_HID), DFF}); SEAM(P2_GU); }
    if (IN(P2_DOWN)) { run_gemm(F, WB(FFN_HID), DFF, WB(W_FFND + (size_t)1024 * DFF * 2), DFF, 68, 4, pg8::EpiRes{X, MODP(2, 5), 0}); SEAM(P2_DOWN); }
    if (IN(P3_MOD)) { RowArgs a{}; a.normg = in[6] + 3072; a.shift = MODP(3, 0); a.scale = MODP(3, 1); a.row_lo = 0; a.row_hi = NR; rows_phase<false, false, false>(F, a); SEAM(P3_MOD); }
    if (IN(P3_WIN)) { run_gemm(F, H, 1024, WB(W_RETIN + (size_t)RET_NIN * 1024 * 2), 1024, 68, 32, pg8::EpiBf16<0>{BIG, RET_NIN}); SEAM(P3_WIN); }
    if (IN(P3_PREP)) { ret_prep(F, 1, in[11], in[12]); SEAM(P3_PREP); }
    if (IN(P3_SCAN)) { ret_scan(F, 1, in[11], in[12], false); SEAM(P3_SCAN); }
    if (IN(P3_GATE)) { ret_gate(F, in[13] + 2048, in[14] + 2048, NCTX); SEAM(P3_GATE); }
    if (IN(P3_WO)) { run_gemm(F, MIX + (size_t)NCTX * 2048, 2048, WB(W_RETO + (size_t)1024 * 2048 * 2), 2048, 64, 4, pg8::EpiRes{X + (size_t)NCTX * 1024, MODP(3, 2), 4}); SEAM(P3_WO); }
    if (IN(P3_MOD2)) { RowArgs a{}; a.normg = in[7] + 3072; a.shift = MODP(3, 3); a.scale = MODP(3, 4); a.row_lo = NCTX; a.row_hi = NR;
                  a.w_router = in[28] + 8192; a.tok_e = tok_e; a.tok_wo = tok_w; a.tok_rank = tok_rank; a.cnt = F.ctl + CW_MOECNT + 512; rows_phase<false, true, false>(F, a); SEAM(P3_MOD2); }
    if (IN(P3_LIST)) { moe_lists(F, F.ctl + CW_MOECNT + 512, NCTX, NR); SEAM(P3_LIST); }
    if (IN(P3_MGU)) { moe_gemms_gu(F, F.ctl + CW_MOECNT + 512, WB(W_MOEGU + (size_t)8 * 2 * EFF * 1024 * 2)); SEAM(P3_MGU); }
    if (IN(P3_MDN)) { moe_gemms_down(F, F.ctl + CW_MOECNT + 512, WB(W_MOED + (size_t)8 * 1024 * EFF * 2)); SEAM(P3_MDN); }
    if (IN(P3_FIN)) { RowArgs a{}; a.normg = in[8]; a.row_lo = NCTX; a.row_hi = NR; a.gate_prev = MODP(3, 5); a.Y = (const float*)(ws + MOE_Y); a.tok_slot = tok_slot; a.tok_w = tok_w; a.out = args.out;
                  rows_phase<true, false, true>(F, a); }
#undef IN
#undef SEAM
#undef MODP
#undef WB
}

#ifndef MK_PER_PHASE
#define MK_PER_PHASE 0
#endif
extern "C" void kernel_launch(void* const* d_in, const int* in_sizes, int n_in, void* d_out, int out_size, void* d_ws, size_t ws_size, hipStream_t stream) {
    static int grid = 0;
    if (grid == 0) {
        if (n_in != 31 || out_size != NLAT * D || ws_size < WS_END) { fprintf(stderr, "kernel_launch: unexpected shapes: n_in %d out %d ws %zu (need %zu)\n", n_in, out_size, ws_size, (size_t)WS_END); grid = -1; return; }
        int dev = 0, cus = 0, per_cu = 0;
        if (hipGetDevice(&dev) != hipSuccess || hipDeviceGetAttribute(&cus, hipDeviceAttributeMultiprocessorCount, dev) != hipSuccess) { grid = -1; return; }
        if (hipFuncSetAttribute((const void*)mega_fwd, hipFuncAttributeMaxDynamicSharedMemorySize, LDS_BYTES) != hipSuccess) { fprintf(stderr, "kernel_launch: hipFuncSetAttribute failed\n"); grid = -1; return; }
        if (hipOccupancyMaxActiveBlocksPerMultiprocessor(&per_cu, (const void*)mega_fwd, NWAVES * 64, LDS_BYTES) != hipSuccess || per_cu < 1)
            fprintf(stderr, "kernel_launch: note: occupancy query reports %d workgroups per CU\n", per_cu);
        (void)hipGetLastError();
        grid = cus;
    }
    if (grid < 0) return;
    if (hipMemsetAsync((char*)d_ws + WS_CTL, 0, CTL_ZERO_BYTES, stream) != hipSuccess) return;
    Args a{};
    for (int i = 0; i < 31; ++i) a.in[i] = (const float*)d_in[i];
    a.out = (float*)d_out; a.ws = (unsigned char*)d_ws; a.pad = 0;
#if MK_PER_PHASE
    for (int p = 0; p < NPH; ++p) { a.ph_lo = p; a.ph_hi = p + 1; a.li = 0; hipLaunchKernelGGL(mega_fwd, dim3(grid), dim3(NWAVES * 64), LDS_BYTES, stream, a); }
#else
    a.ph_lo = 0; a.ph_hi = NPH; a.li = 0; hipLaunchKernelGGL(mega_fwd, dim3(grid), dim3(NWAVES * 64), LDS_BYTES, stream, a);
#endif
    const hipError_t le = hipPeekAtLastError();
    if (le != hipSuccess) fprintf(stderr, "kernel_launch: launch failed: %s\n", hipGetErrorName(le));
}
```

```cpp
#define SWG_NDEFER 5
#include <hip/hip_runtime.h>
#include <cstdio>
#include <cstdint>

namespace pg8 {
#define PG8_LAS __attribute__((address_space(3)))
typedef unsigned short bf16_t;
typedef short bf16x8 __attribute__((ext_vector_type(8)));
typedef float f32x4 __attribute__((ext_vector_type(4)));
typedef float f32x2 __attribute__((ext_vector_type(2)));
typedef unsigned u32x4 __attribute__((ext_vector_type(4)));
typedef unsigned u32x2 __attribute__((ext_vector_type(2)));
constexpr int BM = 256, BK = 64, HALF = 128, HTB = HALF * BK * 2  , STAGE_BYTES = 8 * HTB, NXCD = 8;
#ifndef PG8_WGM
#define PG8_WGM 8
#endif
constexpr int WGM = PG8_WGM;

__host__ __device__ __forceinline__ int lds_byte(int r, int c) { const int st = (r >> 4) * 2 + (c >> 5), rr = r & 15, cc = c & 31, ob = rr * 64 + cc * 2; return st * 1024 + (ob ^ (((ob >> 9) & 1) << 5)); }
__host__ __device__ __forceinline__ void stage_rc(int b, int& R, int& C) { const int st = b / 1024, sb = b % 1024, swz = sb ^ (((sb >> 9) & 1) << 5); R = (st >> 1) * 16 + swz / 64; C = (st & 1) * 32 + (swz % 64) / 2; }
__host__ __device__ __forceinline__ int perm32(int rho) { const int n = rho >> 4, i = rho & 15; return 8 * (i >> 2) + 4 * n + (i & 3); }

#define NDEFER_DEFAULT_ 0
struct Unit { int pm, pn, ks; };
struct Gemm { const bf16_t* A; const bf16_t* Bt; int K, lda; };

struct StaticOrder {
    int nM, nN, nwg, G, c; size_t tA, tB;
    __device__ void init(int nM_, int nN_, int G_, int c_, int K, int lda) { nM = nM_; nN = nN_; nwg = nM * nN; G = G_; c = c_; tA = (size_t)BM * lda * 2; tB = (size_t)BM * K * 2; }
    __device__ bool next(int i, Unit& u) const {
        const long L = (long)i * G + c; if (L >= nwg) return false;
        int wgid = (int)L;
#if !defined(PG8_NOREMAP)
        { const int q = nwg / NXCD, r = nwg % NXCD, xcd = wgid % NXCD, off = wgid / NXCD; wgid = (xcd < r ? xcd * (q + 1) : r * (q + 1) + (xcd - r) * q) + off; }
#endif
        const int nig = WGM * nN, gid = wgid / nig, fm = gid * WGM, gsz = (nM - fm) < WGM ? (nM - fm) : WGM;
        u.pm = fm + ((wgid % nig) % gsz); u.pn = (wgid % nig) / gsz; u.ks = -1; return true;
    }
    __device__ __forceinline__ int nkt(const Unit&) const { return (int)(tB / (BM * 2)) / BK; }
    __device__ __forceinline__ size_t aofs(const Unit& u) const { return (size_t)u.pm * tA; }
    __device__ __forceinline__ size_t bofs(const Unit& u) const { return (size_t)u.pn * tB; }
    __device__ __forceinline__ int arow(const Unit& u, int r) const { return u.pm * BM + r; }
};
struct ResOrder : StaticOrder {
    int nsplit; bool ablk = false;
    __device__ void init2(int G_, int c_, int K, int lda) { init(64, 4, G_, c_, K, lda); nsplit = K / 256; }
    __device__ bool next(int i, Unit& u) const {
        if (StaticOrder::next(i, u)) { u.pm += 4; return true; }
        const long L = (long)i * G + c - nwg; if (L < 0 || L >= 16 * nsplit) return false;
        const int l = (int)L; u.ks = l % nsplit; u.pn = (l / nsplit) & 3; u.pm = l / (4 * nsplit); return true;
    }
    __device__ __forceinline__ int nkt(const Unit& u) const { return u.ks < 0 ? StaticOrder::nkt(u) : 4; }
    __device__ __forceinline__ size_t aofs(const Unit& u) const { return (size_t)u.pm * tA + (u.ks < 0 ? (size_t)0 : (size_t)u.ks * (ablk ? (size_t)4 * BM * BK * 2 : (size_t)512)); }
    __device__ __forceinline__ size_t bofs(const Unit& u) const { return (size_t)u.pn * tB + (u.ks < 0 ? (size_t)0 : (size_t)u.ks * 4 * BM * BK * 2); }
};
struct SguOrder {
    StaticOrder su, sv; int G, c, nwg; size_t dA, dB;
    __device__ bool next(int i, Unit& u) const {
        const long L = (long)i * G + c;
        if (L < su.nwg) { StaticOrder t = su; t.G = 1; t.c = 0; return t.next((int)L, u); }
        if (L >= su.nwg + sv.nwg) return false;
        StaticOrder t = sv; t.G = 1; t.c = 0; t.next((int)(L - su.nwg), u); u.ks = -2; return true;
    }
    __device__ __forceinline__ int nkt(const Unit& u) const { return su.nkt(u); }
    __device__ __forceinline__ size_t aofs(const Unit& u) const { return u.ks == -2 ? dA + sv.aofs(u) : su.aofs(u); }
    __device__ __forceinline__ size_t bofs(const Unit& u) const { return u.ks == -2 ? dB + sv.bofs(u) : su.bofs(u); }
    __device__ __forceinline__ int arow(const Unit& u, int r) const { return 0; }
};
struct MoeOrder : StaticOrder {
    int ts[9]; size_t estride; const int* rowidx;
    __device__ __forceinline__ int expert(int pm) const { int e = 0;
#pragma unroll
        for (int j = 1; j < 8; ++j) e += (pm >= ts[j]) ? 1 : 0; return e; }
    __device__ __forceinline__ size_t bofs(const Unit& u) const { return (size_t)expert(u.pm) * estride + (size_t)u.pn * tB; }
    __device__ __forceinline__ int arow(const Unit& u, int r) const { return rowidx[u.pm * BM + r]; }
};

struct MoeDownOrder : MoeOrder {
    static constexpr int NFULL = 128, KS = 4, KCH = 896;
    __device__ bool next(int i, Unit& u) const {
        const long L = (long)i * G + c; const int nf = nM < NFULL ? nM : NFULL;
#if !defined(MDN_NOXCD)
        if (G == 256 && nf == NFULL) {
            const int x = c & 7, k = c >> 3;
            if (i < 2) { u.pm = i * 64 + x * 8 + (k >> 2); u.pn = k & 3; u.ks = -1; return true; }
            const int pm = nf + ((i - 2) * 8 + x) * 2 + (k >> 4);
            if (pm >= nM) return false;
            u.pm = pm; u.pn = (k >> 2) & 3; u.ks = k & 3; return true;
        }
#endif
        if (L < (long)nf * 4) { u.pm = (int)(L >> 2); u.pn = (int)(L & 3); u.ks = -1; return true; }
        const long l = L - (long)nf * 4; if (l >= (long)(nM - nf) * 4 * KS) return false;
        u.pm = nf + (int)(l / (4 * KS)); u.pn = (int)((l / KS) & 3); u.ks = (int)(l % KS); return true;
    }
    __device__ __forceinline__ int nkt(const Unit& u) const { return u.ks < 0 ? StaticOrder::nkt(u) : KCH / BK; }
    __device__ __forceinline__ size_t aofs(const Unit& u) const { return (size_t)u.pm * tA + (u.ks < 0 ? (size_t)0 : (size_t)u.ks * (KCH / BK) * (BM * BK * 2)); }
    __device__ __forceinline__ size_t bofs(const Unit& u) const { return MoeOrder::bofs(u) + (u.ks < 0 ? (size_t)0 : (size_t)u.ks * (KCH / BK) * (BM * BK * 2)); }
};
__device__ __forceinline__ unsigned cvt_pk_bf16(float lo, float hi) { unsigned r; asm volatile("v_cvt_pk_bf16_f32 %0, %1, %2" : "=v"(r) : "v"(lo), "v"(hi)); return r; }
__device__ __forceinline__ float fast_sigmoid(float x) { return __builtin_amdgcn_rcpf(1.0f + __builtin_amdgcn_exp2f(-1.4426950408889634f * x)); }
__device__ __forceinline__ float gelu_tanh(float x) { constexpr float B = -2.0f * 1.4426950408889634f * 0.7978845608028654f, A = B * 0.044715f;
    const float t = x * __builtin_fmaf(x * x, A, B); return x * __builtin_amdgcn_rcpf(1.0f + __builtin_amdgcn_exp2f(t)); }

struct EpiF32 {
    static constexpr bool PERM = false;
    static constexpr int NDEFER = NDEFER_DEFAULT_;
    float* C; int ldc; float* part; int part_tile0; size_t part_stride;
    __device__ __forceinline__ void operator()(const f32x4 (&acc)[2][2][4][2], const Unit& u, int wr, int wc, int fr, int fq) const {
        const int col0 = u.pn * BM + wc * 32 + 4 * fq; int row0 = u.pm * BM + wr * 64 + fr; float* C = this->C;
        if (u.ks >= 0) { C = part + (size_t)u.ks * part_stride; row0 -= part_tile0 * BM; }
#pragma unroll
        for (int ai = 0; ai < 2; ++ai)
#pragma unroll
            for (int m = 0; m < 4; ++m) { float* rowp = C + (size_t)(row0 + ai * HALF + m * 16) * ldc + col0;
#pragma unroll
                for (int bj = 0; bj < 2; ++bj)
#pragma unroll
                    for (int n = 0; n < 2; ++n) *(f32x4*)(rowp + bj * HALF + n * 16) = acc[ai][bj][m][n]; }
    }
};
template <int ACT  > struct EpiBf16 {
    static constexpr bool PERM = true;
    static constexpr int NDEFER = NDEFER_DEFAULT_;
    bf16_t* O; int ldc; bf16_t* O2 = nullptr; int split_tile = 1 << 30;
    __device__ __forceinline__ void operator()(const f32x4 (&acc)[2][2][4][2], const Unit& u, int wr, int wc, int fr, int fq) const {
        const bool second = u.pn >= split_tile; bf16_t* O = second ? this->O2 : this->O;
        const int row0 = u.pm * BM + wr * 64 + fr, col0 = (second ? u.pn - split_tile : u.pn) * BM + wc * 32 + 8 * fq;
#pragma unroll
        for (int ai = 0; ai < 2; ++ai)
#pragma unroll
            for (int m = 0; m < 4; ++m) { bf16_t* rowp = O + (size_t)(row0 + ai * HALF + m * 16) * ldc + col0;
#pragma unroll
                for (int bj = 0; bj < 2; ++bj) { f32x4 v0 = acc[ai][bj][m][0], v1 = acc[ai][bj][m][1];
                    if (ACT == 3) {
#pragma unroll
                        for (int j = 0; j < 4; ++j) { v0[j] = gelu_tanh(v0[j]); v1[j] = gelu_tanh(v1[j]); } }
                    u32x4 w; w.x = cvt_pk_bf16(v0[0], v0[1]); w.y = cvt_pk_bf16(v0[2], v0[3]); w.z = cvt_pk_bf16(v1[0], v1[1]); w.w = cvt_pk_bf16(v1[2], v1[3]);
#if defined(PG8_NTSTORE)
                    __builtin_nontemporal_store(w, (u32x4*)(rowp + bj * HALF)); } }
#else
                    *(u32x4*)(rowp + bj * HALF) = w; } }
#endif
    }
};
struct EpiVT {
    static constexpr bool PERM = true;
    static constexpr int NDEFER = NDEFER_DEFAULT_;
    bf16_t* O; int ldc; float* ssq; int nr;
    __device__ __forceinline__ void operator()(const f32x4 (&acc)[2][2][4][2], const Unit& u, int wr, int wc, int fr, int fq) const {
        const int row0 = u.pm * BM + wr * 64 + fr, col0 = u.pn * BM + wc * 32 + 8 * fq;
        float sq[2][8];
#pragma unroll
        for (int bj = 0; bj < 2; ++bj)
#pragma unroll
            for (int j = 0; j < 8; ++j) sq[bj][j] = 0.f;
#pragma unroll
        for (int ai = 0; ai < 2; ++ai)
#pragma unroll
            for (int m = 0; m < 4; ++m) { bf16_t* rowp = O + (size_t)(col0 >> 7) * ((size_t)ldc * 128) + (size_t)(row0 + ai * HALF + m * 16) * 128 + (col0 & 127);
#pragma unroll
                for (int bj = 0; bj < 2; ++bj) { f32x4 v0 = acc[ai][bj][m][0], v1 = acc[ai][bj][m][1];
#pragma unroll
                    for (int j = 0; j < 4; ++j) { v0[j] = gelu_tanh(v0[j]); v1[j] = gelu_tanh(v1[j]); sq[bj][j] += v0[j] * v0[j]; sq[bj][4 + j] += v1[j] * v1[j]; }
                    u32x4 w; w.x = cvt_pk_bf16(v0[0], v0[1]); w.y = cvt_pk_bf16(v0[2], v0[3]); w.z = cvt_pk_bf16(v1[0], v1[1]); w.w = cvt_pk_bf16(v1[2], v1[3]);
                    *(u32x4*)(rowp + (size_t)bj * ((size_t)ldc * 128)) = w; } }
#pragma unroll
        for (int bj = 0; bj < 2; ++bj) {
#pragma unroll
            for (int j = 0; j < 8; ++j) { float v = sq[bj][j];
                v += __builtin_bit_cast(float, __builtin_amdgcn_update_dpp(0, __builtin_bit_cast(int, v), 0x128, 0xf, 0xf, false));
                v += __builtin_bit_cast(float, __builtin_amdgcn_update_dpp(0, __builtin_bit_cast(int, v), 0x124, 0xf, 0xf, false));
                v += __builtin_bit_cast(float, __builtin_amdgcn_update_dpp(0, __builtin_bit_cast(int, v), 0x122, 0xf, 0xf, false));
                v += __builtin_bit_cast(float, __builtin_amdgcn_update_dpp(0, __builtin_bit_cast(int, v), 0x121, 0xf, 0xf, false));
                sq[bj][j] = v; }
            if (fr == 0) { float* sp = ssq + (size_t)(2 * u.pm + wr) * nr + col0 + bj * HALF;
                *(f32x4*)sp = (f32x4){sq[bj][0], sq[bj][1], sq[bj][2], sq[bj][3]}; *(f32x4*)(sp + 4) = (f32x4){sq[bj][4], sq[bj][5], sq[bj][6], sq[bj][7]}; } }
    }
};
struct EpiSguIn {
    static constexpr bool PERM = true;
    static constexpr int NDEFER = NDEFER_DEFAULT_;
    EpiBf16<3> eu; EpiVT ev;
    __device__ __forceinline__ void operator()(const f32x4 (&acc)[2][2][4][2], const Unit& u, int wr, int wc, int fr, int fq) const {
        if (u.ks == -2) ev(acc, u, wr, wc, fr, fq); else eu(acc, u, wr, wc, fr, fq);
    }
};
struct EpiQKVG {
    static constexpr bool PERM = true;
#ifndef QKVG_NDEFER
#define QKVG_NDEFER 5
#endif
    static constexpr int NPIECES = 16; static constexpr int NDEFER = QKVG_NDEFER;
    bf16_t* QKV; bf16_t* G; int nr;
    __device__ __forceinline__ void operator()(const f32x4 (&acc)[2][2][4][2], const Unit& u, int wr, int wc, int fr, int fq) const {
        bf16_t* base; int ld; const int pn = u.pn;
        if (pn < 8) { base = QKV + (size_t)pn * nr * 256; ld = 256; }
        else if (pn < 16) { base = QKV + (size_t)nr * 2048 + (size_t)((pn - 8) >> 1) * nr * 512 + ((pn - 8) & 1) * 256; ld = 512; }
        else { base = G + (pn - 16) * 256; ld = 4096; }
        const int row0 = u.pm * BM + wr * 64 + fr, col0 = wc * 32 + 8 * fq;
#pragma unroll
        for (int ai = 0; ai < 2; ++ai)
#pragma unroll
            for (int m = 0; m < 4; ++m) { bf16_t* rowp = base + (size_t)(row0 + ai * HALF + m * 16) * ld + col0;
#pragma unroll
                for (int bj = 0; bj < 2; ++bj) { const f32x4 v0 = acc[ai][bj][m][0], v1 = acc[ai][bj][m][1];
                    u32x4 w; w.x = cvt_pk_bf16(v0[0], v0[1]); w.y = cvt_pk_bf16(v0[2], v0[3]); w.z = cvt_pk_bf16(v1[0], v1[1]); w.w = cvt_pk_bf16(v1[2], v1[3]);
                    *(u32x4*)(rowp + bj * HALF) = w; } }
    }
    __device__ __forceinline__ void split(const f32x4 (&acc)[2][2][4][2], const Unit& u, int wr, int wc, int fr, int fq, u32x4 (&pend)[NDEFER > 0 ? NDEFER : 1], char*& lanebase, int& ldb) const {
        bf16_t* base; int ld; const int pn = u.pn;
        if (pn < 8) { base = QKV + (size_t)pn * nr * 256; ld = 256; }
        else if (pn < 16) { base = QKV + (size_t)nr * 2048 + (size_t)((pn - 8) >> 1) * nr * 512 + ((pn - 8) & 1) * 256; ld = 512; }
        else { base = G + (pn - 16) * 256; ld = 4096; }
        const int row0 = u.pm * BM + wr * 64 + fr, col0 = wc * 32 + 8 * fq;
        lanebase = (char*)(base + (size_t)row0 * ld + col0); ldb = ld;
#pragma unroll
        for (int ai = 0; ai < 2; ++ai)
#pragma unroll
            for (int m = 0; m < 4; ++m) { bf16_t* rowp = base + (size_t)(row0 + ai * HALF + m * 16) * ld + col0;
#pragma unroll
                for (int bj = 0; bj < 2; ++bj) { const f32x4 v0 = acc[ai][bj][m][0], v1 = acc[ai][bj][m][1]; const int i = ai * 8 + m * 2 + bj;
                    u32x4 w; w.x = cvt_pk_bf16(v0[0], v0[1]); w.y = cvt_pk_bf16(v0[2], v0[3]); w.z = cvt_pk_bf16(v1[0], v1[1]); w.w = cvt_pk_bf16(v1[2], v1[3]);
                    if (i >= 16 - NDEFER) pend[i - (16 - NDEFER)] = w; else *(u32x4*)(rowp + bj * HALF) = w; } }
    }
    static __device__ __forceinline__ long defer_off(int i, int ldb) { return ((long)(((i >> 3) * HALF + ((i >> 1) & 3) * 16)) * ldb + (i & 1) * HALF) * 2; }
};
struct EpiY {
    static constexpr bool PERM = true;
    static constexpr int NDEFER = NDEFER_DEFAULT_;
    bf16_t* Y; float* part; int part_tile0; size_t part_stride;
    __device__ __forceinline__ void operator()(const f32x4 (&acc)[2][2][4][2], const Unit& u, int wr, int wc, int fr, int fq) const {
        const int col0 = u.pn * BM + wc * 32 + 8 * fq;
        if (u.ks >= 0) { bf16_t* P = (bf16_t*)part + (size_t)u.ks * part_stride; const int row0 = (u.pm - part_tile0) * BM + wr * 64 + fr;
#pragma unroll
            for (int ai = 0; ai < 2; ++ai)
#pragma unroll
                for (int m = 0; m < 4; ++m) { bf16_t* rowp = P + (size_t)(row0 + ai * HALF + m * 16) * 1024 + col0;
#pragma unroll
                    for (int bj = 0; bj < 2; ++bj) { const f32x4 v0 = acc[ai][bj][m][0], v1 = acc[ai][bj][m][1];
                        u32x4 w; w.x = cvt_pk_bf16(v0[0], v0[1]); w.y = cvt_pk_bf16(v0[2], v0[3]); w.z = cvt_pk_bf16(v1[0], v1[1]); w.w = cvt_pk_bf16(v1[2], v1[3]);
                        *(u32x4*)(rowp + bj * HALF) = w; } }
            return; }
        const int row0 = u.pm * BM + wr * 64 + fr;
#pragma unroll
        for (int ai = 0; ai < 2; ++ai)
#pragma unroll
            for (int m = 0; m < 4; ++m) { bf16_t* rowp = Y + (size_t)(row0 + ai * HALF + m * 16) * 1024 + col0;
#pragma unroll
                for (int bj = 0; bj < 2; ++bj) { const f32x4 v0 = acc[ai][bj][m][0], v1 = acc[ai][bj][m][1];
                    u32x4 w; w.x = cvt_pk_bf16(v0[0], v0[1]); w.y = cvt_pk_bf16(v0[2], v0[3]); w.z = cvt_pk_bf16(v1[0], v1[1]); w.w = cvt_pk_bf16(v1[2], v1[3]);
                    *(u32x4*)(rowp + bj * HALF) = w; } }
    }
};
#ifndef SWG_NDEFER
#define SWG_NDEFER 4
#endif
struct EpiSwigluD {
    static constexpr bool PERM = false;
    static constexpr int NPIECES = 8; static constexpr int NDEFER = SWG_NDEFER;
    bf16_t* O; int ldo;
    template <int FIRST_DEFERRED>
    __device__ __forceinline__ void run(const f32x4 (&acc)[2][2][4][2], const Unit& u, int wr, int wc, int fr, int fq, u32x4* pend, char*& lanebase) const {
        bf16_t* tb = O + ((size_t)u.pm * (ldo / 64) + (size_t)u.pn * 2) * (BM * 64) + (size_t)(wr * 64 + fr + 16 * (fq & 1)) * 64 + wc * 16 + 4 * (fq & 2);
        lanebase = (char*)tb;
#pragma unroll
        for (int ai = 0; ai < 2; ++ai)
#pragma unroll
            for (int mp = 0; mp < 2; ++mp)
#pragma unroll
                for (int bj = 0; bj < 2; ++bj) { u32x2 w[2]; const int i = ai * 4 + mp * 2 + bj;
#pragma unroll
                    for (int q = 0; q < 2; ++q) { const f32x4 g = acc[ai][bj][2 * mp + q][0], uu = acc[ai][bj][2 * mp + q][1]; f32x4 h;
#pragma unroll
                        for (int j = 0; j < 4; ++j) h[j] = g[j] * fast_sigmoid(g[j]) * uu[j];
                        w[q].x = cvt_pk_bf16(h[0], h[1]); w[q].y = cvt_pk_bf16(h[2], h[3]); }
                    const auto rx = __builtin_amdgcn_permlane16_swap(w[0].x, w[1].x, false, false); const auto ry = __builtin_amdgcn_permlane16_swap(w[0].y, w[1].y, false, false);
                    const u32x4 o = (u32x4){rx[0], ry[0], rx[1], ry[1]};
                    if (i >= FIRST_DEFERRED) pend[i - FIRST_DEFERRED] = o; else *(u32x4*)((char*)tb + defer_off(i, 0)) = o; }
    }
    __device__ __forceinline__ void operator()(const f32x4 (&acc)[2][2][4][2], const Unit& u, int wr, int wc, int fr, int fq) const { char* lb; run<NPIECES>(acc, u, wr, wc, fr, fq, nullptr, lb); }
    __device__ __forceinline__ void split(const f32x4 (&acc)[2][2][4][2], const Unit& u, int wr, int wc, int fr, int fq, u32x4 (&pend)[NDEFER > 0 ? NDEFER : 1], char*& lanebase, int& ldb) const {
        ldb = 0; run<NPIECES - NDEFER>(acc, u, wr, wc, fr, fq, pend, lanebase); }
    static __device__ __forceinline__ long defer_off(int i, int) { return ((long)(((i >> 2) * HALF + ((i >> 1) & 1) * 32) * 64) + (long)(i & 1) * (BM * 64)) * 2; }
};
template <class E0, class E1> struct EpiPair {
    static constexpr bool PERM = E0::PERM; static_assert(E0::PERM == E1::PERM, "EpiPair: both epilogues must want the same B staging order");
    static constexpr int NDEFER = NDEFER_DEFAULT_;
    E0 e0; E1 e1;
    __device__ __forceinline__ void operator()(const f32x4 (&acc)[2][2][4][2], const Unit& u, int wr, int wc, int fr, int fq) const {
        if (u.ks == -2) e1(acc, u, wr, wc, fr, fq); else e0(acc, u, wr, wc, fr, fq);
    }
};
template <int MODE>
struct EpiShape {
    static constexpr bool PERM = true;
    static constexpr int NDEFER = NDEFER_DEFAULT_;
    bf16_t* O;
    __device__ __forceinline__ void operator()(const f32x4 (&acc)[2][2][4][2], const Unit& u, int wr, int wc, int fr, int fq) const {
        bf16_t* lb = O + ((size_t)u.pm * 32 + u.pn) * 65536;
        if (MODE == 0 || MODE == 2) lb += (wr * 64 + fr) * 256 + wc * 32 + 8 * fq;
        else if (MODE == 1) lb += (wr * 64 + (fr & ~1)) * 256 + wc * 64 + fq * 16 + (fr & 1) * 8;
        else if (MODE == 3) lb += (wr * 4 + wc) * 8192 + (fr * 4 + fq) * 8;
        else if (MODE == 6) lb = O + ((size_t)u.pm * 256 + wr * 64 + fr) * 8192 + u.pn * 256 + wc * 32 + 8 * fq;
        else lb += (wr * 64 + fr) * 256 + wc * 32 + 8 * fq;
        u32x4 acc5 = {0u, 0u, 0u, 0u};
#pragma unroll
        for (int ai = 0; ai < 2; ++ai)
#pragma unroll
            for (int m = 0; m < 4; ++m)
#pragma unroll
                for (int bj = 0; bj < 2; ++bj) { const f32x4 v0 = acc[ai][bj][m][0], v1 = acc[ai][bj][m][1];
                    u32x4 w; w.x = cvt_pk_bf16(v0[0], v0[1]); w.y = cvt_pk_bf16(v0[2], v0[3]); w.z = cvt_pk_bf16(v1[0], v1[1]); w.w = cvt_pk_bf16(v1[2], v1[3]);
                    if (MODE == 0) *(u32x4*)(lb + (ai * HALF + m * 16) * 256 + bj * HALF) = w;
                    else if (MODE == 1) *(u32x4*)(lb + (ai * HALF + m * 16 + bj) * 256) = w;
                    else if (MODE == 2) *(u32x2*)(lb + (ai * HALF + m * 16) * 256 + bj * HALF) = (u32x2){w.x ^ w.z, w.y ^ w.w};
                    else if (MODE == 3) *(u32x4*)(lb + ((ai * 4 + m) * 2 + bj) * 512) = w;
                    else if (MODE == 6) *(u32x4*)(lb + (size_t)(ai * HALF + m * 16) * 8192 + bj * HALF) = w;
                    else if (MODE == 4) { if (bj == 0) { const f32x4 y0 = acc[ai][1][m][0], y1 = acc[ai][1][m][1]; w.x ^= cvt_pk_bf16(y0[0], y0[1]); w.y ^= cvt_pk_bf16(y0[2], y0[3]); w.z ^= cvt_pk_bf16(y1[0], y1[1]); w.w ^= cvt_pk_bf16(y1[2], y1[3]);
                                          *(u32x4*)(lb + (ai * HALF + m * 16) * 256) = w; } }
                    else { acc5.x ^= w.x; acc5.y ^= w.y; acc5.z ^= w.z; acc5.w ^= w.w; } }
        if (MODE == 5) *(u32x4*)lb = acc5;
    }
};
struct EpiNull {
    static constexpr bool PERM = true;
    static constexpr int NDEFER = NDEFER_DEFAULT_;
    float* sink;
    __device__ __forceinline__ void operator()(const f32x4 (&acc)[2][2][4][2], const Unit& u, int wr, int wc, int fr, int fq) const {
        float s = 0.f;
#pragma unroll
        for (int ai = 0; ai < 2; ++ai)
#pragma unroll
            for (int bj = 0; bj < 2; ++bj)
#pragma unroll
                for (int m = 0; m < 4; ++m)
#pragma unroll
                    for (int n = 0; n < 2; ++n) s += acc[ai][bj][m][n][0] + acc[ai][bj][m][n][1] + acc[ai][bj][m][n][2] + acc[ai][bj][m][n][3];
        if (s == 1.2345e-30f) sink[0] = s;
    }
};
struct EpiRes {
    static constexpr bool PERM = true;
    static constexpr int NDEFER = NDEFER_DEFAULT_;
    bf16_t* X; const float* gate; int tile0;
    float* part;
    __device__ __forceinline__ void operator()(const f32x4 (&acc)[2][2][4][2], const Unit& u, int wr, int wc, int fr, int fq) const {
        const int row0 = u.pm * BM + wr * 64 + fr, col0 = u.pn * BM + wc * 32 + 8 * fq;
        if (u.ks >= 0) {
            bf16_t* P = (bf16_t*)part + (size_t)u.ks * 1024 * 1024;
#pragma unroll
            for (int ai = 0; ai < 2; ++ai)
#pragma unroll
                for (int m = 0; m < 4; ++m) { bf16_t* rowp = P + (size_t)(row0 + ai * HALF + m * 16) * 1024 + col0;
#pragma unroll
                    for (int bj = 0; bj < 2; ++bj) { const f32x4 v0 = acc[ai][bj][m][0], v1 = acc[ai][bj][m][1];
                        u32x4 w; w.x = cvt_pk_bf16(v0[0], v0[1]); w.y = cvt_pk_bf16(v0[2], v0[3]); w.z = cvt_pk_bf16(v1[0], v1[1]); w.w = cvt_pk_bf16(v1[2], v1[3]);
                        *(u32x4*)(rowp + bj * HALF) = w; } }
            return; }
        const int tg = u.pm + tile0, cond = tg < 4 ? 4 : ((tg - 4) >> 4);
        const float* gp = gate + cond * 6144 + col0;
        f32x4 gv[2][2];
#pragma unroll
        for (int bj = 0; bj < 2; ++bj)
#pragma unroll
            for (int n = 0; n < 2; ++n) gv[bj][n] = *(const f32x4*)(gp + bj * HALF + n * 4);
#pragma unroll
        for (int ai = 0; ai < 2; ++ai)
#pragma unroll
            for (int m = 0; m < 4; ++m) { bf16_t* rowp = X + (size_t)(row0 + ai * HALF + m * 16) * 1024 + col0;
#pragma unroll
                for (int bj = 0; bj < 2; ++bj) { u32x4* p = (u32x4*)(rowp + bj * HALF); const u32x4 xr = *p; const f32x4 d0 = gv[bj][0] * acc[ai][bj][m][0], d1 = gv[bj][1] * acc[ai][bj][m][1]; u32x4 o;
                    o.x = cvt_pk_bf16(__builtin_bit_cast(float, xr.x << 16) + d0[0], __builtin_bit_cast(float, xr.x & 0xffff0000u) + d0[1]);
                    o.y = cvt_pk_bf16(__builtin_bit_cast(float, xr.y << 16) + d0[2], __builtin_bit_cast(float, xr.y & 0xffff0000u) + d0[3]);
                    o.z = cvt_pk_bf16(__builtin_bit_cast(float, xr.z << 16) + d1[0], __builtin_bit_cast(float, xr.z & 0xffff0000u) + d1[1]);
                    o.w = cvt_pk_bf16(__builtin_bit_cast(float, xr.w << 16) + d1[2], __builtin_bit_cast(float, xr.w & 0xffff0000u) + d1[3]);
                    *p = o; } }
    }
};
struct EpiSwiglu {
    static constexpr bool PERM = false;
    static constexpr int NDEFER = NDEFER_DEFAULT_;
    bf16_t* O; int ldo; bool blk = false;
    __device__ __forceinline__ void operator()(const f32x4 (&acc)[2][2][4][2], const Unit& u, int wr, int wc, int fr, int fq) const {
        const int row0 = u.pm * BM + wr * 64 + fr, col0 = u.pn * HALF + wc * 16 + 4 * fq;
        if (blk) {
            bf16_t* tb = O + ((size_t)u.pm * (ldo / 64) + (size_t)u.pn * 2) * (BM * 64) + (size_t)(wr * 64 + fr + 16 * (fq & 1)) * 64 + wc * 16 + 4 * (fq & 2);
#pragma unroll
            for (int ai = 0; ai < 2; ++ai)
#pragma unroll
                for (int mp = 0; mp < 2; ++mp)
#pragma unroll
                    for (int bj = 0; bj < 2; ++bj) { u32x2 w[2];
#pragma unroll
                        for (int q = 0; q < 2; ++q) { const f32x4 g = acc[ai][bj][2 * mp + q][0], uu = acc[ai][bj][2 * mp + q][1]; f32x4 h;
#pragma unroll
                            for (int j = 0; j < 4; ++j) h[j] = g[j] * fast_sigmoid(g[j]) * uu[j];
                            w[q].x = cvt_pk_bf16(h[0], h[1]); w[q].y = cvt_pk_bf16(h[2], h[3]); }
                        const auto rx = __builtin_amdgcn_permlane16_swap(w[0].x, w[1].x, false, false); const auto ry = __builtin_amdgcn_permlane16_swap(w[0].y, w[1].y, false, false);
                        *(u32x4*)(tb + (size_t)(ai * HALF + mp * 32) * 64 + (size_t)bj * (BM * 64)) = (u32x4){rx[0], ry[0], rx[1], ry[1]}; }
            return; }
#pragma unroll
        for (int ai = 0; ai < 2; ++ai)
#pragma unroll
            for (int m = 0; m < 4; ++m) { bf16_t* rowp = O + (size_t)(row0 + ai * HALF + m * 16) * ldo + col0;
#pragma unroll
                for (int bj = 0; bj < 2; ++bj) { const f32x4 g = acc[ai][bj][m][0], uu = acc[ai][bj][m][1]; f32x4 h;
#pragma unroll
                    for (int j = 0; j < 4; ++j) h[j] = g[j] * fast_sigmoid(g[j]) * uu[j];
                    u32x2 w; w.x = cvt_pk_bf16(h[0], h[1]); w.y = cvt_pk_bf16(h[2], h[3]);
                    *(u32x2*)(rowp + bj * 64) = w; } }
    }
};

#ifndef PG8_ALIGN
#define PG8_ALIGN true
#endif
template <class Epi, class Sched, bool GATHER = false, bool ALIGN_EPI_ = true, bool ABLK = false, bool BBLK = true>
__device__ __forceinline__ void gemm_phase(PG8_LAS unsigned char* lds, const Gemm g, const Sched& S, const Epi& E) {
    constexpr bool ALIGN_EPI = ALIGN_EPI_ && PG8_ALIGN;
    int tid_ = threadIdx.x; asm volatile("" : "+v"(tid_));
    const int tid = tid_, wid = __builtin_amdgcn_readfirstlane(tid >> 6), lane = tid & 63, wr = wid >> 2, wc = wid & 3, fr = lane & 15, fq = lane >> 4;
    const int K = g.K, lda = g.lda;
    unsigned voffA[2], voffB[2]; int sR[2], sC[2];
#pragma unroll
    for (int i = 0; i < 2; ++i) { int R, C; stage_rc(tid * 16 + i * 8192, R, C); const int Rb = Epi::PERM ? ((R & ~31) + perm32(R & 31)) : R;
        voffA[i] = ABLK ? (unsigned)(R * BK + C) * 2u : (unsigned)(R * lda + C) * 2u; voffB[i] = BBLK ? (unsigned)(Rb * BK + C) * 2u : (unsigned)(Rb * K + C) * 2u; sR[i] = R; sC[i] = C * 2; }
    const size_t kstepA = ABLK ? (size_t)(BM * BK * 2) : (size_t)(BK * 2), kstep = BBLK ? (size_t)(BM * BK * 2) : (size_t)(BK * 2);
    const size_t hstepA = ABLK ? (size_t)(HALF * BK * 2) : (size_t)HALF * lda * 2, hstepB = BBLK ? (size_t)(HALF * BK * 2) : (size_t)HALF * K * 2;
    const unsigned ldsw = (unsigned)wid * 1024u;
    const int aoff = lds_byte(wr * 64 + fr, fq * 8), boff = lds_byte(wc * 32 + fr, fq * 8);
    unsigned ao[2][2], aon[2][2];
#define PG8_SA(b, h) (((b) * 2 + (h)) * HTB)
#define PG8_SB(b, h) ((4 + (b) * 2 + (h)) * HTB)
#define PG8_STAGE(bufoff, gbase, voff) do { _Pragma("unroll") for (int _i = 0; _i < 2; ++_i) \
        __builtin_amdgcn_global_load_lds((const unsigned*)((const char*)(gbase) + (voff)[_i]), (PG8_LAS unsigned*)(lds + (bufoff) + ldsw + _i * 8192), 16, 0, 0); } while (0)
#define PG8_STAGE_A(bufoff, h, ab, OA) do { if constexpr (GATHER) { PG8_STAGE(bufoff, ab, (OA)[h]); } else { PG8_STAGE(bufoff, (ab) + (h) * hstepA, voffA); } } while (0)
#define PG8_GOFFS(dst, uu) do { _Pragma("unroll") for (int _h = 0; _h < 2; ++_h) _Pragma("unroll") for (int _i = 0; _i < 2; ++_i) \
        (dst)[_h][_i] = (unsigned)S.arow(uu, _h * HALF + sR[_i]) * (unsigned)(lda * 2) + (unsigned)sC[_i]; } while (0)
#define PG8_LDA(dst, b, h) do { _Pragma("unroll") for (int m = 0; m < 4; ++m) _Pragma("unroll") for (int k = 0; k < 2; ++k) dst[m][k] = *(const PG8_LAS bf16x8*)(lds + PG8_SA(b, h) + aoff + m * 2048 + k * 1024); } while (0)
#define PG8_LDB(dst, b, h) do { _Pragma("unroll") for (int n = 0; n < 2; ++n) _Pragma("unroll") for (int k = 0; k < 2; ++k) dst[n][k] = *(const PG8_LAS bf16x8*)(lds + PG8_SB(b, h) + boff + n * 2048 + k * 1024); } while (0)
#define PG8_MMA(ai, bj, At, Bt) do { __builtin_amdgcn_s_setprio(1); _Pragma("unroll") for (int m = 0; m < 4; ++m) _Pragma("unroll") for (int n = 0; n < 2; ++n) _Pragma("unroll") for (int k = 0; k < 2; ++k) \
        acc[ai][bj][m][n] = __builtin_amdgcn_mfma_f32_16x16x32_bf16(Bt[n][k], At[m][k], acc[ai][bj][m][n], 0, 0, 0); __builtin_amdgcn_s_setprio(0); } while (0)
#define PG8_WAIT_V(n) asm volatile("s_waitcnt vmcnt(" #n ")" ::: "memory")
#define PG8_WAIT_L(n) asm volatile("s_waitcnt lgkmcnt(" #n ")" ::: "memory")
#define PG8_BAR __builtin_amdgcn_s_barrier()
#define PG8_SCHED __builtin_amdgcn_sched_barrier(0)
    constexpr int ND = Epi::NDEFER;
    u32x4 pend[ND > 0 ? ND : 1]; char* plane = nullptr; int pld = 0, npend = 0, sflag = 0;
#define PG8_WAIT_VS() do { if constexpr (ND > 0) { asm volatile("s_waitcnt vmcnt(9)\n\ts_cmp_gt_i32 %0, 0\n\ts_cbranch_scc1 .Lpg8s%=\n\ts_waitcnt vmcnt(8)\n.Lpg8s%=:" :: "s"(sflag) : "memory", "scc"); sflag = 0; } else PG8_WAIT_V(8); } while (0)
#define PG8_TRICKLE() do { if constexpr (ND > 0) { if (npend > 0) { const int _i = Epi::NPIECES - npend; *(u32x4*)(plane + Epi::defer_off(_i, pld)) = pend[0]; \
        _Pragma("unroll") for (int _k = 0; _k + 1 < ND; ++_k) pend[_k] = pend[_k + 1]; --npend; sflag = 1; } } } while (0)
    Unit cur, nxt; int ui = 0;
    if (!S.next(0, cur)) return;
#if defined(PG8_STAGGER)
    if (S.nwg > 2 * S.G) {
        const unsigned long long t0 = __builtin_amdgcn_s_memrealtime(); const unsigned long long dt = (unsigned long long)(((blockIdx.x >> 3) & 7) * S.nkt(cur) * PG8_STAGGER / 8);
        while (__builtin_amdgcn_s_memrealtime() - t0 < dt) __builtin_amdgcn_s_sleep(8);
    }
#endif
    f32x4 acc[2][2][4][2];
#pragma unroll
    for (int a = 0; a < 2; ++a)
#pragma unroll
        for (int b = 0; b < 2; ++b)
#pragma unroll
            for (int m = 0; m < 4; ++m)
#pragma unroll
                for (int n = 0; n < 2; ++n) acc[a][b][m][n] = (f32x4){0.f, 0.f, 0.f, 0.f};
    bf16x8 At[4][2], B0[2][2], B1[2][2];
    const char* cA = (const char*)g.A + (GATHER ? (size_t)0 : S.aofs(cur)); const char* cB = (const char*)g.Bt + S.bofs(cur);
    if constexpr (GATHER) { PG8_GOFFS(ao, cur);
#pragma unroll
        for (int h = 0; h < 2; ++h)
#pragma unroll
            for (int i = 0; i < 2; ++i) aon[h][i] = ao[h][i]; }
    PG8_STAGE(PG8_SB(0, 0), cB, voffB); PG8_STAGE(PG8_SB(0, 1), cB + hstepB, voffB); PG8_STAGE_A(PG8_SA(0, 0), 0, cA, ao); PG8_STAGE_A(PG8_SA(0, 1), 1, cA, ao);
    if (wr == 1) PG8_BAR;
    PG8_WAIT_V(2); PG8_BAR;
    PG8_STAGE(PG8_SB(1, 0), cB + kstep, voffB); PG8_STAGE_A(PG8_SA(1, 0), 0, cA + kstepA, ao); PG8_STAGE(PG8_SB(1, 1), cB + hstepB + kstep, voffB);
    PG8_WAIT_V(6); PG8_BAR;
    for (;;) {
        const bool has_next = S.next(ui + 1, nxt);
        const char* nA = (GATHER || !has_next) ? cA : (const char*)g.A + S.aofs(nxt); const char* nB = has_next ? (const char*)g.Bt + S.bofs(nxt) : cB;
        const int nt = S.nkt(cur);
        for (int t = 0; t < nt; t += 2) {
            const bool last = (t == nt - 2);
            const char* a1 = cA + (size_t)(t + 1) * kstepA;
            const char* a2 = last ? nA : cA + (size_t)(t + 2) * kstepA; const char* b2 = last ? nB : cB + (size_t)(t + 2) * kstep;
            const char* a3 = a2 + kstepA; const char* b3 = b2 + kstep;
            unsigned o2[2][2];
            if constexpr (GATHER) {
                if (last && has_next) PG8_GOFFS(aon, nxt);
#pragma unroll
                for (int h = 0; h < 2; ++h)
#pragma unroll
                    for (int i = 0; i < 2; ++i) o2[h][i] = last ? aon[h][i] : ao[h][i];
            }
            PG8_LDB(B0, 0, 0); PG8_LDB(B1, 0, 1); PG8_SCHED; PG8_LDA(At, 0, 0); PG8_STAGE_A(PG8_SA(1, 1), 1, a1, ao);
            PG8_WAIT_VS(); PG8_WAIT_L(0); PG8_BAR; PG8_TRICKLE(); PG8_MMA(0, 0, At, B0); PG8_MMA(0, 1, At, B1); PG8_BAR; PG8_SCHED;
            PG8_LDA(At, 0, 1); PG8_STAGE(PG8_SB(0, 0), b2, voffB); PG8_STAGE(PG8_SB(0, 1), b2 + hstepB, voffB); PG8_STAGE_A(PG8_SA(0, 0), 0, a2, o2);
            PG8_WAIT_VS(); PG8_WAIT_L(0); PG8_BAR; PG8_TRICKLE(); PG8_MMA(1, 0, At, B0); PG8_MMA(1, 1, At, B1); PG8_BAR; PG8_SCHED;
            PG8_LDB(B0, 1, 0); PG8_LDB(B1, 1, 1); PG8_SCHED; PG8_LDA(At, 1, 0); PG8_STAGE_A(PG8_SA(0, 1), 1, a2, o2);
            PG8_WAIT_VS(); PG8_WAIT_L(0); PG8_BAR; PG8_TRICKLE(); PG8_MMA(0, 0, At, B0); PG8_MMA(0, 1, At, B1); PG8_BAR; PG8_SCHED;
            PG8_LDA(At, 1, 1); PG8_STAGE(PG8_SB(1, 0), b3, voffB); PG8_STAGE(PG8_SB(1, 1), b3 + hstepB, voffB); PG8_STAGE_A(PG8_SA(1, 0), 0, a3, o2);
            PG8_WAIT_VS(); PG8_WAIT_L(0); PG8_BAR; PG8_TRICKLE(); PG8_MMA(1, 0, At, B0); PG8_MMA(1, 1, At, B1); PG8_BAR; PG8_SCHED;
        }
        if constexpr (ALIGN_EPI) { if (wr == 0) PG8_BAR; }
        if constexpr (ND > 0) {
#pragma unroll
            for (int _f = 0; _f < ND; ++_f) PG8_TRICKLE();
            if (has_next) { E.split(acc, cur, wr, wc, fr, fq, pend, plane, pld); npend = ND; } else E(acc, cur, wr, wc, fr, fq);
        } else E(acc, cur, wr, wc, fr, fq);
        if (!has_next) break;
#pragma unroll
        for (int a = 0; a < 2; ++a)
#pragma unroll
            for (int b = 0; b < 2; ++b)
#pragma unroll
                for (int m = 0; m < 4; ++m)
#pragma unroll
                    for (int n = 0; n < 2; ++n) acc[a][b][m][n] = (f32x4){0.f, 0.f, 0.f, 0.f};
        cur = nxt; cA = nA; cB = nB; ++ui;
        if constexpr (GATHER) {
#pragma unroll
            for (int h = 0; h < 2; ++h)
#pragma unroll
                for (int i = 0; i < 2; ++i) ao[h][i] = aon[h][i]; }
        if constexpr (ALIGN_EPI) { if (wr == 1) PG8_BAR; }
    }
    PG8_WAIT_V(0);
    if constexpr (!ALIGN_EPI) { if (wr == 0) PG8_BAR; }
    PG8_BAR;
#undef PG8_SA
#undef PG8_SB
#undef PG8_STAGE
#undef PG8_STAGE_A
#undef PG8_GOFFS
#undef PG8_LDA
#undef PG8_LDB
#undef PG8_MMA
#undef PG8_WAIT_V
#undef PG8_WAIT_L
#undef PG8_BAR
#undef PG8_SCHED
}
}

constexpr int D = 1024, NB = 4, SEQ = 4096, CTXL = 256, TT = CTXL + SEQ;
constexpr int NCTX = NB * CTXL;
constexpr int NLAT = NB * SEQ;
constexpr int NR = NCTX + NLAT;
constexpr int DFF = 2816, EFF = 3584, NEXP = 8;
constexpr int RET_NIN = 8192;
constexpr int RET_LD = 4096;
constexpr float EPS = 1e-6f;
constexpr int MOE_MAXROWS = 36864;

constexpr size_t MiB = 1u << 20;
constexpr size_t WS_CTL = 0, CTL_ZERO_BYTES = 1 * MiB;
constexpr size_t WS_MOD = 1 * MiB;
constexpr size_t WS_TOK = 2 * MiB;
constexpr size_t WS_ROWIDX = 3 * MiB;
constexpr size_t WS_CNTW = 3 * MiB + 512 * 1024;
constexpr size_t WS_RSTD = 4 * MiB;
constexpr size_t WS_WSB = 5 * MiB;
constexpr size_t WS_W = 6 * MiB;
constexpr size_t W_RETIN = WS_W;
constexpr size_t W_RETO = W_RETIN + 32 * MiB;
constexpr size_t W_MLAD = W_RETO + 8 * MiB;
constexpr size_t W_UQ = W_MLAD + 2 * MiB;
constexpr size_t W_UKV = W_UQ + 1 * MiB;
constexpr size_t W_MLAO = W_UKV + 1 * MiB;
constexpr size_t W_SGUIN = W_MLAO + 2 * MiB;
constexpr size_t W_SGUOUT = W_SGUIN + 12 * MiB;
constexpr size_t W_FFNGU = W_SGUOUT + 6 * MiB;
constexpr size_t W_FFND = W_FFNGU + 22 * MiB;
constexpr size_t W_MOEGU = W_FFND + 11 * MiB;
constexpr size_t W_MOED = W_MOEGU + 224 * MiB;
constexpr size_t WS_X = W_MOED + 112 * MiB;
constexpr size_t WS_H = WS_X + 68 * MiB;
constexpr size_t WS_BIG = WS_H + 34 * MiB;
constexpr size_t WS_PREP = WS_BIG + 272 * MiB;
constexpr size_t WS_OFB = WS_PREP + 170 * MiB;
constexpr size_t WS_MIX = WS_OFB + 136 * MiB;
constexpr size_t WS_END = WS_MIX + 68 * MiB;
constexpr size_t PREP_KT = WS_PREP, PREP_QR = PREP_KT + 34 * MiB, PREP_P = PREP_QR + 34 * MiB;
constexpr size_t PREP_KTF = WS_PREP, PREP_KTB = PREP_KTF + 34 * MiB, PREP_VT = PREP_KTB + 34 * MiB, PREP_PF = PREP_VT + 68 * MiB, PREP_PB = PREP_PF + 17 * MiB;
constexpr size_t RET_QKV = WS_BIG, RET_G = WS_BIG + 136 * MiB;
constexpr size_t MLA_CKV = WS_BIG;
constexpr size_t MLA_CQN = MLA_CKV + 52 * MiB;
constexpr size_t MLA_CKVN = MLA_CQN + 9 * MiB;
constexpr size_t MLA_KR = MLA_CKVN + 9 * MiB;
constexpr size_t MLA_Q = MLA_KR + 3 * MiB;
constexpr int KVR_LD = 2112;
constexpr size_t MLA_KV = MLA_Q + 52 * MiB;
constexpr size_t MLA_O = MLA_KV + 71 * MiB;
static_assert(MLA_O + 34 * MiB <= WS_PREP, "MLA map");
constexpr size_t MOE_HID = WS_BIG;
constexpr size_t MOE_Y = WS_PREP;
constexpr size_t SGU_UV = WS_BIG;
constexpr size_t SGU_VT = SGU_UV + 104 * MiB;
constexpr size_t SGU_SSQ = WS_MIX;
constexpr size_t SGU_UZ = WS_PREP;
constexpr size_t FFN_HID = WS_BIG;
constexpr int CW_BAR = 4096;
constexpr int CW_XQ = 8192;
constexpr int CW_MOECNT = 16384;

constexpr int LDS_BYTES = 147456;
constexpr int LDSCTL_OFF = LDS_BYTES - 1024, MISC_OFF = LDSCTL_OFF + 320;
constexpr int NWAVES = 8;

#define GAS __attribute__((address_space(1)))
#define LAS __attribute__((address_space(3)))
typedef unsigned short bf16;
typedef unsigned v4u __attribute__((ext_vector_type(4)));
typedef unsigned v2u __attribute__((ext_vector_type(2)));
typedef float f32x4 __attribute__((ext_vector_type(4)));
typedef float f32x2 __attribute__((ext_vector_type(2)));
typedef short bf16x8 __attribute__((ext_vector_type(8)));
typedef GAS unsigned gu32;
#define RLX_AGENT __ATOMIC_RELAXED, __HIP_MEMORY_SCOPE_AGENT
#define LDS_WAIT() asm volatile("s_waitcnt lgkmcnt(0)" ::: "memory")
#define VM_WAIT() asm volatile("s_waitcnt vmcnt(0)" ::: "memory")
__device__ __forceinline__ unsigned f2bf(float f) { unsigned u = __builtin_bit_cast(unsigned, f); return (u + 0x7fffu + ((u >> 16) & 1u)) >> 16; }
__device__ __forceinline__ unsigned pk2(float lo, float hi) { return f2bf(lo) | (f2bf(hi) << 16); }
__device__ __forceinline__ float bf2f(unsigned short v) { return __builtin_bit_cast(float, (unsigned)v << 16); }
__device__ __forceinline__ float bflo(unsigned w) { return __builtin_bit_cast(float, w << 16); }
__device__ __forceinline__ float bfhi(unsigned w) { return __builtin_bit_cast(float, w & 0xffff0000u); }
__device__ __forceinline__ float sigmoidf_(float x) { return 1.0f / (1.0f + __expf(-x)); }

#define XB_TMO      128
#define XB_XCNT(j)  (256  + 64 * (j))
#define XB_XSUB(j)  (1280 + 64 * (j))
#define XB_XGEN(j)  (2304 + 64 * (j))
#define XB_TOP      3328
#define XB_TOPGEN   3392
#define XCD_BAR_WORDS 3456
#define XB_SPIN_CAP (1u << 18)

__device__ __forceinline__ unsigned xb_ld(unsigned* p)              { return __hip_atomic_load(p, __ATOMIC_RELAXED, __HIP_MEMORY_SCOPE_AGENT); }
__device__ __forceinline__ unsigned xb_add(unsigned* p, unsigned v) { return __hip_atomic_fetch_add(p, v, __ATOMIC_RELAXED, __HIP_MEMORY_SCOPE_AGENT); }
__device__ __forceinline__ unsigned xb_xcc_id() { return (unsigned)__builtin_amdgcn_s_getreg((3 << 11) | 20) & 0xFu; }
#define XB_SPIN(cond, bar) do { unsigned _sp = 0; while (cond) { __builtin_amdgcn_s_sleep(1); \
    if ((++_sp & 255u) == 0u) { if (xb_ld(&(bar)[XB_TMO])) break; if (_sp > XB_SPIN_CAP) { atomicAdd(&(bar)[XB_TMO], 1u); break; } } } } while (0)

struct XcdBarrier {
    unsigned* bar; unsigned x;
    volatile LAS unsigned* st;
};
__device__ __forceinline__ XcdBarrier xcd_barrier_post(unsigned* bar, volatile LAS unsigned* st) {
    XcdBarrier b; b.bar = bar; b.x = xb_xcc_id(); b.st = st;
    if (threadIdx.x == 0) (void)xb_add(&bar[XB_XCNT(b.x)], 1u);
    return b;
}
__device__ __forceinline__ void xcd_barrier_complete(unsigned* bar, unsigned x, unsigned& nloc, unsigned& nx) {
    const unsigned G = gridDim.x * gridDim.y * gridDim.z;
    unsigned sum, cnt, mine, sp = 0u;
    for (;;) {
        sum = 0u; cnt = 0u; mine = 0u;
#pragma unroll
        for (unsigned j = 0; j < 16; ++j) { const unsigned c = xb_ld(&bar[XB_XCNT(j)]); sum += c; cnt += (c > 0u) ? 1u : 0u; mine = (j == x) ? c : mine; }
        if (sum == G) break;
        __builtin_amdgcn_s_sleep(1);
        if ((++sp & 255u) == 0u) { if (xb_ld(&bar[XB_TMO])) break; if (sp > XB_SPIN_CAP) { atomicAdd(&bar[XB_TMO], 1u); break; } }
    }
    nloc = mine > 0u ? mine : 1u; nx = cnt > 0u ? cnt : 1u;
}
__device__ __forceinline__ void xcd_barrier(const XcdBarrier& b) {
    asm volatile("s_waitcnt vmcnt(0)" ::: "memory");
    __syncthreads();
    if (threadIdx.x == 0) {
        unsigned* bar = b.bar;
        __builtin_amdgcn_s_waitcnt(0);
        unsigned nloc = b.st[0], nx = b.st[1];
        if (nloc == 0u) { xcd_barrier_complete(bar, b.x, nloc, nx); b.st[0] = nloc; b.st[1] = nx; }
        const unsigned old = xb_add(&bar[XB_XSUB(b.x)], 1u);
        const unsigned gen = old / nloc;
        if (old + 1u == (gen + 1u) * nloc) {
            __builtin_amdgcn_fence(__ATOMIC_RELEASE, "agent");
            asm volatile("s_waitcnt vmcnt(0)" ::: "memory");
            const unsigned og = xb_add(&bar[XB_TOP], 1u);
            const unsigned tg = og / nx;
            if (og + 1u == (tg + 1u) * nx) xb_add(&bar[XB_TOPGEN], 1u);
            else XB_SPIN(xb_ld(&bar[XB_TOPGEN]) == tg, bar);
            __builtin_amdgcn_fence(__ATOMIC_ACQUIRE, "agent");
            xb_add(&bar[XB_XGEN(b.x)], 1u);
            asm volatile("s_waitcnt vmcnt(0)" ::: "memory");
        } else {
            XB_SPIN(xb_ld(&bar[XB_XGEN(b.x)]) == gen, bar);
            __builtin_amdgcn_fence(__ATOMIC_ACQUIRE, "agent");
            asm volatile("s_waitcnt vmcnt(0)" ::: "memory");
        }
    }
    __syncthreads();
}

struct Frame {
    LAS unsigned char* lds;
    gu32* ctl;
    unsigned char* ws;
    int tid, lane, wave;
    int vcu, G;
    const float* const* in;
};
__device__ __forceinline__ float row16_sum(float v) {
    v += __builtin_bit_cast(float, __builtin_amdgcn_update_dpp(0, __builtin_bit_cast(int, v), 0x128, 0xf, 0xf, false));
    v += __builtin_bit_cast(float, __builtin_amdgcn_update_dpp(0, __builtin_bit_cast(int, v), 0x124, 0xf, 0xf, false));
    v += __builtin_bit_cast(float, __builtin_amdgcn_update_dpp(0, __builtin_bit_cast(int, v), 0x122, 0xf, 0xf, false));
    v += __builtin_bit_cast(float, __builtin_amdgcn_update_dpp(0, __builtin_bit_cast(int, v), 0x121, 0xf, 0xf, false));
    return v;
}
__device__ __forceinline__ float wave_sum(float v) {
    v = row16_sum(v);
    v += __shfl_xor(v, 16); v += __shfl_xor(v, 32);
    return v;
}
__device__ __forceinline__ int row_cond(int row) { return row < NCTX ? 4 : ((row - NCTX) >> 12); }

enum { MAP_ID = 0, MAP_GU = 1, MAP_PAD = 2 };
template <int MAP, bool BLK>
__device__ __forceinline__ void tr_item(const float* W, int Nsrc, int K, bf16* WT, int Fdim, LAS float* scr, int item, int nblk, int lane) {
    const int kb = item / nblk, nb = item % nblk, k0 = 64 * kb, n0 = 64 * nb;
    const int q = lane & 15, r4 = lane >> 4; int sc, lc;
    if (MAP == MAP_GU) { const int seg = q >> 3, cl = (q & 7) * 4; sc = seg * Fdim + (n0 >> 1) + cl; lc = (cl >> 4) * 32 + seg * 16 + (cl & 15); }
    else { sc = n0 + 4 * q; lc = 4 * q; }
    const bool valid = (MAP != MAP_PAD) || (sc < Nsrc);
    const float* src = W + (size_t)(k0 + r4) * Nsrc + sc;
    f32x4 v[16];
#pragma unroll
    for (int i = 0; i < 16; ++i) v[i] = valid ? __builtin_nontemporal_load((const f32x4*)(src + (size_t)(4 * i) * Nsrc)) : (f32x4){0.f, 0.f, 0.f, 0.f};
#pragma unroll
    for (int i = 0; i < 16; ++i) { LAS float* d = scr + (4 * i + r4) * 65 + lc; d[0] = v[i].x; d[1] = v[i].y; d[2] = v[i].z; d[3] = v[i].w; }
    LDS_WAIT(); asm volatile("" ::: "memory");
    const int c = lane & 7;
#pragma unroll
    for (int j = 0; j < 8; ++j) { const int n = (lane >> 3) + 8 * j; const LAS float* s = scr + (8 * c) * 65 + n;
        v4u o; o.x = pk2(s[0 * 65], s[1 * 65]); o.y = pk2(s[2 * 65], s[3 * 65]); o.z = pk2(s[4 * 65], s[5 * 65]); o.w = pk2(s[6 * 65], s[7 * 65]);
        const int nn = n0 + n;
        bf16* dst = BLK ? WT + ((size_t)(nn >> 8) * (K >> 6) + (k0 >> 6)) * 16384 + (size_t)(nn & 255) * 64 + 8 * c : WT + (size_t)nn * K + k0 + 8 * c;
        *(GAS v4u*)dst = o; }
    LDS_WAIT(); asm volatile("" ::: "memory");
}
template <int MAP, bool BLK = true>
__device__ __forceinline__ void conv_job(Frame& F, const float* W, int Nsrc, int K, bf16* WT, int Ndst, int Fdim, int nmat) {
    LAS float* scr = (LAS float*)(F.lds + F.wave * 17408);
    const int gw = F.vcu * NWAVES + F.wave, NGW = F.G * NWAVES, nblk = Ndst / 64, per = (K / 64) * nblk, nitems = per * nmat;
    for (int it = gw; it < nitems; it += NGW) { const int mat = it / per, loc = it - mat * per;
        tr_item<MAP, BLK>(W + (size_t)mat * K * Nsrc, Nsrc, K, WT + (size_t)mat * Ndst * K, Fdim, scr, loc, nblk, F.lane); }
}
constexpr size_t WS_ROPE = WS_WSB + 512 * 1024;
template <class InT> __device__ __forceinline__ void p0_prologue(Frame& F, const InT& in) {
    unsigned char* ws = F.ws;
    conv_job<MAP_ID>(F, in[9], RET_NIN, 1024, (bf16*)(ws + W_RETIN), RET_NIN, 0, 2);
    conv_job<MAP_ID>(F, in[10], 1024, 2048, (bf16*)(ws + W_RETO), 1024, 0, 2);
    conv_job<MAP_PAD>(F, in[15], 576, 1024, (bf16*)(ws + W_MLAD), 768, 0, 1);
    conv_job<MAP_ID>(F, in[18], 1536, 256, (bf16*)(ws + W_UQ), 1536, 0, 1);
    conv_job<MAP_ID>(F, in[19], 2048, 256, (bf16*)(ws + W_UKV), 2048, 0, 1);
    conv_job<MAP_ID>(F, in[20], 1024, 1024, (bf16*)(ws + W_MLAO), 1024, 0, 1);
    conv_job<MAP_ID, false>(F, in[21], 6144, 1024, (bf16*)(ws + W_SGUIN), 6144, 0, 1);
    conv_job<MAP_ID>(F, in[25], 1024, 3072, (bf16*)(ws + W_SGUOUT), 1024, 0, 1);
    conv_job<MAP_GU>(F, in[26], 2 * DFF, 1024, (bf16*)(ws + W_FFNGU), 2 * DFF, DFF, 2);
    conv_job<MAP_ID>(F, in[27], 1024, DFF, (bf16*)(ws + W_FFND), 1024, 0, 2);
    conv_job<MAP_GU>(F, in[29], 2 * EFF, 1024, (bf16*)(ws + W_MOEGU), 2 * EFF, EFF, 16);
    conv_job<MAP_ID>(F, in[30], 1024, EFF, (bf16*)(ws + W_MOED), 1024, 0, 16);
    const size_t gt = (size_t)blockIdx.x * 512 + F.tid, NT = (size_t)F.G * 512;
    { const f32x4* s0 = (const f32x4*)in[2]; const f32x4* s1 = (const f32x4*)in[0]; v2u* d = (v2u*)(ws + WS_X);
      const size_t n0 = (size_t)NCTX * D / 4, n1 = (size_t)NLAT * D / 4;
      for (size_t i = gt; i < n0 + n1; i += NT) { const f32x4 v = (i < n0) ? s0[i] : s1[i - n0]; d[i] = (v2u){pk2(v.x, v.y), pk2(v.z, v.w)}; } }
    { const float* s = in[23]; bf16* d = (bf16*)(ws + WS_WSB); for (size_t i = gt; i < 8 * 128 * 128; i += NT) d[i] = (bf16)f2bf(s[i]); }
    { f32x2* rr = (f32x2*)(ws + WS_ROPE); f32x2* rm = rr + 64 * 64;
      for (size_t i = gt; i < 64 * 64 + 64 * 16; i += NT) {
          if (i < 64 * 64) { const int pos = (int)i >> 6, fi = (int)i & 63; const float inv = powf(10000.0f, -(float)(2 * fi) / 128.0f); const float a = (float)pos * inv; rr[i] = (f32x2){cosf(a), sinf(a)}; }
          else { const int k = (int)i - 64 * 64, pos = k >> 4, fi = k & 15; const float inv = powf(10000.0f, -(float)(2 * fi) / 32.0f); const float a = (float)pos * inv; rm[k] = (f32x2){cosf(a), sinf(a)}; } } }
    __syncthreads();
    LAS float* sc = (LAS float*)F.lds;
    LAS float* red = (LAS float*)(F.lds + 20480);
    for (int i = F.tid; i < 5 * 1024; i += 512) { const int cond = i >> 10, k = i & 1023; const float v = cond < 4 ? in[1][cond * 1024 + k] : in[3][k]; sc[i] = v * sigmoidf_(v); }
    __syncthreads();
    float* mod = (float*)(ws + WS_MOD);
    for (int item = blockIdx.x; item < 4 * 96; item += F.G) {
        const int layer = item / 96, n0 = (item % 96) * 64, cg = F.tid & 15, ks = F.tid >> 4;
        float acc[5][4];
#pragma unroll
        for (int a = 0; a < 5; ++a)
#pragma unroll
            for (int q = 0; q < 4; ++q) acc[a][q] = 0.f;
        const float* w = in[4] + (size_t)layer * 1024 * 6144 + n0 + cg * 4;
#pragma unroll 4
        for (int j = 0; j < 32; ++j) { const int k = ks + 32 * j; const f32x4 wv = *(const f32x4*)(w + (size_t)k * 6144);
#pragma unroll
            for (int a = 0; a < 5; ++a) { const float s = sc[a * 1024 + k]; acc[a][0] += s * wv.x; acc[a][1] += s * wv.y; acc[a][2] += s * wv.z; acc[a][3] += s * wv.w; } }
#pragma unroll
        for (int a = 0; a < 5; ++a)
#pragma unroll
            for (int q = 0; q < 4; ++q) red[(ks * 5 + a) * 64 + cg * 4 + q] = acc[a][q];
        __syncthreads();
        if (F.tid < 320) { const int a = F.tid >> 6, col = F.tid & 63; float s = 0.f;
            for (int k2 = 0; k2 < 32; ++k2) s += red[(k2 * 5 + a) * 64 + col];
            mod[((size_t)layer * 5 + a) * 6144 + n0 + col] = s + in[5][layer * 6144 + n0 + col]; }
        __syncthreads();
    }
}

struct RowArgs {
    const float* normg;
    const float* shift;
    const float* scale;
    const float* gate_prev; const bf16* Y; const int* tok_slot; const float* tok_w;
    const float* w_router; int* tok_e; float* tok_wo; int* tok_rank; gu32* cnt;
    float* out;
    int row_lo, row_hi;
    int ctx_nsplit; const float* ctx_gate;
};
template <bool COMBINE, bool ROUTE, bool FINAL>
__device__ __forceinline__ void rows_phase(Frame& F, const RowArgs& a) {
    const int gw = F.vcu * NWAVES + F.wave, NGW = F.G * NWAVES, lane = F.lane;
    bf16* X = (bf16*)(F.ws + WS_X); bf16* H = (bf16*)(F.ws + WS_H);
    volatile LAS int* lcnt = (volatile LAS int*)(F.lds + LDSCTL_OFF);
    if (ROUTE) { if (F.tid < 64) lcnt[F.tid] = 0; __syncthreads(); }
    f32x4 ng[4];
#pragma unroll
    for (int j = 0; j < 4; ++j) ng[j] = *(const f32x4*)(a.normg + 4 * lane + 256 * j);
    for (int row = a.row_lo + gw; row < a.row_hi; row += NGW) {
        const int cond = row_cond(row);
        f32x4 v[4]; bf16* xr = X + (size_t)row * D + 4 * lane;
#pragma unroll
        for (int j = 0; j < 4; ++j) { const v2u xw = *(const v2u*)(xr + 256 * j); v[j] = (f32x4){bflo(xw.x), bfhi(xw.x), bflo(xw.y), bfhi(xw.y)}; }
#define ROWS_STORE_X(j_) (*(v2u*)(xr + 256 * (j_)) = (v2u){pk2(v[j_].x, v[j_].y), pk2(v[j_].z, v[j_].w)})
        if (a.ctx_nsplit > 0 && row < NCTX) {
            const bf16* pp = (const bf16*)(F.ws + WS_OFB) + (size_t)row * D + 4 * lane; const float* gp = a.ctx_gate + 4 * 6144 + 4 * lane;
#pragma unroll
            for (int j = 0; j < 4; ++j) { f32x4 s = (f32x4){0.f, 0.f, 0.f, 0.f};
                for (int ks = 0; ks < a.ctx_nsplit; ++ks) { const v2u r = *(const v2u*)(pp + (size_t)ks * 1024 * 1024 + 256 * j); s = s + (f32x4){bflo(r.x), bfhi(r.x), bflo(r.y), bfhi(r.y)}; }
                v[j] = v[j] + *(const f32x4*)(gp + 256 * j) * s; ROWS_STORE_X(j); v[j] = (f32x4){bf2f((unsigned short)f2bf(v[j].x)), bf2f((unsigned short)f2bf(v[j].y)), bf2f((unsigned short)f2bf(v[j].z)), bf2f((unsigned short)f2bf(v[j].w))}; }
        }
        if (COMBINE) {
            const int s1 = a.tok_slot[row * 2], s2 = a.tok_slot[row * 2 + 1]; const float w1 = a.tok_w[row * 2], w2 = a.tok_w[row * 2 + 1];
            const float* gp = a.gate_prev + cond * 6144 + 4 * lane;
            const bool sp1 = s1 >= 32768, sp2 = s2 >= 32768; const bf16* YP = (const bf16*)(F.ws + WS_OFB);
            const bf16* yp1 = YP + (size_t)(sp1 ? s1 - 32768 : 0) * D + 4 * lane; const bf16* yp2 = YP + (size_t)(sp2 ? s2 - 32768 : 0) * D + 4 * lane;
            const bf16* yb1 = a.Y + (size_t)(sp1 ? 0 : s1) * D + 4 * lane; const bf16* yb2 = a.Y + (size_t)(sp2 ? 0 : s2) * D + 4 * lane;
#pragma unroll
            for (int j = 0; j < 4; ++j) { f32x4 p, q; const f32x4 g = *(const f32x4*)(gp + 256 * j);
                if (sp1) { p = (f32x4){0.f, 0.f, 0.f, 0.f}; for (int ks = 0; ks < 4; ++ks) { const v2u r = *(const v2u*)(yp1 + (size_t)ks * 4096 * 1024 + 256 * j); p = p + (f32x4){bflo(r.x), bfhi(r.x), bflo(r.y), bfhi(r.y)}; } }
                else { const v2u r = *(const v2u*)(yb1 + 256 * j); p = (f32x4){bflo(r.x), bfhi(r.x), bflo(r.y), bfhi(r.y)}; }
                if (sp2) { q = (f32x4){0.f, 0.f, 0.f, 0.f}; for (int ks = 0; ks < 4; ++ks) { const v2u r = *(const v2u*)(yp2 + (size_t)ks * 4096 * 1024 + 256 * j); q = q + (f32x4){bflo(r.x), bfhi(r.x), bflo(r.y), bfhi(r.y)}; } }
                else { const v2u r = *(const v2u*)(yb2 + 256 * j); q = (f32x4){bflo(r.x), bfhi(r.x), bflo(r.y), bfhi(r.y)}; }
                v[j] = v[j] + g * (p * w1 + q * w2); if (!FINAL) { ROWS_STORE_X(j); v[j] = (f32x4){bf2f((unsigned short)f2bf(v[j].x)), bf2f((unsigned short)f2bf(v[j].y)), bf2f((unsigned short)f2bf(v[j].z)), bf2f((unsigned short)f2bf(v[j].w))}; } }
        }
        float ss = 0.f;
#pragma unroll
        for (int j = 0; j < 4; ++j) ss += (v[j].x * v[j].x + v[j].y * v[j].y) + (v[j].z * v[j].z + v[j].w * v[j].w);
        const float rstd = 1.0f / sqrtf(wave_sum(ss) * (1.0f / D) + EPS);
        if (FINAL) {
            float* o = a.out + (size_t)(row - NCTX) * D + 4 * lane;
#pragma unroll
            for (int j = 0; j < 4; ++j) *(f32x4*)(o + 256 * j) = v[j] * rstd * ng[j];
        } else {
            const float* sh = a.shift + cond * 6144 + 4 * lane; const float* scp = a.scale + cond * 6144 + 4 * lane;
            f32x4 h[4];
#pragma unroll
            for (int j = 0; j < 4; ++j) { const f32x4 s = *(const f32x4*)(sh + 256 * j), c1 = *(const f32x4*)(scp + 256 * j); h[j] = (v[j] * rstd * ng[j]) * (c1 + 1.0f) + s; }
            bf16* hr = H + (size_t)row * D + 4 * lane;
#pragma unroll
            for (int j = 0; j < 4; ++j) { v2u w; w.x = pk2(h[j].x, h[j].y); w.y = pk2(h[j].z, h[j].w); *(v2u*)(hr + 256 * j) = w; }
            if (ROUTE) {
                float lg[8];
#pragma unroll
                for (int e = 0; e < 8; ++e) lg[e] = 0.f;
#pragma unroll
                for (int j = 0; j < 4; ++j)
#pragma unroll
                    for (int q = 0; q < 4; ++q) { const float hv = h[j][q]; const float* wr = a.w_router + (size_t)(4 * lane + 256 * j + q) * 8; const f32x4 w0 = *(const f32x4*)wr, w1 = *(const f32x4*)(wr + 4);
                        lg[0] += hv * w0.x; lg[1] += hv * w0.y; lg[2] += hv * w0.z; lg[3] += hv * w0.w; lg[4] += hv * w1.x; lg[5] += hv * w1.y; lg[6] += hv * w1.z; lg[7] += hv * w1.w; }
#pragma unroll
                for (int e = 0; e < 8; ++e) lg[e] = wave_sum(lg[e]);
                int i1 = 0; float v1 = lg[0];
#pragma unroll
                for (int e = 1; e < 8; ++e) if (lg[e] > v1) { v1 = lg[e]; i1 = e; }
                int i2 = -1; float v2 = -3.0e38f;
#pragma unroll
                for (int e = 0; e < 8; ++e) if (e != i1 && lg[e] > v2) { v2 = lg[e]; i2 = e; }
                const float e2 = __expf(v2 - v1), w1 = 1.0f / (1.0f + e2), w2 = e2 * w1;
                if (lane == 0) { const int r1 = lcnt[F.wave * 8 + i1]; lcnt[F.wave * 8 + i1] = r1 + 1; const int r2 = lcnt[F.wave * 8 + i2]; lcnt[F.wave * 8 + i2] = r2 + 1;
                    a.tok_e[row * 2] = i1; a.tok_e[row * 2 + 1] = i2; a.tok_wo[row * 2] = w1; a.tok_wo[row * 2 + 1] = w2; a.tok_rank[row * 2] = r1; a.tok_rank[row * 2 + 1] = r2; }
            }
        }
    }
    if (ROUTE) {
        __syncthreads();
        if (F.tid < 64) { int* cntw = (int*)(F.ws + WS_CNTW); cntw[(F.vcu * NWAVES + (F.tid >> 3)) * 8 + (F.tid & 7)] = lcnt[F.tid]; }
        if (F.tid < 8) { int s = 0; for (int wv = 0; wv < 8; ++wv) s += lcnt[wv * 8 + F.tid]; (void)__hip_atomic_fetch_add(a.cnt + 64 * F.tid, (unsigned)s, RLX_AGENT); }
    }
}
__device__ __forceinline__ void moe_offsets(gu32* cnt, int (&ts)[9], int (&cn)[8]) {
    int t = 0;
#pragma unroll
    for (int e = 0; e < 8; ++e) { cn[e] = (int)__hip_atomic_load(cnt + 64 * e, RLX_AGENT); ts[e] = t; t += (cn[e] + 255) >> 8; }
    ts[8] = t;
}
__device__ __forceinline__ void moe_lists(Frame& F, gu32* cnt, int row_lo, int row_hi) {
    int ts[9], cn[8]; moe_offsets(cnt, ts, cn);
    const int* tok_e = (const int*)(F.ws + WS_TOK); const int* tok_rank = tok_e + 4 * NR; int* tok_slot = (int*)tok_e + 6 * NR; int* rowidx = (int*)(F.ws + WS_ROWIDX);
    const int NGW = F.G * NWAVES;
    LAS int* pre = (LAS int*)F.lds; const int* cntw = (const int*)(F.ws + WS_CNTW);
    __syncthreads();
    for (int i = F.tid; i < NGW * 8; i += 512) pre[i] = cntw[i];
    __syncthreads();
    LAS int* tot = pre + NGW * 8;
    const int e_ = F.tid & 7, ch = F.tid >> 3, per = (NGW + 63) / 64, g0 = ch * per, g1 = (g0 + per < NGW) ? g0 + per : NGW;
    { int s = 0; for (int g = g0; g < g1; ++g) { const int c = pre[g * 8 + e_]; pre[g * 8 + e_] = s; s += c; } tot[ch * 8 + e_] = s; }
    __syncthreads();
    if (F.tid < 8) { int s = 0; for (int c2 = 0; c2 < 64; ++c2) { const int c = tot[c2 * 8 + F.tid]; tot[c2 * 8 + F.tid] = s; s += c; } }
    __syncthreads();
    { const int o = tot[ch * 8 + e_]; for (int g = g0; g < g1; ++g) pre[g * 8 + e_] += o; }
    __syncthreads();
    const int gt = blockIdx.x * 512 + F.tid, NT = F.G * 512;
    for (int i = row_lo * 2 + gt; i < row_hi * 2; i += NT) { const int e = tok_e[i], row = i >> 1, g = (row - row_lo) % NGW; int t0 = 0;
#pragma unroll
        for (int j = 0; j < 8; ++j) t0 = (e == j) ? ts[j] : t0;
        const int slot = t0 * 256 + pre[g * 8 + e] + tok_rank[i]; tok_slot[i] = slot; rowidx[slot] = row; }
    for (int i = gt; i < 8 * 256; i += NT) { const int e = i >> 8, k = i & 255; int t0 = 0, c0 = 0, t1 = 0;
#pragma unroll
        for (int j = 0; j < 8; ++j) { t0 = (e == j) ? ts[j] : t0; c0 = (e == j) ? cn[j] : c0; t1 = (e == j) ? ts[j + 1] : t1; }
        const int s = t0 * 256 + c0 + k; if (s < t1 * 256) rowidx[s] = row_lo; }
    __syncthreads();
}

__device__ __forceinline__ void ret_prep(Frame& F) {
    const int tid = F.tid, lane = F.lane, w = F.wave;
    const bf16* BIG = (const bf16*)(F.ws + RET_QKV);
    const f32x2* rope = (const f32x2*)(F.ws + WS_ROPE);
    LAS bf16* ks = (LAS bf16*)F.lds;
    for (int u = F.vcu; u < 544; u += F.G) {
        const int cg = u >> 2, h = u & 3, row0 = cg * 128;
        const bool isctx = row0 < NCTX;
        for (int it = tid; it < 1024; it += 512) { const int j = it >> 3, i0 = (it & 7) * 8, row = row0 + j;
            const bf16* kp = BIG + (size_t)NR * 1024 + (size_t)h * NR * 256 + (size_t)row * 256;
            const v4u a1 = *(const v4u*)(kp + i0), a2 = *(const v4u*)(kp + 64 + i0), b1 = *(const v4u*)(kp + 128 + i0), b2 = *(const v4u*)(kp + 192 + i0);
            const int p = (row - NCTX) & 4095, pr = p >> 6, pc = p & 63;
            unsigned o1[4], o2[4], o3[4], o4[4];
#pragma unroll
            for (int t = 0; t < 4; ++t) {
                float x1[2] = {bflo(a1[t]), bfhi(a1[t])}, x2[2] = {bflo(a2[t]), bfhi(a2[t])}, y1[2] = {bflo(b1[t]), bfhi(b1[t])}, y2[2] = {bflo(b2[t]), bfhi(b2[t])};
                float r1[2], r2[2], r3[2], r4[2];
#pragma unroll
                for (int q = 0; q < 2; ++q) { const int fi = i0 + 2 * t + q; f32x2 cr = (f32x2){1.f, 0.f}, cc = (f32x2){1.f, 0.f};
                    if (!isctx) { cr = rope[pr * 64 + fi]; cc = rope[pc * 64 + fi]; }
                    r1[q] = (x1[q] * cr.x - x2[q] * cr.y) * 0.0625f; r2[q] = (x2[q] * cr.x + x1[q] * cr.y) * 0.0625f;
                    r3[q] = (y1[q] * cc.x - y2[q] * cc.y) * 0.0625f; r4[q] = (y2[q] * cc.x + y1[q] * cc.y) * 0.0625f; }
                o1[t] = pk2(r1[0], r1[1]); o2[t] = pk2(r2[0], r2[1]); o3[t] = pk2(r3[0], r3[1]); o4[t] = pk2(r4[0], r4[1]); }
            LAS bf16* kd = ks + j * 264 + i0;
            *(LAS v4u*)(kd) = (v4u){o1[0], o1[1], o1[2], o1[3]}; *(LAS v4u*)(kd + 64) = (v4u){o2[0], o2[1], o2[2], o2[3]};
            *(LAS v4u*)(kd + 128) = (v4u){o3[0], o3[1], o3[2], o3[3]}; *(LAS v4u*)(kd + 192) = (v4u){o4[0], o4[1], o4[2], o4[3]}; }
        bf16x8 qf[8];
        { const int row = row0 + 16 * w + (lane & 15); const bf16* qp = BIG + (size_t)h * NR * 256 + (size_t)row * 256 + 8 * (lane >> 4);
          v4u raw[8];
#pragma unroll
          for (int s = 0; s < 8; ++s) raw[s] = *(const v4u*)(qp + 32 * s);
          const int p = (row - NCTX) & 4095, pr = p >> 6, pc = p & 63;
#pragma unroll
          for (int half = 0; half < 2; ++half)
#pragma unroll
              for (int s = 0; s < 2; ++s) { const int sa = 4 * half + s, sb = sa + 2; const int pos = half ? pc : pr; v4u oa, ob;
#pragma unroll
                  for (int t = 0; t < 4; ++t) { float xa[2] = {bflo(raw[sa][t]), bfhi(raw[sa][t])}, xb[2] = {bflo(raw[sb][t]), bfhi(raw[sb][t])}; float ra[2], rb[2];
#pragma unroll
                      for (int q = 0; q < 2; ++q) { const int fi = 32 * s + 8 * (lane >> 4) + 2 * t + q; f32x2 cs = (f32x2){1.f, 0.f}; if (!isctx) cs = rope[pos * 64 + fi];
                          ra[q] = xa[q] * cs.x - xb[q] * cs.y; rb[q] = xb[q] * cs.x + xa[q] * cs.y; }
                      oa[t] = pk2(ra[0], ra[1]); ob[t] = pk2(rb[0], rb[1]); }
                  raw[sa] = oa; raw[sb] = ob; }
          bf16* qro = (bf16*)(F.ws + PREP_QR) + (size_t)u * 32768 + (size_t)(w * 8) * 512 + lane * 8;
#pragma unroll
          for (int s = 0; s < 8; ++s) { *(v4u*)(qro + 512 * s) = raw[s]; qf[s] = __builtin_bit_cast(bf16x8, raw[s]); } }
        __syncthreads();
        { f32x4 acc[8];
#pragma unroll
          for (int n = 0; n < 8; ++n) acc[n] = (f32x4){0.f, 0.f, 0.f, 0.f};
#pragma unroll
          for (int s = 0; s < 8; ++s)
#pragma unroll
              for (int n = 0; n < 8; ++n) { const bf16x8 kf = *(const LAS bf16x8*)(ks + (16 * n + (lane & 15)) * 264 + 32 * s + 8 * (lane >> 4));
                  acc[n] = __builtin_amdgcn_mfma_f32_16x16x32_bf16(kf, qf[s], acc[n], 0, 0, 0); }
          bf16* pf = (bf16*)(F.ws + PREP_P) + (size_t)u * 16384;
#pragma unroll
          for (int n = 0; n < 8; ++n) { const int fo = ((w * 4 + (n >> 1)) * 64 + ((n & 1) * 2 + (lane >> 5)) * 16 + (lane & 15)) * 8 + 4 * ((lane >> 4) & 1);
              *(v2u*)(pf + fo) = (v2u){pk2(acc[n][0], acc[n][1]), pk2(acc[n][2], acc[n][3])}; } }
        { bf16* kt = (bf16*)(F.ws + PREP_KT) + (size_t)u * 32768;
          for (int it = tid; it < 4096; it += 512) { const int jg = it & 3, dl = (it >> 2) & 15, blk = it >> 6; const int d = (blk >> 2) * 16 + dl, j0 = ((blk & 3) * 4 + jg) * 8;
              unsigned short kv[8];
#pragma unroll
              for (int t = 0; t < 8; ++t) kv[t] = ks[(j0 + t) * 264 + d];
              v4u o; o.x = kv[0] | ((unsigned)kv[1] << 16); o.y = kv[2] | ((unsigned)kv[3] << 16); o.z = kv[4] | ((unsigned)kv[5] << 16); o.w = kv[6] | ((unsigned)kv[7] << 16);
              const int fo = (((d >> 4) * 4 + (j0 >> 5)) * 64 + ((j0 & 31) >> 3) * 16 + (d & 15)) * 8;
              *(v4u*)(kt + fo) = o; } }
        __syncthreads();
    }
}
#ifndef SCAN_UMAP
#define SCAN_UMAP F.vcu
#endif
template <int DRY = 0>
__device__ __forceinline__ void ret_scan(Frame& F, int j_ret, const float* decay_f, const float* decay_b, bool with_ctx) {
    const int lane = F.lane, w = F.wave, l15 = lane & 15, lq = lane >> 4;
    typedef short v4i16_t __attribute__((ext_vector_type(4)));
    LAS bf16* ST = (LAS bf16*)F.lds;
    LAS unsigned char* VI = F.lds + 33792;
    constexpr int VIB = 128 * 144;
    LAS bf16* OL = (LAS bf16*)(F.lds + 33792 + 2 * 128 * 144);
    for (int u = SCAN_UMAP; u < 256; u += F.G) {
        const int es = u & 7, dir = (u >> 3) & 1, h = (u >> 4) & 3, b = u >> 6;
        if (DRY == 2 && (es & 1)) continue;
        const float gam = sigmoidf_((dir ? decay_b : decay_f)[j_ret * 4 + h]), lg = log2f(gam), g128 = exp2f(lg * 128.f);
        const char* PD = (const char*)(F.ws + PREP_P); const char* KT = (const char*)(F.ws + PREP_KT); const char* QD = (const char*)(F.ws + PREP_QR);
        const char* Vg = (const char*)(F.ws + RET_QKV) + ((size_t)NR * 2048 + (size_t)h * NR * 512 + 64 * es) * 2;
        bf16* OUT = (bf16*)(F.ws + WS_OFB) + (dir ? (size_t)NR * 2048 : 0);
        f32x4 st[2][4];
#pragma unroll
        for (int dt = 0; dt < 2; ++dt)
#pragma unroll
            for (int et = 0; et < 4; ++et) st[dt][et] = (f32x4){0.f, 0.f, 0.f, 0.f};
#if defined(SCAN_STAGGER)
        { const unsigned long long t0 = __builtin_amdgcn_s_memrealtime(); const unsigned long long dt = (unsigned long long)(es * SCAN_STAGGER);
          while (__builtin_amdgcn_s_memrealtime() - t0 < dt) __builtin_amdgcn_s_sleep(4); }
#endif
        __syncthreads();
        for (int i = F.tid; i < 64 * 264 / 2; i += 512) ((LAS unsigned*)ST)[i] = 0u;
        const int il = 16 * w + l15;
        const float qs = dir ? exp2f(lg * (float)(128 - il)) : exp2f(lg * (float)(il + 1));
        const float rf = dir ? exp2f(-lg * (float)il) : exp2f(lg * (float)(il - 127));
#if !defined(SCAN_NOROT)
        const int r8 = es, r4 = es & 3;
#else
        const int r8 = 0, r4 = 0;
#endif
        v4u pm[4];
#pragma unroll
        for (int s4 = 0; s4 < 4; ++s4)
#pragma unroll
            for (int m = 0; m < 4; ++m) { const int j0 = 32 * ((s4 + r4) & 3) + 8 * lq + 2 * m, j1 = j0 + 1; const bool k0 = dir ? (j0 >= il) : (j0 <= il), k1 = dir ? (j1 >= il) : (j1 <= il);
                pm[s4][m] = (k0 ? 0x0000ffffu : 0u) | (k1 ? 0xffff0000u : 0u); }
        const int s4lo = dir ? (16 * w) >> 5 : 0, s4hi = dir ? 3 : (16 * w + 15) >> 5;
        const unsigned po = (unsigned)(w * 4096 + lane * 16), kto = (unsigned)(w * 8192 + lane * 16), qo = (unsigned)(w * 8192 + lane * 16);
        const int vr0 = F.tid >> 3, vpc = F.tid & 7;
        const unsigned vgo = (unsigned)(vr0 * 512 * 2 + vpc * 16); const int vlo = vr0 * 144 + vpc * 16;
        const float kd0 = dir ? exp2f(lg * (float)vr0) : exp2f(lg * (float)(127 - vr0)), kd1 = dir ? exp2f(lg * (float)(vr0 + 64)) : exp2f(lg * (float)(63 - vr0));
        const int vtr = (8 * lq + (l15 >> 2)) * 144 + (l15 & 3) * 8;
#define SCAN_CG(s_) ({ const int _s = (s_); const int _lc = dir ? (_s == 0 ? 1 : (_s == 1 ? 0 : 35 - _s)) : _s; (_lc < 2 ? b * 2 + _lc : 8 + b * 32 + (_lc - 2)); })
#define SCAN_VSCALE(x_, sc_) ({ const v4u _x = (x_); const float _s = (sc_); v4u _o; _Pragma("unroll") for (int _t = 0; _t < 4; ++_t) _o[_t] = pg8::cvt_pk_bf16(bflo(_x[_t]) * _s, bfhi(_x[_t]) * _s); _o; })
#define SCAN_VFRAG(vb_, et_, s4_) ({ const LAS unsigned char* _a = (vb_) + vtr + (s4_) * (32 * 144) + (et_) * 32; \
        const v4i16_t _lo = __builtin_amdgcn_ds_read_tr16_b64_v4i16((LAS v4i16_t*)_a), _hi = __builtin_amdgcn_ds_read_tr16_b64_v4i16((LAS v4i16_t*)(_a + 4 * 144)); \
        (bf16x8){_lo[0], _lo[1], _lo[2], _lo[3], _hi[0], _hi[1], _hi[2], _hi[3]}; })
        bf16x8 pf[4], qf[8], kf[2][4]; v4u vn0, vn1; unsigned warm = 0u, wpend = 0u;
        { const int cg = SCAN_CG(0), pu = cg * 4 + h;
          const char* vp = Vg + (size_t)cg * 128 * 512 * 2; const char* pp = PD + (size_t)pu * 32768; const char* qp = QD + (size_t)pu * 65536; const char* kp = KT + (size_t)pu * 65536;
          vn0 = __builtin_nontemporal_load((const v4u*)(vp + vgo)); vn1 = __builtin_nontemporal_load((const v4u*)(vp + vgo + 64 * 512 * 2));
#pragma unroll
          for (int s4 = 0; s4 < 4; ++s4) { const int s4r = (s4 + r4) & 3; if (s4r >= s4lo && s4r <= s4hi) pf[s4] = *(const bf16x8*)(pp + po + 1024 * s4r); }
#pragma unroll
          for (int s8 = 0; s8 < 8; ++s8) qf[s8] = *(const bf16x8*)(qp + qo + 1024 * ((s8 + r8) & 7));
#pragma unroll
          for (int dt = 0; dt < 2; ++dt)
#pragma unroll
              for (int s4 = 0; s4 < 4; ++s4) kf[dt][s4] = *(const bf16x8*)(kp + dt * 4096 + kto + 1024 * ((s4 + r4) & 3));
          *(LAS v4u*)(VI + vlo) = SCAN_VSCALE(vn0, kd0); *(LAS v4u*)(VI + vlo + 64 * 144) = SCAN_VSCALE(vn1, kd1); }
        __syncthreads();
        for (int s = 0; s < 34; ++s) {
            const int lc = dir ? (s == 0 ? 1 : (s == 1 ? 0 : 35 - s)) : s;
            const int cg = SCAN_CG(s), row0 = cg * 128;
            const int sn = s < 33 ? s + 1 : 33, cgn = SCAN_CG(sn), pun = cgn * 4 + h;
            const char* vpn = Vg + (size_t)cgn * 128 * 512 * 2; const char* ppn = PD + (size_t)pun * 32768; const char* qpn = QD + (size_t)pun * 65536; const char* kpn = KT + (size_t)pun * 65536;
            const LAS unsigned char* vcur = VI + (s & 1) * VIB;
#if defined(SCAN_L2WARM)
            {
              warm ^= wpend;
              const int s2 = s + SCAN_L2WARM < 34 ? s + SCAN_L2WARM : 33, cg2 = SCAN_CG(s2), pu2 = cg2 * 4 + h; const int slot = es * 8 + w; const int wl = lane < 20 ? lane : 0;
              const char* lp = wl < 4 ? PD + (size_t)pu2 * 32768 + (size_t)(slot * 4 + wl) * 128 : wl < 12 ? QD + (size_t)pu2 * 65536 + (size_t)(slot * 8 + wl - 4) * 128 : KT + (size_t)pu2 * 65536 + (size_t)(slot * 8 + wl - 12) * 128;
              wpend = *(const unsigned*)lp; }
#endif
            if (DRY != 1) { vn0 = __builtin_nontemporal_load((const v4u*)(vpn + vgo)); vn1 = __builtin_nontemporal_load((const v4u*)(vpn + vgo + 64 * 512 * 2)); }
            f32x4 a1[4], a2[4];
#pragma unroll
            for (int et = 0; et < 4; ++et) { a1[et] = (f32x4){0.f, 0.f, 0.f, 0.f}; a2[et] = (f32x4){0.f, 0.f, 0.f, 0.f}; }
#pragma unroll
            for (int s4 = 0; s4 < 4; ++s4) { const int s4r = (s4 + r4) & 3; if (s4r >= s4lo && s4r <= s4hi) {
                const bf16x8 pmk = __builtin_bit_cast(bf16x8, __builtin_bit_cast(v4u, pf[s4]) & pm[s4]);
#pragma unroll
                for (int et = 0; et < 4; ++et) { const bf16x8 vfr = SCAN_VFRAG(vcur, et, s4r); a1[et] = __builtin_amdgcn_mfma_f32_16x16x32_bf16(vfr, pmk, a1[et], 0, 0, 0); }
                if (DRY != 1) pf[s4] = *(const bf16x8*)(ppn + po + 1024 * s4r); } }
#pragma unroll
            for (int s8 = 0; s8 < 8; ++s8) { const int s8r = (s8 + r8) & 7;
#pragma unroll
                for (int et = 0; et < 4; ++et) { const bf16x8 sf = *(const LAS bf16x8*)(ST + (16 * et + l15) * 264 + 32 * s8r + 8 * lq);
                    a2[et] = __builtin_amdgcn_mfma_f32_16x16x32_bf16(sf, qf[s8], a2[et], 0, 0, 0); }
                if (DRY != 1) qf[s8] = *(const bf16x8*)(qpn + qo + 1024 * s8r); }
            const bool wr_o = (DRY == 0 || DRY == 2) && (with_ctx || lc >= 2);
            if (wr_o) {
#pragma unroll
                for (int et = 0; et < 4; ++et) { const f32x4 o = a1[et] * rf + a2[et] * qs; *(LAS v2u*)(OL + il * 72 + 16 * et + 4 * lq) = (v2u){pk2(o[0], o[1]), pk2(o[2], o[3])}; }
            }
            __syncthreads();
#pragma unroll
            for (int dt = 0; dt < 2; ++dt)
#pragma unroll
                for (int et = 0; et < 4; ++et) st[dt][et] = st[dt][et] * g128;
#pragma unroll
            for (int s4 = 0; s4 < 4; ++s4) { const int s4r = (s4 + r4) & 3;
#pragma unroll
                for (int et = 0; et < 4; ++et) { const bf16x8 vfr = SCAN_VFRAG(vcur, et, s4r);
                    st[0][et] = __builtin_amdgcn_mfma_f32_16x16x32_bf16(kf[0][s4], vfr, st[0][et], 0, 0, 0);
                    st[1][et] = __builtin_amdgcn_mfma_f32_16x16x32_bf16(kf[1][s4], vfr, st[1][et], 0, 0, 0); }
                if (DRY != 1) { kf[0][s4] = *(const bf16x8*)(kpn + kto + 1024 * s4r); kf[1][s4] = *(const bf16x8*)(kpn + 4096 + kto + 1024 * s4r); } }
#pragma unroll
            for (int dt = 0; dt < 2; ++dt)
#pragma unroll
                for (int et = 0; et < 4; ++et) *(LAS v2u*)(ST + (16 * et + l15) * 264 + 32 * w + 16 * dt + 4 * lq) = (v2u){pk2(st[dt][et][0], st[dt][et][1]), pk2(st[dt][et][2], st[dt][et][3])};
            if (wr_o) { const int orow = F.tid >> 3, opc = F.tid & 7;
#pragma unroll
                for (int k = 0; k < 2; ++k) { const v4u ov = *(const LAS v4u*)(OL + (orow + 64 * k) * 72 + 8 * opc);
                    *(v4u*)(OUT + (size_t)(row0 + orow + 64 * k) * 2048 + h * 512 + 64 * es + 8 * opc) = ov; } }
            { LAS unsigned char* vnx = VI + ((s + 1) & 1) * VIB + vlo; *(LAS v4u*)(vnx) = SCAN_VSCALE(vn0, kd0); *(LAS v4u*)(vnx + 64 * 144) = SCAN_VSCALE(vn1, kd1); }
            __syncthreads();
        }
#if defined(SCAN_L2WARM)
        if ((warm ^ wpend) == 0x12345677u) ((volatile unsigned*)(F.ws + WS_RSTD))[lane] = warm;
#endif
#undef SCAN_CG
#undef SCAN_VSCALE
#undef SCAN_VFRAG
    }
}
template <int PROBE = 0>
__device__ __forceinline__ void ret_gate(Frame& F, const float* gnf, const float* gnb, int row_lo) {
    const int gw = F.vcu * NWAVES + F.wave, NGW = F.G * NWAVES, lane = F.lane;
    const bf16* BIG = (const bf16*)(F.ws + RET_G); const bf16* OFp = (const bf16*)(F.ws + WS_OFB); const bf16* OBp = OFp + (size_t)NR * 2048; bf16* MIX = (bf16*)(F.ws + WS_MIX);
    const int col0 = (lane >> 4) * 512 + (lane & 15) * 8;
    v4u rf[4], rb[4], gf4[4], gb4[4];
#define GATE_LOAD(row_) do { const int _r = (row_) < NR ? (row_) : NR - 1; _Pragma("unroll") for (int p = 0; p < 4; ++p) { \
        rf[p] = *(const v4u*)(OFp + (size_t)_r * 2048 + col0 + 128 * p); rb[p] = *(const v4u*)(OBp + (size_t)_r * 2048 + col0 + 128 * p); \
        gf4[p] = *(const v4u*)(BIG + (size_t)_r * RET_LD + col0 + 128 * p); gb4[p] = *(const v4u*)(BIG + (size_t)_r * RET_LD + 2048 + col0 + 128 * p); } } while (0)
    GATE_LOAD(row_lo + gw);
    for (int row = row_lo + gw; row < NR; row += NGW) {
        v4u cf[4], cb[4], cgf[4], cgb[4];
#pragma unroll
        for (int p = 0; p < 4; ++p) { cf[p] = rf[p]; cb[p] = rb[p]; cgf[p] = gf4[p]; cgb[p] = gb4[p]; }
        if (PROBE != 1) GATE_LOAD(row + NGW);
        float sf = 0.f, sb = 0.f;
#pragma unroll
        for (int p = 0; p < 4; ++p)
#pragma unroll
            for (int t = 0; t < 4; ++t) { sf += bflo(cf[p][t]) + bfhi(cf[p][t]); sb += bflo(cb[p][t]) + bfhi(cb[p][t]); }
        const float muf = row16_sum(sf) * (1.0f / 512.0f), mub = row16_sum(sb) * (1.0f / 512.0f);
        float qf = 0.f, qb = 0.f;
#pragma unroll
        for (int p = 0; p < 4; ++p)
#pragma unroll
            for (int t = 0; t < 4; ++t) { const float a0 = bflo(cf[p][t]) - muf, a1 = bfhi(cf[p][t]) - muf, b0 = bflo(cb[p][t]) - mub, b1 = bfhi(cb[p][t]) - mub; qf += a0 * a0 + a1 * a1; qb += b0 * b0 + b1 * b1; }
        const float rsf = 1.0f / sqrtf(row16_sum(qf) * (1.0f / 512.0f) + EPS), rsb = 1.0f / sqrtf(row16_sum(qb) * (1.0f / 512.0f) + EPS);
#pragma unroll
        for (int p = 0; p < 4; ++p) { const float* gpf = gnf + col0 + 128 * p; const float* gpb = gnb + col0 + 128 * p;
            const f32x4 nf0 = *(const f32x4*)gpf, nf1 = *(const f32x4*)(gpf + 4), nb0 = *(const f32x4*)gpb, nb1 = *(const f32x4*)(gpb + 4); v4u o;
#pragma unroll
            for (int t = 0; t < 4; ++t) { const float g0 = bflo(cgf[p][t]), g1 = bfhi(cgf[p][t]), h0 = bflo(cgb[p][t]), h1 = bfhi(cgb[p][t]);
                const float yf0 = (bflo(cf[p][t]) - muf) * rsf * (t < 2 ? nf0[2 * t] : nf1[2 * t - 4]), yf1 = (bfhi(cf[p][t]) - muf) * rsf * (t < 2 ? nf0[2 * t + 1] : nf1[2 * t - 3]);
                const float yb0 = (bflo(cb[p][t]) - mub) * rsb * (t < 2 ? nb0[2 * t] : nb1[2 * t - 4]), yb1 = (bfhi(cb[p][t]) - mub) * rsb * (t < 2 ? nb0[2 * t + 1] : nb1[2 * t - 3]);
                o[t] = pg8::cvt_pk_bf16(g0 * pg8::fast_sigmoid(g0) * yf0 + h0 * pg8::fast_sigmoid(h0) * yb0, g1 * pg8::fast_sigmoid(g1) * yf1 + h1 * pg8::fast_sigmoid(h1) * yb1); }
            if (PROBE == 0) *(v4u*)(MIX + (size_t)row * 2048 + col0 + 128 * p) = o;
            else if (PROBE == 1) *(v4u*)((bf16*)(F.ws + WS_PREP) + (size_t)row * 2048 + col0 + 128 * p) = o;
            else if (row < 0) *(v4u*)(MIX + col0 + 128 * p) = o; }
    }
#undef GATE_LOAD
}

__device__ __forceinline__ void mla_rows(Frame& F, const float* g_q, const float* g_kv) {
    const int gw = F.vcu * NWAVES + F.wave, NGW = F.G * NWAVES, lane = F.lane;
    const float* CKV = (const float*)(F.ws + MLA_CKV); bf16* CQN = (bf16*)(F.ws + MLA_CQN); bf16* CKVN = (bf16*)(F.ws + MLA_CKVN); bf16* KR = (bf16*)(F.ws + MLA_KV) + 2048;
    const f32x2* rm = (const f32x2*)(F.ws + WS_ROPE) + 64 * 64;
    const f32x4 gq = *(const f32x4*)(g_q + 4 * lane), gk = *(const f32x4*)(g_kv + 4 * lane);
    for (int row = gw; row < NR; row += NGW) {
        const float* r = CKV + (size_t)row * 768;
        const f32x4 a = *(const f32x4*)(r + 4 * lane), c = *(const f32x4*)(r + 256 + 4 * lane);
        const float sa = wave_sum((a.x * a.x + a.y * a.y) + (a.z * a.z + a.w * a.w)), sc = wave_sum((c.x * c.x + c.y * c.y) + (c.z * c.z + c.w * c.w));
        const float ra = 1.0f / sqrtf(sa * (1.0f / 256.0f) + EPS), rc = 1.0f / sqrtf(sc * (1.0f / 256.0f) + EPS);
        *(v2u*)(CQN + (size_t)row * 256 + 4 * lane) = (v2u){pk2(a.x * ra * gq.x, a.y * ra * gq.y), pk2(a.z * ra * gq.z, a.w * ra * gq.w)};
        *(v2u*)(CKVN + (size_t)row * 256 + 4 * lane) = (v2u){pk2(c.x * rc * gk.x, c.y * rc * gk.y), pk2(c.z * rc * gk.z, c.w * rc * gk.w)};
        if (lane < 32) { const int part = lane >> 4, i = lane & 15; const float x1 = r[512 + part * 32 + i], x2 = r[512 + part * 32 + 16 + i];
            f32x2 cs = (f32x2){1.f, 0.f};
            if (row >= NCTX) { const int p = (row - NCTX) & 4095; const int pos = part ? (p & 63) : (p >> 6); cs = rm[pos * 16 + i]; }
            KR[(size_t)row * KVR_LD + part * 32 + i] = (bf16)f2bf(x1 * cs.x - x2 * cs.y); KR[(size_t)row * KVR_LD + part * 32 + 16 + i] = (bf16)f2bf(x2 * cs.x + x1 * cs.y); }
    }
}

__device__ __forceinline__ void sgu_spatial(Frame& F, const float* g_v, const float* b_s) {
    const int tid = F.tid, lane = F.lane, w = F.wave, l15 = lane & 15, lq = lane >> 4;
    const bf16* U = (const bf16*)(F.ws + SGU_UV); const bf16* VT = (const bf16*)(F.ws + SGU_VT); bf16* UZ = (bf16*)(F.ws + SGU_UZ); const float* SSQ = (const float*)(F.ws + SGU_SSQ); const bf16* WSB = (const bf16*)(F.ws + WS_WSB);
    LAS bf16* WL = (LAS bf16*)F.lds;
    LAS bf16* ZL = (LAS bf16*)(F.lds + 34816);
    LAS float* RS = (LAS float*)(F.lds + 69632);
    for (int u = F.vcu; u < 136 * 24; u += F.G) {
        const int cg = u / 24, r24 = u - cg * 24, g = r24 / 3, third = r24 - g * 3, row0 = cg * 128, c0 = g * 384 + third * 128;
        __syncthreads();
        if (tid < 128) { const float* sp = SSQ + row0 + tid; float s = 0.f;
#pragma unroll
            for (int k = 0; k < 24; ++k) s += sp[(size_t)k * NR];
            RS[tid] = 1.0f / sqrtf(s * (1.0f / 3072.0f) + EPS); }
        bf16x8 vf[4];
        { const bf16* vp = VT + (size_t)cg * (3072 * 128) + (size_t)(c0 + 16 * w + l15) * 128 + 8 * lq;
#pragma unroll
          for (int s4 = 0; s4 < 4; ++s4) vf[s4] = *(const bf16x8*)(vp + 32 * s4); }
        __syncthreads();
        for (int it = tid; it < 2048; it += 512) { const int p = it >> 4, pc = it & 15; const v4u x = *(const v4u*)(WSB + (size_t)g * 16384 + p * 128 + pc * 8); v4u o;
#pragma unroll
            for (int t = 0; t < 4; ++t) o[t] = pg8::cvt_pk_bf16(bflo(x[t]) * RS[pc * 8 + 2 * t], bfhi(x[t]) * RS[pc * 8 + 2 * t + 1]);
            *(LAS v4u*)(WL + p * 136 + pc * 8) = o; }
        __syncthreads();
        f32x4 acc[8];
#pragma unroll
        for (int pt = 0; pt < 8; ++pt) acc[pt] = (f32x4){0.f, 0.f, 0.f, 0.f};
#pragma unroll
        for (int s4 = 0; s4 < 4; ++s4)
#pragma unroll
            for (int pt = 0; pt < 8; ++pt) { const bf16x8 wf = *(const LAS bf16x8*)(WL + (16 * pt + l15) * 136 + 32 * s4 + 8 * lq);
                acc[pt] = __builtin_amdgcn_mfma_f32_16x16x32_bf16(vf[s4], wf, acc[pt], 0, 0, 0); }
        { const f32x4 gv = *(const f32x4*)(g_v + c0 + 16 * w + 4 * lq);
#pragma unroll
          for (int pt = 0; pt < 8; ++pt) { const float bs = b_s[g * 128 + 16 * pt + l15];
              *(LAS v2u*)(ZL + (16 * pt + l15) * 136 + 16 * w + 4 * lq) = (v2u){pg8::cvt_pk_bf16(acc[pt][0] * gv[0] + bs, acc[pt][1] * gv[1] + bs), pg8::cvt_pk_bf16(acc[pt][2] * gv[2] + bs, acc[pt][3] * gv[3] + bs)}; } }
        __syncthreads();
        for (int it = tid; it < 2048; it += 512) { const int p = it >> 4, pc = it & 15;
            const v4u uu = *(const v4u*)(U + (size_t)(row0 + p) * 3072 + c0 + pc * 8); const v4u zz = *(const LAS v4u*)(ZL + p * 136 + pc * 8); v4u o;
#pragma unroll
            for (int t = 0; t < 4; ++t) o[t] = pg8::cvt_pk_bf16(bflo(uu[t]) * bflo(zz[t]), bfhi(uu[t]) * bfhi(zz[t]));
            *(v4u*)(UZ + (size_t)(row0 + p) * 3072 + c0 + pc * 8) = o; }
    }
}

namespace att {
constexpr int NW = 8, QBLK = 32, KVBLK = 64;
constexpr float SCALE = 0.07216878364870322f;
constexpr float THR = 8.f;
constexpr int SHM_V = KVBLK * 128 * 2, SHM_K = KVBLK * 192 * 2;
constexpr int NQL = 4;
constexpr int NKB = 3;
constexpr int SHM_ATTN = 2 * SHM_V + NKB * SHM_K + NW * 64 * 4 + NW * NQL * 1024;
using s16x4  = __attribute__((ext_vector_type(4))) short;
using f32x16 = __attribute__((ext_vector_type(16))) float;
#define KSWZ(row, colB) ((row) * 384 + ((colB) ^ (((row) & 7) << 4)))
#define SBAR() __builtin_amdgcn_sched_barrier(0)
__device__ __forceinline__ int crow(int r, int hi) { return (r & 3) + 8 * (r >> 2) + 4 * hi; }
__device__ __forceinline__ unsigned cvtpk(float lo, float hi) { unsigned r; asm volatile("v_cvt_pk_bf16_f32 %0, %1, %2" : "=v"(r) : "v"(lo), "v"(hi)); return r; }

__device__ __forceinline__ void partialSM(f32x16& p0, f32x16& p1, float& m_reg, float& mn, float& alpha) {
  constexpr float C = SCALE * 1.4426950408889634f;
  float pmax = p0[0]; for (int r = 1; r < 16; ++r) pmax = fmaxf(pmax, p0[r]); for (int r = 0; r < 16; ++r) pmax = fmaxf(pmax, p1[r]);
  { auto rr = __builtin_amdgcn_permlane32_swap(__float_as_uint(pmax), __float_as_uint(pmax), false, false);
    pmax = fmaxf(__uint_as_float(rr[0]), __uint_as_float(rr[1])); }
  if (__builtin_expect(__all(pmax - m_reg <= THR / SCALE), 1)) { mn = m_reg; alpha = 1.f; }
  else { mn = fmaxf(m_reg, pmax); alpha = __builtin_amdgcn_exp2f((m_reg - mn) * C); m_reg = mn; }
  float mnC = -mn * C;
  for (int r = 0; r < 16; ++r) p0[r] = fmaf(p0[r], C, mnC); for (int r = 0; r < 16; ++r) p1[r] = fmaf(p1[r], C, mnC);
  for (int r = 0; r < 16; ++r) p0[r] = __builtin_amdgcn_exp2f(p0[r]);
}
__device__ __forceinline__ void finishSM(f32x16& p0, f32x16& p1, float alpha, float& l_reg, bf16x8& pa0, bf16x8& pa1, bf16x8& pa2, bf16x8& pa3) {
  for (int r = 0; r < 16; ++r) p1[r] = __builtin_amdgcn_exp2f(p1[r]);
  float ps = 0; for (int r = 0; r < 16; ++r) ps += p0[r]; for (int r = 0; r < 16; ++r) ps += p1[r];
  { auto rr = __builtin_amdgcn_permlane32_swap(__float_as_uint(ps), __float_as_uint(ps), false, false);
    ps = __uint_as_float(rr[0]) + __uint_as_float(rr[1]); }
  l_reg = l_reg * alpha + ps;
#define PK4(P, BASE, OUT) do { unsigned a0 = cvtpk(P[BASE + 0], P[BASE + 1]), a1 = cvtpk(P[BASE + 2], P[BASE + 3]);   \
    unsigned b0 = cvtpk(P[BASE + 4], P[BASE + 5]), b1 = cvtpk(P[BASE + 6], P[BASE + 7]);                              \
    auto r0 = __builtin_amdgcn_permlane32_swap(a0, b0, false, false); auto r1 = __builtin_amdgcn_permlane32_swap(a1, b1, false, false); \
    v4u w = {r0[0], r1[0], r0[1], r1[1]}; OUT = __builtin_bit_cast(bf16x8, w); } while (0)
  PK4(p0, 0, pa0); PK4(p0, 8, pa1); PK4(p1, 0, pa2); PK4(p1, 8, pa3);
#undef PK4
}
__device__ __forceinline__ void qkt(f32x16& p0, f32x16& p1, const LAS char* const (&ka)[4], int kbo, const bf16x8* qr, const LAS char* qrope) {
  p0 = f32x16{}; p1 = f32x16{};
  const LAS char* kb[4];
#pragma unroll
  for (int dr = 0; dr < 4; ++dr) kb[dr] = ka[dr] + kbo;
#pragma unroll
  for (int d0 = 0; d0 < 12; ++d0) { const LAS char* a = kb[d0 & 3] + (d0 >> 2) * 128;
    const bf16x8 b0 = *reinterpret_cast<const LAS bf16x8*>(a);
    const bf16x8 b1 = *reinterpret_cast<const LAS bf16x8*>(a + 32 * 384);
    const bf16x8 qv = d0 < 12 - NQL ? qr[d0] : *reinterpret_cast<const LAS bf16x8*>(qrope + (d0 - (12 - NQL)) * 1024);
    p0 = __builtin_amdgcn_mfma_f32_32x32x16_bf16(b0, qv, p0, 0, 0, 0);
    p1 = __builtin_amdgcn_mfma_f32_32x32x16_bf16(b1, qv, p1, 0, 0, 0); }
}
__device__ __forceinline__ int v_st(int k, int c) { const int kk = (k & ~0xC) | ((k & 4) << 1) | ((k & 8) >> 1); return ((kk >> 3) * 4 + (c >> 5)) * 512 + ((kk & 7) * 32 + (c & 31)) * 2; }
__device__ __forceinline__ int v_rd_base(int lane) { return ((lane & 3) << 3) | (((lane >> 2) & 3) << 6) | (((lane >> 4) & 1) << 5) | (((lane >> 5) & 1) << 8); }
constexpr int v_rd_off(int d0, int ks, int half) { return d0 * 512 + ks * 4096 + half * 2048; }
template <int OFF> __device__ __forceinline__ s16x4 tr_read(int vb) {
  s16x4 r; asm volatile("ds_read_b64_tr_b16 %0, %1 offset:%2" : "=&v"(r) : "v"(vb), "i"(OFF) : "memory"); return r;
}
template <int D0> __device__ __forceinline__ void pv_one(f32x16& od, int vb, bf16x8 pa0, bf16x8 pa1, bf16x8 pa2, bf16x8 pa3) {
  const s16x4 l0 = tr_read<v_rd_off(D0, 0, 0)>(vb), h0 = tr_read<v_rd_off(D0, 0, 1)>(vb), l1 = tr_read<v_rd_off(D0, 1, 0)>(vb), h1 = tr_read<v_rd_off(D0, 1, 1)>(vb);
  const s16x4 l2 = tr_read<v_rd_off(D0, 2, 0)>(vb), h2 = tr_read<v_rd_off(D0, 2, 1)>(vb), l3 = tr_read<v_rd_off(D0, 3, 0)>(vb), h3 = tr_read<v_rd_off(D0, 3, 1)>(vb);
  asm volatile("s_waitcnt lgkmcnt(0)" ::: "memory"); SBAR();
#define PK(L, H) (bf16x8){L[0], L[1], L[2], L[3], H[0], H[1], H[2], H[3]}
  od = __builtin_amdgcn_mfma_f32_32x32x16_bf16(pa0, PK(l0, h0), od, 0, 0, 0);
  od = __builtin_amdgcn_mfma_f32_32x32x16_bf16(pa1, PK(l1, h1), od, 0, 0, 0);
  od = __builtin_amdgcn_mfma_f32_32x32x16_bf16(pa2, PK(l2, h2), od, 0, 0, 0);
  od = __builtin_amdgcn_mfma_f32_32x32x16_bf16(pa3, PK(l3, h3), od, 0, 0, 0);
#undef PK
}
__device__ __forceinline__ void pv_d0(f32x16* o, int vb, bf16x8 pa0, bf16x8 pa1, bf16x8 pa2, bf16x8 pa3) {
  pv_one<0>(o[0], vb, pa0, pa1, pa2, pa3); pv_one<1>(o[1], vb, pa0, pa1, pa2, pa3); pv_one<2>(o[2], vb, pa0, pa1, pa2, pa3); pv_one<3>(o[3], vb, pa0, pa1, pa2, pa3);
}
template <bool NODMA = false>
__device__ __forceinline__ void attn_unit(const bf16* __restrict__ Q, const bf16* __restrict__ KVR, bf16* __restrict__ O, const f32x2* __restrict__ ropem,
                                          int qrow0, int h, int kc0, int kl0, int nk, LAS unsigned char* ldsL) {
  char* lds = (char*)ldsL;
  int tid_ = threadIdx.x; asm volatile("" : "+v"(tid_));
  const int tid = tid_, wid = __builtin_amdgcn_readfirstlane(tid >> 6), lane = tid & 63, r32 = lane & 31, hi = lane >> 5;
  char* V_lds = lds;
  float* wsf = (float*)(lds + 2 * SHM_V + NKB * SHM_K) + wid * 64; float* li_l = wsf; float* al_l = wsf + 32;
  LAS char* qrope = (LAS char*)ldsL + 2 * SHM_V + NKB * SHM_K + NW * 64 * 4 + wid * (NQL * 1024) + lane * 16;
  const LAS char* ka[4];
#pragma unroll
  for (int dr = 0; dr < 4; ++dr) ka[dr] = (const LAS char*)ldsL + 2 * SHM_V + r32 * 384 + (((dr * 2 + hi) ^ (r32 & 7)) << 4);
  float m_reg = -1e30f, l_reg = 0; f32x16 o[4] = {}; bf16x8 qr[12 - NQL];
  { const bf16* Qs = Q; asm volatile("" : "+s"(Qs));
    const int qrow = qrow0 + wid * QBLK + r32; const bf16* Qw = Qs + (size_t)qrow * 1536 + h * 192 + hi * 8;
#pragma unroll
    for (int d0 = 0; d0 < 12 - NQL; ++d0) qr[d0] = *reinterpret_cast<const bf16x8*>(Qw + d0 * 16);
#pragma unroll
    for (int d0 = 12 - NQL; d0 < 8; ++d0) *reinterpret_cast<LAS bf16x8*>(qrope + (d0 - (12 - NQL)) * 1024) = *reinterpret_cast<const bf16x8*>(Qw + d0 * 16);
    bf16x8 qx[4];
#pragma unroll
    for (int d0 = 0; d0 < 4; ++d0) qx[d0] = *reinterpret_cast<const bf16x8*>(Qw + (8 + d0) * 16);
    if (qrow >= NCTX) {
      const int p = (qrow - NCTX) & 4095;
#pragma unroll
      for (int part = 0; part < 2; ++part) { const int pos = part ? (p & 63) : (p >> 6); const v4u xa = __builtin_bit_cast(v4u, qx[2 * part]), xb = __builtin_bit_cast(v4u, qx[1 + 2 * part]); v4u oa, ob;
#pragma unroll
        for (int t = 0; t < 4; ++t) { const f32x2 c0 = ropem[pos * 16 + hi * 8 + 2 * t], c1 = ropem[pos * 16 + hi * 8 + 2 * t + 1];
          const float a0 = bflo(xa[t]), a1 = bfhi(xa[t]), b0 = bflo(xb[t]), b1 = bfhi(xb[t]);
          oa[t] = pk2(a0 * c0.x - b0 * c0.y, a1 * c1.x - b1 * c1.y); ob[t] = pk2(b0 * c0.x + a0 * c0.y, b1 * c1.x + a1 * c1.y); }
        qx[2 * part] = __builtin_bit_cast(bf16x8, oa); qx[1 + 2 * part] = __builtin_bit_cast(bf16x8, ob); } }
#pragma unroll
    for (int d0 = 0; d0 < 4; ++d0) *reinterpret_cast<LAS bf16x8*>(qrope + (d0 + NQL - 4) * 1024) = qx[d0]; }
  const int vb0 = (int)(uintptr_t)V_lds + v_rd_base(lane);
#define KROW(k) ((k) < 256 ? kc0 + (k) : kl0 + (k) - 256)
#define KDMA(k0, b) do { const char* _kb = (const char*)(KVR + (size_t)KROW(k0) * 2112); int _ln = lane; asm volatile("" : "+v"(_ln)); _Pragma("unroll") for (int _i = 0; _i < 3; ++_i) { \
    const int _ob = (wid * 3 + _i) * 1024 + _ln * 16, _row = _ob / 384, _cb = (_ob - _row * 384) ^ ((_row & 7) << 4), _pc = _cb >> 4; \
    const unsigned _off = 2u * (unsigned)(_row * 2112 + (_pc < 16 ? h * 256 + _pc * 8 : 2048 + (_pc - 16) * 8)); \
    __builtin_amdgcn_global_load_lds((const unsigned*)(_kb + _off), (LAS unsigned*)(ldsL + 2 * SHM_V + (b) * SHM_K + (wid * 3 + _i) * 1024), 16, 0, 0); } } while (0)
#define VDMA(k0, b) do { const char* _kb = (const char*)(KVR + (size_t)KROW(k0) * 2112); int _ln = lane; asm volatile("" : "+v"(_ln)); _Pragma("unroll") for (int _i = 0; _i < 2; ++_i) { \
    const int _ob = (wid * 2 + _i) * 1024 + _ln * 16, _sub = _ob >> 9, _within = (_ob & 511) >> 1, _kk = (_sub >> 2) * 8 + (_within >> 5); \
    const int _k = (_kk & ~0xC) | ((_kk & 4) << 1) | ((_kk & 8) >> 1), _c = (_sub & 3) * 32 + (_within & 31); \
    const unsigned _off = 2u * (unsigned)(_k * 2112 + h * 256 + 128 + _c); \
    __builtin_amdgcn_global_load_lds((const unsigned*)(_kb + _off), (LAS unsigned*)(ldsL + (b) * SHM_V + (wid * 2 + _i) * 1024), 16, 0, 0); } } while (0)
#define RESC(a) do { if (__any((a) < 1.f)) { if (hi == 0) al_l[r32] = (a); asm volatile("s_waitcnt lgkmcnt(0)" ::: "memory"); \
    for (int d = 0; d < 4; ++d) for (int r = 0; r < 16; ++r) o[d][r] *= al_l[crow(r, hi)]; } } while (0)
#define SEAM3() do { asm volatile("s_waitcnt vmcnt(3) lgkmcnt(0)" ::: "memory"); __builtin_amdgcn_s_barrier(); asm volatile("" ::: "memory"); } while (0)
#define SEAM0() do { asm volatile("s_waitcnt vmcnt(0) lgkmcnt(0)" ::: "memory"); __builtin_amdgcn_s_barrier(); asm volatile("" ::: "memory"); } while (0)
#define KT_(t) ((t) < NT ? (t) : NT - 1)
  f32x16 pA0, pA1, pB0, pB1; float mnA, mnB, alA, alB; bf16x8 pa0, pa1, pa2, pa3; const int NT = nk / KVBLK;
  KDMA(0, 0); VDMA(0, 0); KDMA(KVBLK, 1); VDMA(KVBLK, 1); SEAM0();
  qkt(pA0, pA1, ka, 0, qr, qrope); partialSM(pA0, pA1, m_reg, mnA, alA);
  asm volatile("s_waitcnt lgkmcnt(0)" ::: "memory"); __builtin_amdgcn_s_barrier(); asm volatile("" ::: "memory");
  KDMA(KT_(2) * KVBLK, 2);
  int kb1 = SHM_K, kb2 = 2 * SHM_K;
  for (int j = 1; j + 1 < NT; j += 2) {
    SBAR(); qkt(pB0, pB1, ka, kb1, qr, qrope); SBAR();
    { const int kt = KT_(j + 2); const int kbuf = (j + 2) % NKB; KDMA(kt * KVBLK, kbuf); } SBAR();
    finishSM(pA0, pA1, alA, l_reg, pa0, pa1, pa2, pa3); SBAR();
    pv_d0(o, vb0, pa0, pa1, pa2, pa3); partialSM(pB0, pB1, m_reg, mnB, alB);
    SEAM3();
    VDMA(KT_(j + 1) * KVBLK, 0);
    RESC(alB);
    SBAR(); qkt(pA0, pA1, ka, kb2, qr, qrope); SBAR();
    { const int kt = KT_(j + 3); const int kbuf = (j + 3) % NKB; KDMA(kt * KVBLK, kbuf); } SBAR();
    finishSM(pB0, pB1, alB, l_reg, pa0, pa1, pa2, pa3); SBAR();
    pv_d0(o, vb0 + SHM_V, pa0, pa1, pa2, pa3); partialSM(pA0, pA1, m_reg, mnA, alA);
    SEAM3();
    VDMA(KT_(j + 2) * KVBLK, 1);
    RESC(alA);
    kb1 = ((j + 2) % NKB) * SHM_K; kb2 = ((j + 3) % NKB) * SHM_K;
  }
  SBAR(); qkt(pB0, pB1, ka, kb1, qr, qrope);
  finishSM(pA0, pA1, alA, l_reg, pa0, pa1, pa2, pa3); SBAR();
  pv_d0(o, vb0, pa0, pa1, pa2, pa3); partialSM(pB0, pB1, m_reg, mnB, alB);
  SEAM0(); RESC(alB);
  finishSM(pB0, pB1, alB, l_reg, pa0, pa1, pa2, pa3); SBAR();
  pv_d0(o, vb0 + SHM_V, pa0, pa1, pa2, pa3);
  if (hi == 0) li_l[r32] = l_reg; asm volatile("s_waitcnt lgkmcnt(0)" ::: "memory");
  float rli[16];
#pragma unroll
  for (int r = 0; r < 16; ++r) rli[r] = __builtin_amdgcn_rcpf(li_l[crow(r, hi)]);
  { LAS bf16* ot = (LAS bf16*)(ldsL + 2 * SHM_V) + wid * (32 * 136);
#pragma unroll
    for (int r = 0; r < 16; ++r) { const int orow = crow(r, hi);
#pragma unroll
      for (int d0 = 0; d0 < 4; ++d0) ot[orow * 136 + d0 * 32 + r32] = (bf16)f2bf(o[d0][r] * rli[r]); }
    asm volatile("s_waitcnt lgkmcnt(0)" ::: "memory");
    bf16* Ow = O + (size_t)(qrow0 + wid * QBLK) * 1024 + h * 128;
#pragma unroll
    for (int k = 0; k < 8; ++k) { const int p = lane + 64 * k, row = p >> 4, pc = p & 15;
      *(v4u*)(Ow + (size_t)row * 1024 + pc * 8) = *(const LAS v4u*)(ot + row * 136 + pc * 8); } }
  __syncthreads();
#undef KROW
#undef KDMA
#undef VDMA
#undef SEAM3
#undef SEAM0
#undef KT_
#undef RESC
}
#undef KSWZ
}

enum Phase { P_PRO, P0_MOD, P0_WIN, P0_PREP, P0_SCAN, P0_GATE, P0_WO, P0_MOD2, P0_GU, P0_DOWN, P1_MOD, P1_WD, P1_ROWS, P1_UQ, P1_UKV, P1_ATT, P1_WO, P1_MOD2, P1_LIST, P1_MGU, P1_MDN, P2_MOD, P2_WIN, P2_RSTD, P2_SPA, P2_WOUT, P2_MOD2, P2_GU, P2_DOWN, P3_MOD, P3_WIN, P3_PREP, P3_SCAN, P3_GATE, P3_WO, P3_MOD2, P3_LIST, P3_MGU, P3_MDN, P3_FIN, NPH };
struct Args { const float* in[31]; float* out; unsigned char* ws; int ph_lo, ph_hi, li, pad; };

template <class Epi>
__device__ __forceinline__ void run_gemm(Frame& F, const bf16* A, int lda, const bf16* Bt, int K, int nM, int nN, const Epi& E) {
    pg8::Gemm g{A, Bt, K, lda}; pg8::StaticOrder S; S.init(nM, nN, F.G, (int)blockIdx.x, K, lda);
    pg8::gemm_phase<Epi, pg8::StaticOrder, false, true>(F.lds, g, S, E);
}
template <bool ABLK = false>
__device__ __forceinline__ void run_gemm_res(Frame& F, const bf16* A, int lda, const bf16* Bt, int K, const float* gate) {
    pg8::Gemm g{A, Bt, K, lda}; pg8::ResOrder S; S.init2(F.G, (int)blockIdx.x, K, lda); S.ablk = ABLK;
    pg8::EpiRes E{(bf16*)(F.ws + WS_X), gate, 0, (float*)(F.ws + WS_OFB)};
    pg8::gemm_phase<pg8::EpiRes, pg8::ResOrder, false, true, ABLK>(F.lds, g, S, E);
}
__device__ __forceinline__ void moe_gemms_gu(Frame& F, gu32* cnt, const bf16* Wgu) {
    int ts[9], cn[8]; moe_offsets(cnt, ts, cn);
    pg8::MoeOrder S; S.init(ts[8], 2 * EFF / 256, F.G, (int)blockIdx.x, 1024, 1024);
#pragma unroll
    for (int j = 0; j < 9; ++j) S.ts[j] = ts[j];
    S.estride = (size_t)2 * EFF * 1024 * 2; S.rowidx = (const int*)(F.ws + WS_ROWIDX);
    pg8::Gemm g{(const bf16*)(F.ws + WS_H), Wgu, 1024, 1024};
    pg8::EpiSwiglu E{(bf16*)(F.ws + MOE_HID), EFF, true};
    pg8::gemm_phase<pg8::EpiSwiglu, pg8::MoeOrder, true, true>(F.lds, g, S, E);
}
constexpr size_t MOE_YP = WS_OFB;
__device__ __forceinline__ void moe_gemms_down(Frame& F, gu32* cnt, const bf16* Wd) {
    int ts[9], cn[8]; moe_offsets(cnt, ts, cn);
    pg8::MoeDownOrder S; S.init(ts[8], 4, F.G, (int)blockIdx.x, EFF, EFF);
#pragma unroll
    for (int j = 0; j < 9; ++j) S.ts[j] = ts[j];
    S.estride = (size_t)1024 * EFF * 2; S.rowidx = nullptr;
    pg8::Gemm g{(const bf16*)(F.ws + MOE_HID), Wd, EFF, EFF};
    pg8::EpiY E{(bf16*)(F.ws + MOE_Y), (float*)(F.ws + MOE_YP), pg8::MoeDownOrder::NFULL, (size_t)4096 * 1024};
    pg8::gemm_phase<pg8::EpiY, pg8::MoeDownOrder, false, true, true>(F.lds, g, S, E);
}
template <bool NODMA = false>
__device__ __forceinline__ void attn_phase(Frame& F) {
    const bf16* Q = (const bf16*)(F.ws + MLA_Q); const bf16* KV = (const bf16*)(F.ws + MLA_KV); bf16* O = NODMA ? (bf16*)(F.ws + WS_MIX) : (bf16*)(F.ws + MLA_O);
    const f32x2* ropem = (const f32x2*)(F.ws + WS_ROPE) + 64 * 64;
    for (int i = 0;; ++i) { const int L = i * F.G + F.vcu; if (L >= 544) break;
        int qrow0, hh, b, nk;
        if (L < 512) { const int qb = L & 15; hh = (L >> 4) & 7; b = L >> 7; qrow0 = NCTX + b * SEQ + qb * 256; nk = TT; }
        else { const int Lc = L - 512; hh = Lc & 7; b = Lc >> 3; qrow0 = b * CTXL; nk = CTXL; }
        att::attn_unit<NODMA>(Q, KV, O, ropem, qrow0, hh, b * CTXL, NCTX + b * SEQ, nk, F.lds); }
}

__global__ void __launch_bounds__(NWAVES * 64, 2) mega_fwd(Args args) {
    extern __shared__ __attribute__((aligned(16))) unsigned char lds[];
    Frame F;
    F.lds = (LAS unsigned char*)lds; F.ws = args.ws;
    F.tid = threadIdx.x; F.lane = F.tid & 63; F.wave = __builtin_amdgcn_readfirstlane(F.tid >> 6);
    F.G = gridDim.x; { const int bx = blockIdx.x; F.vcu = (F.G % 8 == 0) ? (bx % 8) * (F.G / 8) + bx / 8 : bx; }
    F.ctl = (gu32*)(args.ws + WS_CTL);
    for (int u = F.tid; u < (LDS_BYTES - LDSCTL_OFF) / 4; u += NWAVES * 64) ((LAS unsigned*)(F.lds + LDSCTL_OFF))[u] = 0u;
    __syncthreads();
    const int lo = args.ph_lo, hi = args.ph_hi;
    XcdBarrier bar; bar.bar = (unsigned*)(F.ctl + CW_BAR) + args.li * XCD_BAR_WORDS; bar.x = 0; bar.st = (volatile LAS unsigned*)(F.lds + MISC_OFF + 32);
    if (hi - lo > 1) bar = xcd_barrier_post((unsigned*)(F.ctl + CW_BAR) + args.li * XCD_BAR_WORDS, (volatile LAS unsigned*)(F.lds + MISC_OFF + 32));
    unsigned char* ws = args.ws;
    struct InPtr { __device__ __forceinline__ const float* operator[](int k) const { int kk = k; asm volatile("" : "+s"(kk));
        const __attribute__((address_space(4))) char* ka = (const __attribute__((address_space(4))) char*)__builtin_amdgcn_kernarg_segment_ptr();
        return *(const float* const __attribute__((address_space(4)))*)(ka + 8 * kk); } } in;
    float* mod = (float*)(ws + WS_MOD); bf16* X = (bf16*)(ws + WS_X); bf16* H = (bf16*)(ws + WS_H); bf16* BIG = (bf16*)(ws + WS_BIG); bf16* MIX = (bf16*)(ws + WS_MIX);
    int* tok_e = (int*)(ws + WS_TOK); float* tok_w = (float*)(tok_e + 2 * NR); int* tok_rank = tok_e + 4 * NR; int* tok_slot = tok_e + 6 * NR;
#ifndef PH_MASK
#define PH_MASK 0xFFFFFFFFFFFFFFFFull
#endif
#define IN(k) ((((PH_MASK) >> (k)) & 1ull) && lo <= (k) && (k) < hi)
#define SEAM(k) do { if ((k) + 1 < hi) xcd_barrier(bar); } while (0)
#ifndef REP_PRO
#define REP_PRO 1
#endif
#ifndef REP_SCAN
#define REP_SCAN 1
#endif
#ifndef REP_GATE
#define REP_GATE 1
#endif
#ifndef REP_ATT
#define REP_ATT 1
#endif
#ifndef REP_GEMM
#define REP_GEMM 1
#endif
#ifndef REP_MOD
#define REP_MOD 1
#endif
#ifndef REP_SGU
#define REP_SGU 1
#endif
#define REPEAT(n) for (int _r = 0; _r < (n); ++_r, (_r < (n) ? xcd_barrier(bar) : (void)0)) if (({ asm volatile("" : "+v"(F.tid), "+v"(F.lane)); true; }))
#define MODP(layer, k) (mod + (size_t)(layer) * 5 * 6144 + (k) * 1024)
#define WB(off) ((const bf16*)(ws + (off)))

    if (IN(P_PRO)) { REPEAT(REP_PRO) { p0_prologue(F, in); } SEAM(P_PRO); }
    if (IN(P0_MOD)) { REPEAT(REP_MOD) { RowArgs a{}; a.normg = in[6]; a.shift = MODP(0, 0); a.scale = MODP(0, 1); a.row_lo = 0; a.row_hi = NR; rows_phase<false, false, false>(F, a); } SEAM(P0_MOD); }
#ifndef REP_WIN
#define REP_WIN REP_GEMM
#endif
#ifndef REP_GU
#define REP_GU REP_GEMM
#endif
#ifndef REP_MGU
#define REP_MGU REP_GEMM
#endif
#ifndef REP_MDN
#define REP_MDN REP_GEMM
#endif
#ifndef REP_WINNULL
#define REP_WINNULL 0
#endif
#ifndef REP_WINHALF
#define REP_WINHALF 0
#endif
    if (IN(P0_WIN)) { for (int _q = 0; _q < REP_WINHALF; ++_q) {
            if ((blockIdx.x & 8) == 0) { pg8::Gemm g{H, WB(W_RETIN), 1024, 1024}; pg8::StaticOrder S; S.init(68, 32, F.G / 2, (int)((blockIdx.x >> 4) * 8 + (blockIdx.x & 7)), 1024, 1024);
                pg8::EpiQKVG E{(bf16*)(ws + RET_QKV), (bf16*)(ws + RET_G), NR}; pg8::gemm_phase<pg8::EpiQKVG, pg8::StaticOrder, false, true>(F.lds, g, S, E); }
            xcd_barrier(bar); }
#ifndef REP_WINSHAPE
#define REP_WINSHAPE 0
#endif
#ifndef SHAPE_MODE
#define SHAPE_MODE 0
#endif
      for (int _q = 0; _q < REP_WINSHAPE; ++_q) { run_gemm(F, H, 1024, WB(W_RETIN), 1024, 68, 32, pg8::EpiShape<SHAPE_MODE>{(bf16*)(ws + RET_QKV)}); xcd_barrier(bar); }
      for (int _q = 0; _q < REP_WINNULL; ++_q) { run_gemm(F, H, 1024, WB(W_RETIN), 1024, 68, 32, pg8::EpiNull{(float*)(ws + WS_RSTD)}); xcd_barrier(bar); }
      REPEAT(REP_WIN) { run_gemm(F, H, 1024, WB(W_RETIN), 1024, 68, 32, pg8::EpiQKVG{(bf16*)(ws + RET_QKV), (bf16*)(ws + RET_G), NR}); } SEAM(P0_WIN); }
#ifndef REP_PREP
#define REP_PREP 1
#endif
    if (IN(P0_PREP)) { REPEAT(REP_PREP) { ret_prep(F); } SEAM(P0_PREP); }
#ifndef REP_SCANDRY
#define REP_SCANDRY 0
#endif
#ifndef SCANDRY_MODE
#define SCANDRY_MODE 1
#endif
    if (IN(P0_SCAN)) { for (int _q = 0; _q < REP_SCANDRY; ++_q) { ret_scan<SCANDRY_MODE>(F, 0, in[11], in[12], true); xcd_barrier(bar); }
      REPEAT(REP_SCAN) { ret_scan(F, 0, in[11], in[12], true); } SEAM(P0_SCAN); }
#ifndef GATE_PROBE
#define GATE_PROBE 0
#endif
#ifndef REP_GATEPROBE
#define REP_GATEPROBE 0
#endif
    if (IN(P0_GATE)) { for (int _q = 0; _q < REP_GATEPROBE; ++_q) { ret_gate<GATE_PROBE>(F, in[13], in[14], 0); xcd_barrier(bar); }
      REPEAT(REP_GATE) { ret_gate(F, in[13], in[14], 0); } SEAM(P0_GATE); }
    if (IN(P0_WO)) { run_gemm_res(F, MIX, 2048, WB(W_RETO), 2048, MODP(0, 2)); SEAM(P0_WO); }
    if (IN(P0_MOD2)) { REPEAT(REP_MOD) { RowArgs a{}; a.normg = in[7]; a.shift = MODP(0, 3); a.scale = MODP(0, 4); a.row_lo = 0; a.row_hi = NR; a.ctx_nsplit = 8; a.ctx_gate = MODP(0, 2); rows_phase<false, false, false>(F, a); } SEAM(P0_MOD2); }
    if (IN(P0_GU)) { REPEAT(REP_GU) { run_gemm(F, H, 1024, WB(W_FFNGU), 1024, 68, 22, pg8::EpiSwigluD{(bf16*)(ws + FFN_HID), DFF}); } SEAM(P0_GU); }
    if (IN(P0_DOWN)) { run_gemm_res<true>(F, WB(FFN_HID), DFF, WB(W_FFND), DFF, MODP(0, 5)); SEAM(P0_DOWN); }
    if (IN(P1_MOD)) { REPEAT(REP_MOD) { RowArgs a{}; a.normg = in[6] + 1024; a.shift = MODP(1, 0); a.scale = MODP(1, 1); a.row_lo = 0; a.row_hi = NR; a.ctx_nsplit = 11; a.ctx_gate = MODP(0, 5); rows_phase<false, false, false>(F, a); } SEAM(P1_MOD); }
    if (IN(P1_WD)) { REPEAT(REP_GEMM) { run_gemm(F, H, 1024, WB(W_MLAD), 1024, 68, 3, pg8::EpiF32{(float*)(ws + MLA_CKV), 768, nullptr, 0, 0}); } SEAM(P1_WD); }
    if (IN(P1_ROWS)) { mla_rows(F, in[16], in[17]); SEAM(P1_ROWS); }
    if (IN(P1_UQ)) { REPEAT(REP_GEMM) {
        const bf16* A0 = WB(MLA_CQN); const bf16* A1 = WB(MLA_CKVN); const bf16* B0 = WB(W_UQ); const bf16* B1 = WB(W_UKV);
        pg8::Gemm g{A0, B0, 256, 256}; pg8::SguOrder S; S.su.init(68, 6, 1, 0, 256, 256); S.sv.init(68, 8, 1, 0, 256, 256); S.G = F.G; S.c = (int)blockIdx.x; S.nwg = S.su.nwg + S.sv.nwg;
        S.dA = (size_t)((const char*)A1 - (const char*)A0); S.dB = (size_t)((const char*)B1 - (const char*)B0);
        typedef pg8::EpiPair<pg8::EpiBf16<0>, pg8::EpiBf16<0>> EpiQKV;
        EpiQKV E{pg8::EpiBf16<0>{(bf16*)(ws + MLA_Q), 1536}, pg8::EpiBf16<0>{(bf16*)(ws + MLA_KV), KVR_LD}};
        pg8::gemm_phase<EpiQKV, pg8::SguOrder, false, true>(F.lds, g, S, E); } SEAM(P1_UQ); }
#ifndef REP_ATTNODMA
#define REP_ATTNODMA 0
#endif
    if (IN(P1_ATT)) { for (int _q = 0; _q < REP_ATTNODMA; ++_q) { attn_phase<true>(F); xcd_barrier(bar); }
      REPEAT(REP_ATT) { attn_phase(F); } SEAM(P1_ATT); }
    if (IN(P1_WO)) { run_gemm_res(F, WB(MLA_O), 1024, WB(W_MLAO), 1024, MODP(1, 2)); SEAM(P1_WO); }
    if (IN(P1_MOD2)) { RowArgs a{}; a.normg = in[7] + 1024; a.shift = MODP(1, 3); a.scale = MODP(1, 4); a.row_lo = 0; a.row_hi = NR;
                  a.w_router = in[28]; a.tok_e = tok_e; a.tok_wo = tok_w; a.tok_rank = tok_rank; a.cnt = F.ctl + CW_MOECNT; a.ctx_nsplit = 4; a.ctx_gate = MODP(1, 2); rows_phase<false, true, false>(F, a); SEAM(P1_MOD2); }
    if (IN(P1_LIST)) { moe_lists(F, F.ctl + CW_MOECNT, 0, NR); SEAM(P1_LIST); }
#if defined(PROBE_SLEEP_US)
    if (IN(P1_MGU)) { const unsigned long long t0 = __builtin_amdgcn_s_memrealtime(); while (__builtin_amdgcn_s_memrealtime() - t0 < (unsigned long long)PROBE_SLEEP_US * 100ull) __builtin_amdgcn_s_sleep(32); }
#endif
    if (IN(P1_MGU)) { REPEAT(REP_MGU) { moe_gemms_gu(F, F.ctl + CW_MOECNT, WB(W_MOEGU)); } SEAM(P1_MGU); }
    if (IN(P1_MDN)) { REPEAT(REP_MDN) { moe_gemms_down(F, F.ctl + CW_MOECNT, WB(W_MOED)); } SEAM(P1_MDN); }
    if (IN(P2_MOD)) { RowArgs a{}; a.normg = in[6] + 2048; a.shift = MODP(2, 0); a.scale = MODP(2, 1); a.row_lo = 0; a.row_hi = NR;
                  a.gate_prev = MODP(1, 5); a.Y = (const bf16*)(ws + MOE_Y); a.tok_slot = tok_slot; a.tok_w = tok_w; rows_phase<true, false, false>(F, a); SEAM(P2_MOD); }
#ifndef REP_SGUIN
#define REP_SGUIN 1
#endif
    if (IN(P2_WIN)) { REPEAT(REP_SGUIN) {
        const bf16* Wu = WB(W_SGUIN); const bf16* Wv = WB(W_SGUIN + (size_t)3072 * 1024 * 2);
        pg8::Gemm g{H, Wu, 1024, 1024}; pg8::SguOrder S; S.su.init(68, 12, 1, 0, 1024, 1024); S.sv.init(12, 68, 1, 0, 1024, 1024); S.G = F.G; S.c = (int)blockIdx.x; S.nwg = S.su.nwg + S.sv.nwg;
        S.dA = (size_t)((const char*)Wv - (const char*)H); S.dB = (size_t)((const char*)H - (const char*)Wu);
        pg8::EpiSguIn E{pg8::EpiBf16<3>{(bf16*)(ws + SGU_UV), 3072}, pg8::EpiVT{(bf16*)(ws + SGU_VT), 3072, (float*)(ws + SGU_SSQ), NR}};
        pg8::gemm_phase<pg8::EpiSguIn, pg8::SguOrder, false, true, false, false>(F.lds, g, S, E); } SEAM(P2_WIN); }
    if (IN(P2_SPA)) { REPEAT(REP_SGU) { sgu_spatial(F, in[22], in[24]); } SEAM(P2_SPA); }
    if (IN(P2_WOUT)) { run_gemm_res(F, WB(SGU_UZ), 3072, WB(W_SGUOUT), 3072, MODP(2, 2)); SEAM(P2_WOUT); }
    if (IN(P2_MOD2)) { REPEAT(REP_MOD) { RowArgs a{}; a.normg = in[7] + 2048; a.shift = MODP(2, 3); a.scale = MODP(2, 4); a.row_lo = 0; a.row_hi = NR; a.ctx_nsplit = 12; a.ctx_gate = MODP(2, 2); rows_phase<false, false, false>(F, a); } SEAM(P2_MOD2); }
    if (IN(P2_GU)) { REPEAT(REP_GEMM) { run_gemm(F, H, 1024, WB(W_FFNGU + (size_t)2 * DFF * 1024 * 2), 1024, 68, 22, pg8::EpiSwigluD{(bf16*)(ws + FFN_HID), DFF}); } SEAM(P2_GU); }
    if (IN(P2_DOWN)) { run_gemm_res<true>(F, WB(FFN_HID), DFF, WB(W_FFND + (size_t)1024 * DFF * 2), DFF, MODP(2, 5)); SEAM(P2_DOWN); }
    if (IN(P3_MOD)) { REPEAT(REP_MOD) { RowArgs a{}; a.normg = in[6] + 3072; a.shift = MODP(3, 0); a.scale = MODP(3, 1); a.row_lo = 0; a.row_hi = NR; a.ctx_nsplit = 11; a.ctx_gate = MODP(2, 5); rows_phase<false, false, false>(F, a); } SEAM(P3_MOD); }
    if (IN(P3_WIN)) { REPEAT(REP_GEMM) { run_gemm(F, H, 1024, WB(W_RETIN + (size_t)RET_NIN * 1024 * 2), 1024, 68, 32, pg8::EpiQKVG{(bf16*)(ws + RET_QKV), (bf16*)(ws + RET_G), NR}); } SEAM(P3_WIN); }
    if (IN(P3_PREP)) { REPEAT(REP_PREP) { ret_prep(F); } SEAM(P3_PREP); }
#ifndef REP_SCAN3
#define REP_SCAN3 REP_SCAN
#endif
    if (IN(P3_SCAN)) { REPEAT(REP_SCAN3) { ret_scan(F, 1, in[11], in[12], false); } SEAM(P3_SCAN); }
    if (IN(P3_GATE)) { REPEAT(REP_GATE) { ret_gate(F, in[13] + 2048, in[14] + 2048, NCTX); } SEAM(P3_GATE); }
    if (IN(P3_WO)) { run_gemm(F, MIX + (size_t)NCTX * 2048, 2048, WB(W_RETO + (size_t)1024 * 2048 * 2), 2048, 64, 4, pg8::EpiRes{X + (size_t)NCTX * 1024, MODP(3, 2), 4, nullptr}); SEAM(P3_WO); }
    if (IN(P3_MOD2)) { RowArgs a{}; a.normg = in[7] + 3072; a.shift = MODP(3, 3); a.scale = MODP(3, 4); a.row_lo = NCTX; a.row_hi = NR;
                  a.w_router = in[28] + 8192; a.tok_e = tok_e; a.tok_wo = tok_w; a.tok_rank = tok_rank; a.cnt = F.ctl + CW_MOECNT + 512; rows_phase<false, true, false>(F, a); SEAM(P3_MOD2); }
    if (IN(P3_LIST)) { moe_lists(F, F.ctl + CW_MOECNT + 512, NCTX, NR); SEAM(P3_LIST); }
    if (IN(P3_MGU)) { REPEAT(REP_GEMM) { moe_gemms_gu(F, F.ctl + CW_MOECNT + 512, WB(W_MOEGU + (size_t)8 * 2 * EFF * 1024 * 2)); } SEAM(P3_MGU); }
    if (IN(P3_MDN)) { REPEAT(REP_GEMM) { moe_gemms_down(F, F.ctl + CW_MOECNT + 512, WB(W_MOED + (size_t)8 * 1024 * EFF * 2)); } SEAM(P3_MDN); }
    if (IN(P3_FIN)) { RowArgs a{}; a.normg = in[8]; a.row_lo = NCTX; a.row_hi = NR; a.gate_prev = MODP(3, 5); a.Y = (const bf16*)(ws + MOE_Y); a.tok_slot = tok_slot; a.tok_w = tok_w; a.out = args.out;
                  rows_phase<true, false, true>(F, a); }
#undef IN
#undef SEAM
#undef MODP
#undef WB
}

#ifndef MK_PER_PHASE
#define MK_PER_PHASE 0
#endif
extern "C" void kernel_launch(void* const* d_in, const int* in_sizes, int n_in, void* d_out, int out_size, void* d_ws, size_t ws_size, hipStream_t stream) {
    static int grid = 0;
    if (grid == 0) {
        if (n_in != 31 || out_size != NLAT * D || ws_size < WS_END) { fprintf(stderr, "kernel_launch: unexpected shapes: n_in %d out %d ws %zu (need %zu)\n", n_in, out_size, ws_size, (size_t)WS_END); grid = -1; return; }
        int dev = 0, cus = 0, per_cu = 0;
        if (hipGetDevice(&dev) != hipSuccess || hipDeviceGetAttribute(&cus, hipDeviceAttributeMultiprocessorCount, dev) != hipSuccess) { grid = -1; return; }
        if (hipFuncSetAttribute((const void*)mega_fwd, hipFuncAttributeMaxDynamicSharedMemorySize, LDS_BYTES) != hipSuccess) { fprintf(stderr, "kernel_launch: hipFuncSetAttribute failed\n"); grid = -1; return; }
        if (hipOccupancyMaxActiveBlocksPerMultiprocessor(&per_cu, (const void*)mega_fwd, NWAVES * 64, LDS_BYTES) != hipSuccess || per_cu < 1)
            fprintf(stderr, "kernel_launch: note: occupancy query reports %d workgroups per CU\n", per_cu);
        (void)hipGetLastError();
        grid = cus;
    }
    if (grid < 0) return;
    if (hipMemsetAsync((char*)d_ws + WS_CTL, 0, CTL_ZERO_BYTES, stream) != hipSuccess) return;
    Args a{};
    for (int i = 0; i < 31; ++i) a.in[i] = (const float*)d_in[i];
    a.out = (float*)d_out; a.ws = (unsigned char*)d_ws; a.pad = 0;
#if MK_PER_PHASE
    for (int p = 0; p < NPH; ++p) { a.ph_lo = p; a.ph_hi = p + 1; a.li = 0; hipLaunchKernelGGL(mega_fwd, dim3(grid), dim3(NWAVES * 64), LDS_BYTES, stream, a); }
#else
    a.ph_lo = 0; a.ph_hi = NPH; a.li = 0; hipLaunchKernelGGL(mega_fwd, dim3(grid), dim3(NWAVES * 64), LDS_BYTES, stream, a);
#endif
    const hipError_t le = hipPeekAtLastError();
    if (le != hipSuccess) fprintf(stderr, "kernel_launch: launch failed: %s\n", hipGetErrorName(le));
}
```

```cpp
#include <hip/hip_runtime.h>
#include <cstdio>
#include <cstdint>

namespace pg8 {
#define PG8_LAS __attribute__((address_space(3)))
typedef unsigned short bf16_t;
typedef short bf16x8 __attribute__((ext_vector_type(8)));
typedef float f32x4 __attribute__((ext_vector_type(4)));
typedef float f32x2 __attribute__((ext_vector_type(2)));
typedef unsigned u32x4 __attribute__((ext_vector_type(4)));
typedef unsigned u32x2 __attribute__((ext_vector_type(2)));
constexpr int BM = 256, BK = 64, HALF = 128, HTB = HALF * BK * 2  , STAGE_BYTES = 8 * HTB, NXCD = 8;
#ifndef PG8_WGM
#define PG8_WGM 8
#endif
constexpr int WGM = PG8_WGM;

__host__ __device__ __forceinline__ int lds_byte(int r, int c) { const int st = (r >> 4) * 2 + (c >> 5), rr = r & 15, cc = c & 31, ob = rr * 64 + cc * 2; return st * 1024 + (ob ^ (((ob >> 9) & 1) << 5)); }
__host__ __device__ __forceinline__ void stage_rc(int b, int& R, int& C) { const int st = b / 1024, sb = b % 1024, swz = sb ^ (((sb >> 9) & 1) << 5); R = (st >> 1) * 16 + swz / 64; C = (st & 1) * 32 + (swz % 64) / 2; }
__host__ __device__ __forceinline__ int perm32(int rho) { const int n = rho >> 4, i = rho & 15; return 8 * (i >> 2) + 4 * n + (i & 3); }

#define NDEFER_DEFAULT_ 0
struct Unit { int pm, pn, ks; };
struct Gemm { const bf16_t* A; const bf16_t* Bt; int K, lda; };

struct StaticOrder {
    int nM, nN, nwg, G, c; size_t tA, tB;
    __device__ void init(int nM_, int nN_, int G_, int c_, int K, int lda) { nM = nM_; nN = nN_; nwg = nM * nN; G = G_; c = c_; tA = (size_t)BM * lda * 2; tB = (size_t)BM * K * 2; }
    __device__ bool next(int i, Unit& u) const {
        const long L = (long)i * G + c; if (L >= nwg) return false;
        int wgid = (int)L;
#if !defined(PG8_NOREMAP)
        { const int q = nwg / NXCD, r = nwg % NXCD, xcd = wgid % NXCD, off = wgid / NXCD; wgid = (xcd < r ? xcd * (q + 1) : r * (q + 1) + (xcd - r) * q) + off; }
#endif
        const int nig = WGM * nN, gid = wgid / nig, fm = gid * WGM, gsz = (nM - fm) < WGM ? (nM - fm) : WGM;
        u.pm = fm + ((wgid % nig) % gsz); u.pn = (wgid % nig) / gsz; u.ks = -1; return true;
    }
    __device__ __forceinline__ int nkt(const Unit&) const { return (int)(tB / (BM * 2)) / BK; }
    __device__ __forceinline__ size_t aofs(const Unit& u) const { return (size_t)u.pm * tA; }
    __device__ __forceinline__ size_t bofs(const Unit& u) const { return (size_t)u.pn * tB; }
    __device__ __forceinline__ int arow(const Unit& u, int r) const { return u.pm * BM + r; }
};
struct ResOrder : StaticOrder {
    int nsplit; bool ablk = false;
    __device__ void init2(int G_, int c_, int K, int lda) { init(64, 4, G_, c_, K, lda); nsplit = K / 256; }
    __device__ bool next(int i, Unit& u) const {
        if (StaticOrder::next(i, u)) { u.pm += 4; return true; }
        const long L = (long)i * G + c - nwg; if (L < 0 || L >= 16 * nsplit) return false;
        const int l = (int)L; u.ks = l % nsplit; u.pn = (l / nsplit) & 3; u.pm = l / (4 * nsplit); return true;
    }
    __device__ __forceinline__ int nkt(const Unit& u) const { return u.ks < 0 ? StaticOrder::nkt(u) : 4; }
    __device__ __forceinline__ size_t aofs(const Unit& u) const { return (size_t)u.pm * tA + (u.ks < 0 ? (size_t)0 : (size_t)u.ks * (ablk ? (size_t)4 * BM * BK * 2 : (size_t)512)); }
    __device__ __forceinline__ size_t bofs(const Unit& u) const { return (size_t)u.pn * tB + (u.ks < 0 ? (size_t)0 : (size_t)u.ks * 4 * BM * BK * 2); }
};
struct SguOrder {
    StaticOrder su, sv; int G, c, nwg; size_t dA, dB;
    __device__ bool next(int i, Unit& u) const {
        const long L = (long)i * G + c;
        if (L < su.nwg) { StaticOrder t = su; t.G = 1; t.c = 0; return t.next((int)L, u); }
        if (L >= su.nwg + sv.nwg) return false;
        StaticOrder t = sv; t.G = 1; t.c = 0; t.next((int)(L - su.nwg), u); u.ks = -2; return true;
    }
    __device__ __forceinline__ int nkt(const Unit& u) const { return su.nkt(u); }
    __device__ __forceinline__ size_t aofs(const Unit& u) const { return u.ks == -2 ? dA + sv.aofs(u) : su.aofs(u); }
    __device__ __forceinline__ size_t bofs(const Unit& u) const { return u.ks == -2 ? dB + sv.bofs(u) : su.bofs(u); }
    __device__ __forceinline__ int arow(const Unit& u, int r) const { return 0; }
};
struct MoeOrder : StaticOrder {
    int ts[9]; size_t estride; const int* rowidx;
    __device__ __forceinline__ int expert(int pm) const { int e = 0;
#pragma unroll
        for (int j = 1; j < 8; ++j) e += (pm >= ts[j]) ? 1 : 0; return e; }
    __device__ __forceinline__ size_t bofs(const Unit& u) const { return (size_t)expert(u.pm) * estride + (size_t)u.pn * tB; }
    __device__ __forceinline__ int arow(const Unit& u, int r) const { return rowidx[u.pm * BM + r]; }
};

struct MoeDownOrder : MoeOrder {
    static constexpr int NFULL = 128, KS = 4, KCH = 896;
    __device__ bool next(int i, Unit& u) const {
        const long L = (long)i * G + c; const int nf = nM < NFULL ? nM : NFULL;
#if !defined(MDN_NOXCD)
        if (G == 256 && nf == NFULL) {
            const int x = c & 7, k = c >> 3;
            if (i < 2) { u.pm = i * 64 + x * 8 + (k >> 2); u.pn = k & 3; u.ks = -1; return true; }
            const int pm = nf + ((i - 2) * 8 + x) * 2 + (k >> 4);
            if (pm >= nM) return false;
            u.pm = pm; u.pn = (k >> 2) & 3; u.ks = k & 3; return true;
        }
#endif
        if (L < (long)nf * 4) { u.pm = (int)(L >> 2); u.pn = (int)(L & 3); u.ks = -1; return true; }
        const long l = L - (long)nf * 4; if (l >= (long)(nM - nf) * 4 * KS) return false;
        u.pm = nf + (int)(l / (4 * KS)); u.pn = (int)((l / KS) & 3); u.ks = (int)(l % KS); return true;
    }
    __device__ __forceinline__ int nkt(const Unit& u) const { return u.ks < 0 ? StaticOrder::nkt(u) : KCH / BK; }
    __device__ __forceinline__ size_t aofs(const Unit& u) const { return (size_t)u.pm * tA + (u.ks < 0 ? (size_t)0 : (size_t)u.ks * (KCH / BK) * (BM * BK * 2)); }
    __device__ __forceinline__ size_t bofs(const Unit& u) const { return MoeOrder::bofs(u) + (u.ks < 0 ? (size_t)0 : (size_t)u.ks * (KCH / BK) * (BM * BK * 2)); }
};
__device__ __forceinline__ unsigned cvt_pk_bf16(float lo, float hi) { unsigned r; asm volatile("v_cvt_pk_bf16_f32 %0, %1, %2" : "=v"(r) : "v"(lo), "v"(hi)); return r; }
__device__ __forceinline__ float fast_sigmoid(float x) { return __builtin_amdgcn_rcpf(1.0f + __builtin_amdgcn_exp2f(-1.4426950408889634f * x)); }
__device__ __forceinline__ float gelu_tanh(float x) { constexpr float B = -2.0f * 1.4426950408889634f * 0.7978845608028654f, A = B * 0.044715f;
    const float t = x * __builtin_fmaf(x * x, A, B); return x * __builtin_amdgcn_rcpf(1.0f + __builtin_amdgcn_exp2f(t)); }

struct EpiF32 {
    static constexpr bool PERM = false;
    static constexpr int NDEFER = NDEFER_DEFAULT_;
    float* C; int ldc; float* part; int part_tile0; size_t part_stride;
    __device__ __forceinline__ void operator()(const f32x4 (&acc)[2][2][4][2], const Unit& u, int wr, int wc, int fr, int fq) const {
        const int col0 = u.pn * BM + wc * 32 + 4 * fq; int row0 = u.pm * BM + wr * 64 + fr; float* C = this->C;
        if (u.ks >= 0) { C = part + (size_t)u.ks * part_stride; row0 -= part_tile0 * BM; }
#pragma unroll
        for (int ai = 0; ai < 2; ++ai)
#pragma unroll
            for (int m = 0; m < 4; ++m) { float* rowp = C + (size_t)(row0 + ai * HALF + m * 16) * ldc + col0;
#pragma unroll
                for (int bj = 0; bj < 2; ++bj)
#pragma unroll
                    for (int n = 0; n < 2; ++n) *(f32x4*)(rowp + bj * HALF + n * 16) = acc[ai][bj][m][n]; }
    }
};
template <int ACT  > struct EpiBf16 {
    static constexpr bool PERM = true;
    static constexpr int NDEFER = NDEFER_DEFAULT_;
    bf16_t* O; int ldc; bf16_t* O2 = nullptr; int split_tile = 1 << 30;
    __device__ __forceinline__ void operator()(const f32x4 (&acc)[2][2][4][2], const Unit& u, int wr, int wc, int fr, int fq) const {
        const bool second = u.pn >= split_tile; bf16_t* O = second ? this->O2 : this->O;
        const int row0 = u.pm * BM + wr * 64 + fr, col0 = (second ? u.pn - split_tile : u.pn) * BM + wc * 32 + 8 * fq;
#pragma unroll
        for (int ai = 0; ai < 2; ++ai)
#pragma unroll
            for (int m = 0; m < 4; ++m) { bf16_t* rowp = O + (size_t)(row0 + ai * HALF + m * 16) * ldc + col0;
#pragma unroll
                for (int bj = 0; bj < 2; ++bj) { f32x4 v0 = acc[ai][bj][m][0], v1 = acc[ai][bj][m][1];
                    if (ACT == 3) {
#pragma unroll
                        for (int j = 0; j < 4; ++j) { v0[j] = gelu_tanh(v0[j]); v1[j] = gelu_tanh(v1[j]); } }
                    u32x4 w; w.x = cvt_pk_bf16(v0[0], v0[1]); w.y = cvt_pk_bf16(v0[2], v0[3]); w.z = cvt_pk_bf16(v1[0], v1[1]); w.w = cvt_pk_bf16(v1[2], v1[3]);
#if defined(PG8_NTSTORE)
                    __builtin_nontemporal_store(w, (u32x4*)(rowp + bj * HALF)); } }
#else
                    *(u32x4*)(rowp + bj * HALF) = w; } }
#endif
    }
};
struct EpiVT {
    static constexpr bool PERM = true;
    static constexpr int NDEFER = NDEFER_DEFAULT_;
    bf16_t* O; int ldc; float* ssq; int nr;
    __device__ __forceinline__ void operator()(const f32x4 (&acc)[2][2][4][2], const Unit& u, int wr, int wc, int fr, int fq) const {
        const int row0 = u.pm * BM + wr * 64 + fr, col0 = u.pn * BM + wc * 32 + 8 * fq;
        float sq[2][8];
#pragma unroll
        for (int bj = 0; bj < 2; ++bj)
#pragma unroll
            for (int j = 0; j < 8; ++j) sq[bj][j] = 0.f;
#pragma unroll
        for (int ai = 0; ai < 2; ++ai)
#pragma unroll
            for (int m = 0; m < 4; ++m) { bf16_t* rowp = O + (size_t)(col0 >> 7) * ((size_t)ldc * 128) + (size_t)(row0 + ai * HALF + m * 16) * 128 + (col0 & 127);
#pragma unroll
                for (int bj = 0; bj < 2; ++bj) { f32x4 v0 = acc[ai][bj][m][0], v1 = acc[ai][bj][m][1];
#pragma unroll
                    for (int j = 0; j < 4; ++j) { v0[j] = gelu_tanh(v0[j]); v1[j] = gelu_tanh(v1[j]); sq[bj][j] += v0[j] * v0[j]; sq[bj][4 + j] += v1[j] * v1[j]; }
                    u32x4 w; w.x = cvt_pk_bf16(v0[0], v0[1]); w.y = cvt_pk_bf16(v0[2], v0[3]); w.z = cvt_pk_bf16(v1[0], v1[1]); w.w = cvt_pk_bf16(v1[2], v1[3]);
                    *(u32x4*)(rowp + (size_t)bj * ((size_t)ldc * 128)) = w; } }
#pragma unroll
        for (int bj = 0; bj < 2; ++bj) {
#pragma unroll
            for (int j = 0; j < 8; ++j) { float v = sq[bj][j];
                v += __builtin_bit_cast(float, __builtin_amdgcn_update_dpp(0, __builtin_bit_cast(int, v), 0x128, 0xf, 0xf, false));
                v += __builtin_bit_cast(float, __builtin_amdgcn_update_dpp(0, __builtin_bit_cast(int, v), 0x124, 0xf, 0xf, false));
                v += __builtin_bit_cast(float, __builtin_amdgcn_update_dpp(0, __builtin_bit_cast(int, v), 0x122, 0xf, 0xf, false));
                v += __builtin_bit_cast(float, __builtin_amdgcn_update_dpp(0, __builtin_bit_cast(int, v), 0x121, 0xf, 0xf, false));
                sq[bj][j] = v; }
            if (fr == 0) { float* sp = ssq + (size_t)(2 * u.pm + wr) * nr + col0 + bj * HALF;
                *(f32x4*)sp = (f32x4){sq[bj][0], sq[bj][1], sq[bj][2], sq[bj][3]}; *(f32x4*)(sp + 4) = (f32x4){sq[bj][4], sq[bj][5], sq[bj][6], sq[bj][7]}; } }
    }
};
struct EpiSguIn {
    static constexpr bool PERM = true;
    static constexpr int NDEFER = NDEFER_DEFAULT_;
    EpiBf16<3> eu; EpiVT ev;
    __device__ __forceinline__ void operator()(const f32x4 (&acc)[2][2][4][2], const Unit& u, int wr, int wc, int fr, int fq) const {
        if (u.ks == -2) ev(acc, u, wr, wc, fr, fq); else eu(acc, u, wr, wc, fr, fq);
    }
};
struct EpiQKVG {
    static constexpr bool PERM = true;
#ifndef QKVG_NDEFER
#define QKVG_NDEFER 5
#endif
    static constexpr int NDEFER = QKVG_NDEFER;
    bf16_t* QKV; bf16_t* G; int nr;
    __device__ __forceinline__ void operator()(const f32x4 (&acc)[2][2][4][2], const Unit& u, int wr, int wc, int fr, int fq) const {
        bf16_t* base; int ld; const int pn = u.pn;
        if (pn < 8) { base = QKV + (size_t)pn * nr * 256; ld = 256; }
        else if (pn < 16) { base = QKV + (size_t)nr * 2048 + (size_t)((pn - 8) >> 1) * nr * 512 + ((pn - 8) & 1) * 256; ld = 512; }
        else { base = G + (pn - 16) * 256; ld = 4096; }
        const int row0 = u.pm * BM + wr * 64 + fr, col0 = wc * 32 + 8 * fq;
#pragma unroll
        for (int ai = 0; ai < 2; ++ai)
#pragma unroll
            for (int m = 0; m < 4; ++m) { bf16_t* rowp = base + (size_t)(row0 + ai * HALF + m * 16) * ld + col0;
#pragma unroll
                for (int bj = 0; bj < 2; ++bj) { const f32x4 v0 = acc[ai][bj][m][0], v1 = acc[ai][bj][m][1];
                    u32x4 w; w.x = cvt_pk_bf16(v0[0], v0[1]); w.y = cvt_pk_bf16(v0[2], v0[3]); w.z = cvt_pk_bf16(v1[0], v1[1]); w.w = cvt_pk_bf16(v1[2], v1[3]);
                    *(u32x4*)(rowp + bj * HALF) = w; } }
    }
    __device__ __forceinline__ void split(const f32x4 (&acc)[2][2][4][2], const Unit& u, int wr, int wc, int fr, int fq, u32x4 (&pend)[NDEFER > 0 ? NDEFER : 1], char*& lanebase, int& ldb) const {
        bf16_t* base; int ld; const int pn = u.pn;
        if (pn < 8) { base = QKV + (size_t)pn * nr * 256; ld = 256; }
        else if (pn < 16) { base = QKV + (size_t)nr * 2048 + (size_t)((pn - 8) >> 1) * nr * 512 + ((pn - 8) & 1) * 256; ld = 512; }
        else { base = G + (pn - 16) * 256; ld = 4096; }
        const int row0 = u.pm * BM + wr * 64 + fr, col0 = wc * 32 + 8 * fq;
        lanebase = (char*)(base + (size_t)row0 * ld + col0); ldb = ld;
#pragma unroll
        for (int ai = 0; ai < 2; ++ai)
#pragma unroll
            for (int m = 0; m < 4; ++m) { bf16_t* rowp = base + (size_t)(row0 + ai * HALF + m * 16) * ld + col0;
#pragma unroll
                for (int bj = 0; bj < 2; ++bj) { const f32x4 v0 = acc[ai][bj][m][0], v1 = acc[ai][bj][m][1]; const int i = ai * 8 + m * 2 + bj;
                    u32x4 w; w.x = cvt_pk_bf16(v0[0], v0[1]); w.y = cvt_pk_bf16(v0[2], v0[3]); w.z = cvt_pk_bf16(v1[0], v1[1]); w.w = cvt_pk_bf16(v1[2], v1[3]);
                    if (i >= 16 - NDEFER) pend[i - (16 - NDEFER)] = w; else *(u32x4*)(rowp + bj * HALF) = w; } }
    }
    static __device__ __forceinline__ long defer_off(int i, int ldb) { return ((long)(((i >> 3) * HALF + ((i >> 1) & 3) * 16)) * ldb + (i & 1) * HALF) * 2; }
};
struct EpiY {
    static constexpr bool PERM = true;
    static constexpr int NDEFER = NDEFER_DEFAULT_;
    bf16_t* Y; float* part; int part_tile0; size_t part_stride;
    __device__ __forceinline__ void operator()(const f32x4 (&acc)[2][2][4][2], const Unit& u, int wr, int wc, int fr, int fq) const {
        const int col0 = u.pn * BM + wc * 32 + 8 * fq;
        if (u.ks >= 0) { bf16_t* P = (bf16_t*)part + (size_t)u.ks * part_stride; const int row0 = (u.pm - part_tile0) * BM + wr * 64 + fr;
#pragma unroll
            for (int ai = 0; ai < 2; ++ai)
#pragma unroll
                for (int m = 0; m < 4; ++m) { bf16_t* rowp = P + (size_t)(row0 + ai * HALF + m * 16) * 1024 + col0;
#pragma unroll
                    for (int bj = 0; bj < 2; ++bj) { const f32x4 v0 = acc[ai][bj][m][0], v1 = acc[ai][bj][m][1];
                        u32x4 w; w.x = cvt_pk_bf16(v0[0], v0[1]); w.y = cvt_pk_bf16(v0[2], v0[3]); w.z = cvt_pk_bf16(v1[0], v1[1]); w.w = cvt_pk_bf16(v1[2], v1[3]);
                        *(u32x4*)(rowp + bj * HALF) = w; } }
            return; }
        const int row0 = u.pm * BM + wr * 64 + fr;
#pragma unroll
        for (int ai = 0; ai < 2; ++ai)
#pragma unroll
            for (int m = 0; m < 4; ++m) { bf16_t* rowp = Y + (size_t)(row0 + ai * HALF + m * 16) * 1024 + col0;
#pragma unroll
                for (int bj = 0; bj < 2; ++bj) { const f32x4 v0 = acc[ai][bj][m][0], v1 = acc[ai][bj][m][1];
                    u32x4 w; w.x = cvt_pk_bf16(v0[0], v0[1]); w.y = cvt_pk_bf16(v0[2], v0[3]); w.z = cvt_pk_bf16(v1[0], v1[1]); w.w = cvt_pk_bf16(v1[2], v1[3]);
                    *(u32x4*)(rowp + bj * HALF) = w; } }
    }
};
template <class E0, class E1> struct EpiPair {
    static constexpr bool PERM = E0::PERM; static_assert(E0::PERM == E1::PERM, "EpiPair: both epilogues must want the same B staging order");
    static constexpr int NDEFER = NDEFER_DEFAULT_;
    E0 e0; E1 e1;
    __device__ __forceinline__ void operator()(const f32x4 (&acc)[2][2][4][2], const Unit& u, int wr, int wc, int fr, int fq) const {
        if (u.ks == -2) e1(acc, u, wr, wc, fr, fq); else e0(acc, u, wr, wc, fr, fq);
    }
};
template <int MODE>
struct EpiShape {
    static constexpr bool PERM = true;
    static constexpr int NDEFER = NDEFER_DEFAULT_;
    bf16_t* O;
    __device__ __forceinline__ void operator()(const f32x4 (&acc)[2][2][4][2], const Unit& u, int wr, int wc, int fr, int fq) const {
        bf16_t* lb = O + ((size_t)u.pm * 32 + u.pn) * 65536;
        if (MODE == 0 || MODE == 2) lb += (wr * 64 + fr) * 256 + wc * 32 + 8 * fq;
        else if (MODE == 1) lb += (wr * 64 + (fr & ~1)) * 256 + wc * 64 + fq * 16 + (fr & 1) * 8;
        else if (MODE == 3) lb += (wr * 4 + wc) * 8192 + (fr * 4 + fq) * 8;
        else if (MODE == 6) lb = O + ((size_t)u.pm * 256 + wr * 64 + fr) * 8192 + u.pn * 256 + wc * 32 + 8 * fq;
        else lb += (wr * 64 + fr) * 256 + wc * 32 + 8 * fq;
        u32x4 acc5 = {0u, 0u, 0u, 0u};
#pragma unroll
        for (int ai = 0; ai < 2; ++ai)
#pragma unroll
            for (int m = 0; m < 4; ++m)
#pragma unroll
                for (int bj = 0; bj < 2; ++bj) { const f32x4 v0 = acc[ai][bj][m][0], v1 = acc[ai][bj][m][1];
                    u32x4 w; w.x = cvt_pk_bf16(v0[0], v0[1]); w.y = cvt_pk_bf16(v0[2], v0[3]); w.z = cvt_pk_bf16(v1[0], v1[1]); w.w = cvt_pk_bf16(v1[2], v1[3]);
                    if (MODE == 0) *(u32x4*)(lb + (ai * HALF + m * 16) * 256 + bj * HALF) = w;
                    else if (MODE == 1) *(u32x4*)(lb + (ai * HALF + m * 16 + bj) * 256) = w;
                    else if (MODE == 2) *(u32x2*)(lb + (ai * HALF + m * 16) * 256 + bj * HALF) = (u32x2){w.x ^ w.z, w.y ^ w.w};
                    else if (MODE == 3) *(u32x4*)(lb + ((ai * 4 + m) * 2 + bj) * 512) = w;
                    else if (MODE == 6) *(u32x4*)(lb + (size_t)(ai * HALF + m * 16) * 8192 + bj * HALF) = w;
                    else if (MODE == 4) { if (bj == 0) { const f32x4 y0 = acc[ai][1][m][0], y1 = acc[ai][1][m][1]; w.x ^= cvt_pk_bf16(y0[0], y0[1]); w.y ^= cvt_pk_bf16(y0[2], y0[3]); w.z ^= cvt_pk_bf16(y1[0], y1[1]); w.w ^= cvt_pk_bf16(y1[2], y1[3]);
                                          *(u32x4*)(lb + (ai * HALF + m * 16) * 256) = w; } }
                    else { acc5.x ^= w.x; acc5.y ^= w.y; acc5.z ^= w.z; acc5.w ^= w.w; } }
        if (MODE == 5) *(u32x4*)lb = acc5;
    }
};
struct EpiNull {
    static constexpr bool PERM = true;
    static constexpr int NDEFER = NDEFER_DEFAULT_;
    float* sink;
    __device__ __forceinline__ void operator()(const f32x4 (&acc)[2][2][4][2], const Unit& u, int wr, int wc, int fr, int fq) const {
        float s = 0.f;
#pragma unroll
        for (int ai = 0; ai < 2; ++ai)
#pragma unroll
            for (int bj = 0; bj < 2; ++bj)
#pragma unroll
                for (int m = 0; m < 4; ++m)
#pragma unroll
                    for (int n = 0; n < 2; ++n) s += acc[ai][bj][m][n][0] + acc[ai][bj][m][n][1] + acc[ai][bj][m][n][2] + acc[ai][bj][m][n][3];
        if (s == 1.2345e-30f) sink[0] = s;
    }
};
struct EpiRes {
    static constexpr bool PERM = true;
    static constexpr int NDEFER = NDEFER_DEFAULT_;
    bf16_t* X; const float* gate; int tile0;
    float* part;
    __device__ __forceinline__ void operator()(const f32x4 (&acc)[2][2][4][2], const Unit& u, int wr, int wc, int fr, int fq) const {
        const int row0 = u.pm * BM + wr * 64 + fr, col0 = u.pn * BM + wc * 32 + 8 * fq;
        if (u.ks >= 0) {
            bf16_t* P = (bf16_t*)part + (size_t)u.ks * 1024 * 1024;
#pragma unroll
            for (int ai = 0; ai < 2; ++ai)
#pragma unroll
                for (int m = 0; m < 4; ++m) { bf16_t* rowp = P + (size_t)(row0 + ai * HALF + m * 16) * 1024 + col0;
#pragma unroll
                    for (int bj = 0; bj < 2; ++bj) { const f32x4 v0 = acc[ai][bj][m][0], v1 = acc[ai][bj][m][1];
                        u32x4 w; w.x = cvt_pk_bf16(v0[0], v0[1]); w.y = cvt_pk_bf16(v0[2], v0[3]); w.z = cvt_pk_bf16(v1[0], v1[1]); w.w = cvt_pk_bf16(v1[2], v1[3]);
                        *(u32x4*)(rowp + bj * HALF) = w; } }
            return; }
        const int tg = u.pm + tile0, cond = tg < 4 ? 4 : ((tg - 4) >> 4);
        const float* gp = gate + cond * 6144 + col0;
        f32x4 gv[2][2];
#pragma unroll
        for (int bj = 0; bj < 2; ++bj)
#pragma unroll
            for (int n = 0; n < 2; ++n) gv[bj][n] = *(const f32x4*)(gp + bj * HALF + n * 4);
#pragma unroll
        for (int ai = 0; ai < 2; ++ai)
#pragma unroll
            for (int m = 0; m < 4; ++m) { bf16_t* rowp = X + (size_t)(row0 + ai * HALF + m * 16) * 1024 + col0;
#pragma unroll
                for (int bj = 0; bj < 2; ++bj) { u32x4* p = (u32x4*)(rowp + bj * HALF); const u32x4 xr = *p; const f32x4 d0 = gv[bj][0] * acc[ai][bj][m][0], d1 = gv[bj][1] * acc[ai][bj][m][1]; u32x4 o;
                    o.x = cvt_pk_bf16(__builtin_bit_cast(float, xr.x << 16) + d0[0], __builtin_bit_cast(float, xr.x & 0xffff0000u) + d0[1]);
                    o.y = cvt_pk_bf16(__builtin_bit_cast(float, xr.y << 16) + d0[2], __builtin_bit_cast(float, xr.y & 0xffff0000u) + d0[3]);
                    o.z = cvt_pk_bf16(__builtin_bit_cast(float, xr.z << 16) + d1[0], __builtin_bit_cast(float, xr.z & 0xffff0000u) + d1[1]);
                    o.w = cvt_pk_bf16(__builtin_bit_cast(float, xr.w << 16) + d1[2], __builtin_bit_cast(float, xr.w & 0xffff0000u) + d1[3]);
                    *p = o; } }
    }
};
struct EpiSwiglu {
    static constexpr bool PERM = false;
    static constexpr int NDEFER = NDEFER_DEFAULT_;
    bf16_t* O; int ldo; bool blk = false;
    __device__ __forceinline__ void operator()(const f32x4 (&acc)[2][2][4][2], const Unit& u, int wr, int wc, int fr, int fq) const {
        const int row0 = u.pm * BM + wr * 64 + fr, col0 = u.pn * HALF + wc * 16 + 4 * fq;
        if (blk) {
            bf16_t* tb = O + ((size_t)u.pm * (ldo / 64) + (size_t)u.pn * 2) * (BM * 64) + (size_t)(wr * 64 + fr + 16 * (fq & 1)) * 64 + wc * 16 + 4 * (fq & 2);
#pragma unroll
            for (int ai = 0; ai < 2; ++ai)
#pragma unroll
                for (int mp = 0; mp < 2; ++mp)
#pragma unroll
                    for (int bj = 0; bj < 2; ++bj) { u32x2 w[2];
#pragma unroll
                        for (int q = 0; q < 2; ++q) { const f32x4 g = acc[ai][bj][2 * mp + q][0], uu = acc[ai][bj][2 * mp + q][1]; f32x4 h;
#pragma unroll
                            for (int j = 0; j < 4; ++j) h[j] = g[j] * fast_sigmoid(g[j]) * uu[j];
                            w[q].x = cvt_pk_bf16(h[0], h[1]); w[q].y = cvt_pk_bf16(h[2], h[3]); }
                        const auto rx = __builtin_amdgcn_permlane16_swap(w[0].x, w[1].x, false, false); const auto ry = __builtin_amdgcn_permlane16_swap(w[0].y, w[1].y, false, false);
                        *(u32x4*)(tb + (size_t)(ai * HALF + mp * 32) * 64 + (size_t)bj * (BM * 64)) = (u32x4){rx[0], ry[0], rx[1], ry[1]}; }
            return; }
#pragma unroll
        for (int ai = 0; ai < 2; ++ai)
#pragma unroll
            for (int m = 0; m < 4; ++m) { bf16_t* rowp = O + (size_t)(row0 + ai * HALF + m * 16) * ldo + col0;
#pragma unroll
                for (int bj = 0; bj < 2; ++bj) { const f32x4 g = acc[ai][bj][m][0], uu = acc[ai][bj][m][1]; f32x4 h;
#pragma unroll
                    for (int j = 0; j < 4; ++j) h[j] = g[j] * fast_sigmoid(g[j]) * uu[j];
                    u32x2 w; w.x = cvt_pk_bf16(h[0], h[1]); w.y = cvt_pk_bf16(h[2], h[3]);
                    *(u32x2*)(rowp + bj * 64) = w; } }
    }
};

#ifndef PG8_ALIGN
#define PG8_ALIGN true
#endif
template <class Epi, class Sched, bool GATHER = false, bool ALIGN_EPI_ = true, bool ABLK = false, bool BBLK = true>
__device__ __forceinline__ void gemm_phase(PG8_LAS unsigned char* lds, const Gemm g, const Sched& S, const Epi& E) {
    constexpr bool ALIGN_EPI = ALIGN_EPI_ && PG8_ALIGN;
    int tid_ = threadIdx.x; asm volatile("" : "+v"(tid_));
    const int tid = tid_, wid = __builtin_amdgcn_readfirstlane(tid >> 6), lane = tid & 63, wr = wid >> 2, wc = wid & 3, fr = lane & 15, fq = lane >> 4;
    const int K = g.K, lda = g.lda;
    unsigned voffA[2], voffB[2]; int sR[2], sC[2];
#pragma unroll
    for (int i = 0; i < 2; ++i) { int R, C; stage_rc(tid * 16 + i * 8192, R, C); const int Rb = Epi::PERM ? ((R & ~31) + perm32(R & 31)) : R;
        voffA[i] = ABLK ? (unsigned)(R * BK + C) * 2u : (unsigned)(R * lda + C) * 2u; voffB[i] = BBLK ? (unsigned)(Rb * BK + C) * 2u : (unsigned)(Rb * K + C) * 2u; sR[i] = R; sC[i] = C * 2; }
    const size_t kstepA = ABLK ? (size_t)(BM * BK * 2) : (size_t)(BK * 2), kstep = BBLK ? (size_t)(BM * BK * 2) : (size_t)(BK * 2);
    const size_t hstepA = ABLK ? (size_t)(HALF * BK * 2) : (size_t)HALF * lda * 2, hstepB = BBLK ? (size_t)(HALF * BK * 2) : (size_t)HALF * K * 2;
    const unsigned ldsw = (unsigned)wid * 1024u;
    const int aoff = lds_byte(wr * 64 + fr, fq * 8), boff = lds_byte(wc * 32 + fr, fq * 8);
    unsigned ao[2][2], aon[2][2];
#define PG8_SA(b, h) (((b) * 2 + (h)) * HTB)
#define PG8_SB(b, h) ((4 + (b) * 2 + (h)) * HTB)
#define PG8_STAGE(bufoff, gbase, voff) do { _Pragma("unroll") for (int _i = 0; _i < 2; ++_i) \
        __builtin_amdgcn_global_load_lds((const unsigned*)((const char*)(gbase) + (voff)[_i]), (PG8_LAS unsigned*)(lds + (bufoff) + ldsw + _i * 8192), 16, 0, 0); } while (0)
#define PG8_STAGE_A(bufoff, h, ab, OA) do { if constexpr (GATHER) { PG8_STAGE(bufoff, ab, (OA)[h]); } else { PG8_STAGE(bufoff, (ab) + (h) * hstepA, voffA); } } while (0)
#define PG8_GOFFS(dst, uu) do { _Pragma("unroll") for (int _h = 0; _h < 2; ++_h) _Pragma("unroll") for (int _i = 0; _i < 2; ++_i) \
        (dst)[_h][_i] = (unsigned)S.arow(uu, _h * HALF + sR[_i]) * (unsigned)(lda * 2) + (unsigned)sC[_i]; } while (0)
#define PG8_LDA(dst, b, h) do { _Pragma("unroll") for (int m = 0; m < 4; ++m) _Pragma("unroll") for (int k = 0; k < 2; ++k) dst[m][k] = *(const PG8_LAS bf16x8*)(lds + PG8_SA(b, h) + aoff + m * 2048 + k * 1024); } while (0)
#define PG8_LDB(dst, b, h) do { _Pragma("unroll") for (int n = 0; n < 2; ++n) _Pragma("unroll") for (int k = 0; k < 2; ++k) dst[n][k] = *(const PG8_LAS bf16x8*)(lds + PG8_SB(b, h) + boff + n * 2048 + k * 1024); } while (0)
#define PG8_MMA(ai, bj, At, Bt) do { __builtin_amdgcn_s_setprio(1); _Pragma("unroll") for (int m = 0; m < 4; ++m) _Pragma("unroll") for (int n = 0; n < 2; ++n) _Pragma("unroll") for (int k = 0; k < 2; ++k) \
        acc[ai][bj][m][n] = __builtin_amdgcn_mfma_f32_16x16x32_bf16(Bt[n][k], At[m][k], acc[ai][bj][m][n], 0, 0, 0); __builtin_amdgcn_s_setprio(0); } while (0)
#define PG8_WAIT_V(n) asm volatile("s_waitcnt vmcnt(" #n ")" ::: "memory")
#define PG8_WAIT_L(n) asm volatile("s_waitcnt lgkmcnt(" #n ")" ::: "memory")
#define PG8_BAR __builtin_amdgcn_s_barrier()
#define PG8_SCHED __builtin_amdgcn_sched_barrier(0)
    constexpr int ND = Epi::NDEFER;
    u32x4 pend[ND > 0 ? ND : 1]; char* plane = nullptr; int pld = 0, npend = 0, sflag = 0;
#define PG8_WAIT_VS() do { if constexpr (ND > 0) { asm volatile("s_waitcnt vmcnt(9)\n\ts_cmp_gt_i32 %0, 0\n\ts_cbranch_scc1 .Lpg8s%=\n\ts_waitcnt vmcnt(8)\n.Lpg8s%=:" :: "s"(sflag) : "memory", "scc"); sflag = 0; } else PG8_WAIT_V(8); } while (0)
#define PG8_TRICKLE() do { if constexpr (ND > 0) { if (npend > 0) { const int _i = 16 - npend; *(u32x4*)(plane + Epi::defer_off(_i, pld)) = pend[0]; \
        _Pragma("unroll") for (int _k = 0; _k + 1 < ND; ++_k) pend[_k] = pend[_k + 1]; --npend; sflag = 1; } } } while (0)
    Unit cur, nxt; int ui = 0;
    if (!S.next(0, cur)) return;
#if defined(PG8_STAGGER)
    if (S.nwg > 2 * S.G) {
        const unsigned long long t0 = __builtin_amdgcn_s_memrealtime(); const unsigned long long dt = (unsigned long long)(((blockIdx.x >> 3) & 7) * S.nkt(cur) * PG8_STAGGER / 8);
        while (__builtin_amdgcn_s_memrealtime() - t0 < dt) __builtin_amdgcn_s_sleep(8);
    }
#endif
    f32x4 acc[2][2][4][2];
#pragma unroll
    for (int a = 0; a < 2; ++a)
#pragma unroll
        for (int b = 0; b < 2; ++b)
#pragma unroll
            for (int m = 0; m < 4; ++m)
#pragma unroll
                for (int n = 0; n < 2; ++n) acc[a][b][m][n] = (f32x4){0.f, 0.f, 0.f, 0.f};
    bf16x8 At[4][2], B0[2][2], B1[2][2];
    const char* cA = (const char*)g.A + (GATHER ? (size_t)0 : S.aofs(cur)); const char* cB = (const char*)g.Bt + S.bofs(cur);
    if constexpr (GATHER) { PG8_GOFFS(ao, cur);
#pragma unroll
        for (int h = 0; h < 2; ++h)
#pragma unroll
            for (int i = 0; i < 2; ++i) aon[h][i] = ao[h][i]; }
    PG8_STAGE(PG8_SB(0, 0), cB, voffB); PG8_STAGE(PG8_SB(0, 1), cB + hstepB, voffB); PG8_STAGE_A(PG8_SA(0, 0), 0, cA, ao); PG8_STAGE_A(PG8_SA(0, 1), 1, cA, ao);
    if (wr == 1) PG8_BAR;
    PG8_WAIT_V(2); PG8_BAR;
    PG8_STAGE(PG8_SB(1, 0), cB + kstep, voffB); PG8_STAGE_A(PG8_SA(1, 0), 0, cA + kstepA, ao); PG8_STAGE(PG8_SB(1, 1), cB + hstepB + kstep, voffB);
    PG8_WAIT_V(6); PG8_BAR;
    for (;;) {
        const bool has_next = S.next(ui + 1, nxt);
        const char* nA = (GATHER || !has_next) ? cA : (const char*)g.A + S.aofs(nxt); const char* nB = has_next ? (const char*)g.Bt + S.bofs(nxt) : cB;
        const int nt = S.nkt(cur);
        for (int t = 0; t < nt; t += 2) {
            const bool last = (t == nt - 2);
            const char* a1 = cA + (size_t)(t + 1) * kstepA;
            const char* a2 = last ? nA : cA + (size_t)(t + 2) * kstepA; const char* b2 = last ? nB : cB + (size_t)(t + 2) * kstep;
            const char* a3 = a2 + kstepA; const char* b3 = b2 + kstep;
            unsigned o2[2][2];
            if constexpr (GATHER) {
                if (last && has_next) PG8_GOFFS(aon, nxt);
#pragma unroll
                for (int h = 0; h < 2; ++h)
#pragma unroll
                    for (int i = 0; i < 2; ++i) o2[h][i] = last ? aon[h][i] : ao[h][i];
            }
            PG8_LDB(B0, 0, 0); PG8_LDB(B1, 0, 1); PG8_SCHED; PG8_LDA(At, 0, 0); PG8_STAGE_A(PG8_SA(1, 1), 1, a1, ao);
            PG8_WAIT_VS(); PG8_WAIT_L(0); PG8_BAR; PG8_TRICKLE(); PG8_MMA(0, 0, At, B0); PG8_MMA(0, 1, At, B1); PG8_BAR; PG8_SCHED;
            PG8_LDA(At, 0, 1); PG8_STAGE(PG8_SB(0, 0), b2, voffB); PG8_STAGE(PG8_SB(0, 1), b2 + hstepB, voffB); PG8_STAGE_A(PG8_SA(0, 0), 0, a2, o2);
            PG8_WAIT_VS(); PG8_WAIT_L(0); PG8_BAR; PG8_TRICKLE(); PG8_MMA(1, 0, At, B0); PG8_MMA(1, 1, At, B1); PG8_BAR; PG8_SCHED;
            PG8_LDB(B0, 1, 0); PG8_LDB(B1, 1, 1); PG8_SCHED; PG8_LDA(At, 1, 0); PG8_STAGE_A(PG8_SA(0, 1), 1, a2, o2);
            PG8_WAIT_VS(); PG8_WAIT_L(0); PG8_BAR; PG8_TRICKLE(); PG8_MMA(0, 0, At, B0); PG8_MMA(0, 1, At, B1); PG8_BAR; PG8_SCHED;
            PG8_LDA(At, 1, 1); PG8_STAGE(PG8_SB(1, 0), b3, voffB); PG8_STAGE(PG8_SB(1, 1), b3 + hstepB, voffB); PG8_STAGE_A(PG8_SA(1, 0), 0, a3, o2);
            PG8_WAIT_VS(); PG8_WAIT_L(0); PG8_BAR; PG8_TRICKLE(); PG8_MMA(1, 0, At, B0); PG8_MMA(1, 1, At, B1); PG8_BAR; PG8_SCHED;
        }
        if constexpr (ALIGN_EPI) { if (wr == 0) PG8_BAR; }
        if constexpr (ND > 0) {
#pragma unroll
            for (int _f = 0; _f < ND; ++_f) PG8_TRICKLE();
            if (has_next) { E.split(acc, cur, wr, wc, fr, fq, pend, plane, pld); npend = ND; } else E(acc, cur, wr, wc, fr, fq);
        } else E(acc, cur, wr, wc, fr, fq);
        if (!has_next) break;
#pragma unroll
        for (int a = 0; a < 2; ++a)
#pragma unroll
            for (int b = 0; b < 2; ++b)
#pragma unroll
                for (int m = 0; m < 4; ++m)
#pragma unroll
                    for (int n = 0; n < 2; ++n) acc[a][b][m][n] = (f32x4){0.f, 0.f, 0.f, 0.f};
        cur = nxt; cA = nA; cB = nB; ++ui;
        if constexpr (GATHER) {
#pragma unroll
            for (int h = 0; h < 2; ++h)
#pragma unroll
                for (int i = 0; i < 2; ++i) ao[h][i] = aon[h][i]; }
        if constexpr (ALIGN_EPI) { if (wr == 1) PG8_BAR; }
    }
    PG8_WAIT_V(0);
    if constexpr (!ALIGN_EPI) { if (wr == 0) PG8_BAR; }
    PG8_BAR;
#undef PG8_SA
#undef PG8_SB
#undef PG8_STAGE
#undef PG8_STAGE_A
#undef PG8_GOFFS
#undef PG8_LDA
#undef PG8_LDB
#undef PG8_MMA
#undef PG8_WAIT_V
#undef PG8_WAIT_L
#undef PG8_BAR
#undef PG8_SCHED
}
}

constexpr int D = 1024, NB = 4, SEQ = 4096, CTXL = 256, TT = CTXL + SEQ;
constexpr int NCTX = NB * CTXL;
constexpr int NLAT = NB * SEQ;
constexpr int NR = NCTX + NLAT;
constexpr int DFF = 2816, EFF = 3584, NEXP = 8;
constexpr int RET_NIN = 8192;
constexpr int RET_LD = 4096;
constexpr float EPS = 1e-6f;
constexpr int MOE_MAXROWS = 36864;

constexpr size_t MiB = 1u << 20;
constexpr size_t WS_CTL = 0, CTL_ZERO_BYTES = 1 * MiB;
constexpr size_t WS_MOD = 1 * MiB;
constexpr size_t WS_TOK = 2 * MiB;
constexpr size_t WS_ROWIDX = 3 * MiB;
constexpr size_t WS_CNTW = 3 * MiB + 512 * 1024;
constexpr size_t WS_RSTD = 4 * MiB;
constexpr size_t WS_WSB = 5 * MiB;
constexpr size_t WS_W = 6 * MiB;
constexpr size_t W_RETIN = WS_W;
constexpr size_t W_RETO = W_RETIN + 32 * MiB;
constexpr size_t W_MLAD = W_RETO + 8 * MiB;
constexpr size_t W_UQ = W_MLAD + 2 * MiB;
constexpr size_t W_UKV = W_UQ + 1 * MiB;
constexpr size_t W_MLAO = W_UKV + 1 * MiB;
constexpr size_t W_SGUIN = W_MLAO + 2 * MiB;
constexpr size_t W_SGUOUT = W_SGUIN + 12 * MiB;
constexpr size_t W_FFNGU = W_SGUOUT + 6 * MiB;
constexpr size_t W_FFND = W_FFNGU + 22 * MiB;
constexpr size_t W_MOEGU = W_FFND + 11 * MiB;
constexpr size_t W_MOED = W_MOEGU + 224 * MiB;
constexpr size_t WS_X = W_MOED + 112 * MiB;
constexpr size_t WS_H = WS_X + 68 * MiB;
constexpr size_t WS_BIG = WS_H + 34 * MiB;
constexpr size_t WS_PREP = WS_BIG + 272 * MiB;
constexpr size_t WS_OFB = WS_PREP + 170 * MiB;
constexpr size_t WS_MIX = WS_OFB + 136 * MiB;
constexpr size_t WS_END = WS_MIX + 68 * MiB;
constexpr size_t PREP_KT = WS_PREP, PREP_QR = PREP_KT + 34 * MiB, PREP_P = PREP_QR + 34 * MiB;
constexpr size_t PREP_KTF = WS_PREP, PREP_KTB = PREP_KTF + 34 * MiB, PREP_VT = PREP_KTB + 34 * MiB, PREP_PF = PREP_VT + 68 * MiB, PREP_PB = PREP_PF + 17 * MiB;
constexpr size_t RET_QKV = WS_BIG, RET_G = WS_BIG + 136 * MiB;
constexpr size_t MLA_CKV = WS_BIG;
constexpr size_t MLA_CQN = MLA_CKV + 52 * MiB;
constexpr size_t MLA_CKVN = MLA_CQN + 9 * MiB;
constexpr size_t MLA_KR = MLA_CKVN + 9 * MiB;
constexpr size_t MLA_Q = MLA_KR + 3 * MiB;
constexpr int KVR_LD = 2112;
constexpr size_t MLA_KV = MLA_Q + 52 * MiB;
constexpr size_t MLA_O = MLA_KV + 71 * MiB;
static_assert(MLA_O + 34 * MiB <= WS_PREP, "MLA map");
constexpr size_t MOE_HID = WS_BIG;
constexpr size_t MOE_Y = WS_PREP;
constexpr size_t SGU_UV = WS_BIG;
constexpr size_t SGU_VT = SGU_UV + 104 * MiB;
constexpr size_t SGU_SSQ = WS_MIX;
constexpr size_t SGU_UZ = WS_PREP;
constexpr size_t FFN_HID = WS_BIG;
constexpr int CW_BAR = 4096;
constexpr int CW_XQ = 8192;
constexpr int CW_MOECNT = 16384;

constexpr int LDS_BYTES = 147456;
constexpr int LDSCTL_OFF = LDS_BYTES - 1024, MISC_OFF = LDSCTL_OFF + 320;
constexpr int NWAVES = 8;

#define GAS __attribute__((address_space(1)))
#define LAS __attribute__((address_space(3)))
typedef unsigned short bf16;
typedef unsigned v4u __attribute__((ext_vector_type(4)));
typedef unsigned v2u __attribute__((ext_vector_type(2)));
typedef float f32x4 __attribute__((ext_vector_type(4)));
typedef float f32x2 __attribute__((ext_vector_type(2)));
typedef short bf16x8 __attribute__((ext_vector_type(8)));
typedef GAS unsigned gu32;
#define RLX_AGENT __ATOMIC_RELAXED, __HIP_MEMORY_SCOPE_AGENT
#define LDS_WAIT() asm volatile("s_waitcnt lgkmcnt(0)" ::: "memory")
#define VM_WAIT() asm volatile("s_waitcnt vmcnt(0)" ::: "memory")
__device__ __forceinline__ unsigned f2bf(float f) { unsigned u = __builtin_bit_cast(unsigned, f); return (u + 0x7fffu + ((u >> 16) & 1u)) >> 16; }
__device__ __forceinline__ unsigned pk2(float lo, float hi) { return f2bf(lo) | (f2bf(hi) << 16); }
__device__ __forceinline__ float bf2f(unsigned short v) { return __builtin_bit_cast(float, (unsigned)v << 16); }
__device__ __forceinline__ float bflo(unsigned w) { return __builtin_bit_cast(float, w << 16); }
__device__ __forceinline__ float bfhi(unsigned w) { return __builtin_bit_cast(float, w & 0xffff0000u); }
__device__ __forceinline__ float sigmoidf_(float x) { return 1.0f / (1.0f + __expf(-x)); }

#define XB_TMO      128
#define XB_XCNT(j)  (256  + 64 * (j))
#define XB_XSUB(j)  (1280 + 64 * (j))
#define XB_XGEN(j)  (2304 + 64 * (j))
#define XB_TOP      3328
#define XB_TOPGEN   3392
#define XCD_BAR_WORDS 3456
#define XB_SPIN_CAP (1u << 18)

__device__ __forceinline__ unsigned xb_ld(unsigned* p)              { return __hip_atomic_load(p, __ATOMIC_RELAXED, __HIP_MEMORY_SCOPE_AGENT); }
__device__ __forceinline__ unsigned xb_add(unsigned* p, unsigned v) { return __hip_atomic_fetch_add(p, v, __ATOMIC_RELAXED, __HIP_MEMORY_SCOPE_AGENT); }
__device__ __forceinline__ unsigned xb_xcc_id() { return (unsigned)__builtin_amdgcn_s_getreg((3 << 11) | 20) & 0xFu; }
#define XB_SPIN(cond, bar) do { unsigned _sp = 0; while (cond) { __builtin_amdgcn_s_sleep(1); \
    if ((++_sp & 255u) == 0u) { if (xb_ld(&(bar)[XB_TMO])) break; if (_sp > XB_SPIN_CAP) { atomicAdd(&(bar)[XB_TMO], 1u); break; } } } } while (0)

struct XcdBarrier {
    unsigned* bar; unsigned x;
    volatile LAS unsigned* st;
};
__device__ __forceinline__ XcdBarrier xcd_barrier_post(unsigned* bar, volatile LAS unsigned* st) {
    XcdBarrier b; b.bar = bar; b.x = xb_xcc_id(); b.st = st;
    if (threadIdx.x == 0) (void)xb_add(&bar[XB_XCNT(b.x)], 1u);
    return b;
}
__device__ __forceinline__ void xcd_barrier_complete(unsigned* bar, unsigned x, unsigned& nloc, unsigned& nx) {
    const unsigned G = gridDim.x * gridDim.y * gridDim.z;
    unsigned sum, cnt, mine, sp = 0u;
    for (;;) {
        sum = 0u; cnt = 0u; mine = 0u;
#pragma unroll
        for (unsigned j = 0; j < 16; ++j) { const unsigned c = xb_ld(&bar[XB_XCNT(j)]); sum += c; cnt += (c > 0u) ? 1u : 0u; mine = (j == x) ? c : mine; }
        if (sum == G) break;
        __builtin_amdgcn_s_sleep(1);
        if ((++sp & 255u) == 0u) { if (xb_ld(&bar[XB_TMO])) break; if (sp > XB_SPIN_CAP) { atomicAdd(&bar[XB_TMO], 1u); break; } }
    }
    nloc = mine > 0u ? mine : 1u; nx = cnt > 0u ? cnt : 1u;
}
__device__ __forceinline__ void xcd_barrier(const XcdBarrier& b) {
    asm volatile("s_waitcnt vmcnt(0)" ::: "memory");
    __syncthreads();
    if (threadIdx.x == 0) {
        unsigned* bar = b.bar;
        __builtin_amdgcn_s_waitcnt(0);
        unsigned nloc = b.st[0], nx = b.st[1];
        if (nloc == 0u) { xcd_barrier_complete(bar, b.x, nloc, nx); b.st[0] = nloc; b.st[1] = nx; }
        const unsigned old = xb_add(&bar[XB_XSUB(b.x)], 1u);
        const unsigned gen = old / nloc;
        if (old + 1u == (gen + 1u) * nloc) {
            __builtin_amdgcn_fence(__ATOMIC_RELEASE, "agent");
            asm volatile("s_waitcnt vmcnt(0)" ::: "memory");
            const unsigned og = xb_add(&bar[XB_TOP], 1u);
            const unsigned tg = og / nx;
            if (og + 1u == (tg + 1u) * nx) xb_add(&bar[XB_TOPGEN], 1u);
            else XB_SPIN(xb_ld(&bar[XB_TOPGEN]) == tg, bar);
            __builtin_amdgcn_fence(__ATOMIC_ACQUIRE, "agent");
            xb_add(&bar[XB_XGEN(b.x)], 1u);
            asm volatile("s_waitcnt vmcnt(0)" ::: "memory");
        } else {
            XB_SPIN(xb_ld(&bar[XB_XGEN(b.x)]) == gen, bar);
            __builtin_amdgcn_fence(__ATOMIC_ACQUIRE, "agent");
            asm volatile("s_waitcnt vmcnt(0)" ::: "memory");
        }
    }
    __syncthreads();
}

struct Frame {
    LAS unsigned char* lds;
    gu32* ctl;
    unsigned char* ws;
    int tid, lane, wave;
    int vcu, G;
    const float* const* in;
};
__device__ __forceinline__ float row16_sum(float v) {
    v += __builtin_bit_cast(float, __builtin_amdgcn_update_dpp(0, __builtin_bit_cast(int, v), 0x128, 0xf, 0xf, false));
    v += __builtin_bit_cast(float, __builtin_amdgcn_update_dpp(0, __builtin_bit_cast(int, v), 0x124, 0xf, 0xf, false));
    v += __builtin_bit_cast(float, __builtin_amdgcn_update_dpp(0, __builtin_bit_cast(int, v), 0x122, 0xf, 0xf, false));
    v += __builtin_bit_cast(float, __builtin_amdgcn_update_dpp(0, __builtin_bit_cast(int, v), 0x121, 0xf, 0xf, false));
    return v;
}
__device__ __forceinline__ float wave_sum(float v) {
    v = row16_sum(v);
    v += __shfl_xor(v, 16); v += __shfl_xor(v, 32);
    return v;
}
__device__ __forceinline__ int row_cond(int row) { return row < NCTX ? 4 : ((row - NCTX) >> 12); }

enum { MAP_ID = 0, MAP_GU = 1, MAP_PAD = 2 };
template <int MAP, bool BLK>
__device__ __forceinline__ void tr_item(const float* W, int Nsrc, int K, bf16* WT, int Fdim, LAS float* scr, int item, int nblk, int lane) {
    const int kb = item / nblk, nb = item % nblk, k0 = 64 * kb, n0 = 64 * nb;
    const int q = lane & 15, r4 = lane >> 4; int sc, lc;
    if (MAP == MAP_GU) { const int seg = q >> 3, cl = (q & 7) * 4; sc = seg * Fdim + (n0 >> 1) + cl; lc = (cl >> 4) * 32 + seg * 16 + (cl & 15); }
    else { sc = n0 + 4 * q; lc = 4 * q; }
    const bool valid = (MAP != MAP_PAD) || (sc < Nsrc);
    const float* src = W + (size_t)(k0 + r4) * Nsrc + sc;
    f32x4 v[16];
#pragma unroll
    for (int i = 0; i < 16; ++i) v[i] = valid ? __builtin_nontemporal_load((const f32x4*)(src + (size_t)(4 * i) * Nsrc)) : (f32x4){0.f, 0.f, 0.f, 0.f};
#pragma unroll
    for (int i = 0; i < 16; ++i) { LAS float* d = scr + (4 * i + r4) * 65 + lc; d[0] = v[i].x; d[1] = v[i].y; d[2] = v[i].z; d[3] = v[i].w; }
    LDS_WAIT(); asm volatile("" ::: "memory");
    const int c = lane & 7;
#pragma unroll
    for (int j = 0; j < 8; ++j) { const int n = (lane >> 3) + 8 * j; const LAS float* s = scr + (8 * c) * 65 + n;
        v4u o; o.x = pk2(s[0 * 65], s[1 * 65]); o.y = pk2(s[2 * 65], s[3 * 65]); o.z = pk2(s[4 * 65], s[5 * 65]); o.w = pk2(s[6 * 65], s[7 * 65]);
        const int nn = n0 + n;
        bf16* dst = BLK ? WT + ((size_t)(nn >> 8) * (K >> 6) + (k0 >> 6)) * 16384 + (size_t)(nn & 255) * 64 + 8 * c : WT + (size_t)nn * K + k0 + 8 * c;
        *(GAS v4u*)dst = o; }
    LDS_WAIT(); asm volatile("" ::: "memory");
}
template <int MAP, bool BLK = true>
__device__ __forceinline__ void conv_job(Frame& F, const float* W, int Nsrc, int K, bf16* WT, int Ndst, int Fdim, int nmat) {
    LAS float* scr = (LAS float*)(F.lds + F.wave * 17408);
    const int gw = F.vcu * NWAVES + F.wave, NGW = F.G * NWAVES, nblk = Ndst / 64, per = (K / 64) * nblk, nitems = per * nmat;
    for (int it = gw; it < nitems; it += NGW) { const int mat = it / per, loc = it - mat * per;
        tr_item<MAP, BLK>(W + (size_t)mat * K * Nsrc, Nsrc, K, WT + (size_t)mat * Ndst * K, Fdim, scr, loc, nblk, F.lane); }
}
constexpr size_t WS_ROPE = WS_WSB + 512 * 1024;
template <class InT> __device__ __forceinline__ void p0_prologue(Frame& F, const InT& in) {
    unsigned char* ws = F.ws;
    conv_job<MAP_ID>(F, in[9], RET_NIN, 1024, (bf16*)(ws + W_RETIN), RET_NIN, 0, 2);
    conv_job<MAP_ID>(F, in[10], 1024, 2048, (bf16*)(ws + W_RETO), 1024, 0, 2);
    conv_job<MAP_PAD>(F, in[15], 576, 1024, (bf16*)(ws + W_MLAD), 768, 0, 1);
    conv_job<MAP_ID>(F, in[18], 1536, 256, (bf16*)(ws + W_UQ), 1536, 0, 1);
    conv_job<MAP_ID>(F, in[19], 2048, 256, (bf16*)(ws + W_UKV), 2048, 0, 1);
    conv_job<MAP_ID>(F, in[20], 1024, 1024, (bf16*)(ws + W_MLAO), 1024, 0, 1);
    conv_job<MAP_ID, false>(F, in[21], 6144, 1024, (bf16*)(ws + W_SGUIN), 6144, 0, 1);
    conv_job<MAP_ID>(F, in[25], 1024, 3072, (bf16*)(ws + W_SGUOUT), 1024, 0, 1);
    conv_job<MAP_GU>(F, in[26], 2 * DFF, 1024, (bf16*)(ws + W_FFNGU), 2 * DFF, DFF, 2);
    conv_job<MAP_ID>(F, in[27], 1024, DFF, (bf16*)(ws + W_FFND), 1024, 0, 2);
    conv_job<MAP_GU>(F, in[29], 2 * EFF, 1024, (bf16*)(ws + W_MOEGU), 2 * EFF, EFF, 16);
    conv_job<MAP_ID>(F, in[30], 1024, EFF, (bf16*)(ws + W_MOED), 1024, 0, 16);
    const size_t gt = (size_t)blockIdx.x * 512 + F.tid, NT = (size_t)F.G * 512;
    { const f32x4* s0 = (const f32x4*)in[2]; const f32x4* s1 = (const f32x4*)in[0]; v2u* d = (v2u*)(ws + WS_X);
      const size_t n0 = (size_t)NCTX * D / 4, n1 = (size_t)NLAT * D / 4;
      for (size_t i = gt; i < n0 + n1; i += NT) { const f32x4 v = (i < n0) ? s0[i] : s1[i - n0]; d[i] = (v2u){pk2(v.x, v.y), pk2(v.z, v.w)}; } }
    { const float* s = in[23]; bf16* d = (bf16*)(ws + WS_WSB); for (size_t i = gt; i < 8 * 128 * 128; i += NT) d[i] = (bf16)f2bf(s[i]); }
    { f32x2* rr = (f32x2*)(ws + WS_ROPE); f32x2* rm = rr + 64 * 64;
      for (size_t i = gt; i < 64 * 64 + 64 * 16; i += NT) {
          if (i < 64 * 64) { const int pos = (int)i >> 6, fi = (int)i & 63; const float inv = powf(10000.0f, -(float)(2 * fi) / 128.0f); const float a = (float)pos * inv; rr[i] = (f32x2){cosf(a), sinf(a)}; }
          else { const int k = (int)i - 64 * 64, pos = k >> 4, fi = k & 15; const float inv = powf(10000.0f, -(float)(2 * fi) / 32.0f); const float a = (float)pos * inv; rm[k] = (f32x2){cosf(a), sinf(a)}; } } }
    __syncthreads();
    LAS float* sc = (LAS float*)F.lds;
    LAS float* red = (LAS float*)(F.lds + 20480);
    for (int i = F.tid; i < 5 * 1024; i += 512) { const int cond = i >> 10, k = i & 1023; const float v = cond < 4 ? in[1][cond * 1024 + k] : in[3][k]; sc[i] = v * sigmoidf_(v); }
    __syncthreads();
    float* mod = (float*)(ws + WS_MOD);
    for (int item = blockIdx.x; item < 4 * 96; item += F.G) {
        const int layer = item / 96, n0 = (item % 96) * 64, cg = F.tid & 15, ks = F.tid >> 4;
        float acc[5][4];
#pragma unroll
        for (int a = 0; a < 5; ++a)
#pragma unroll
            for (int q = 0; q < 4; ++q) acc[a][q] = 0.f;
        const float* w = in[4] + (size_t)layer * 1024 * 6144 + n0 + cg * 4;
#pragma unroll 4
        for (int j = 0; j < 32; ++j) { const int k = ks + 32 * j; const f32x4 wv = *(const f32x4*)(w + (size_t)k * 6144);
#pragma unroll
            for (int a = 0; a < 5; ++a) { const float s = sc[a * 1024 + k]; acc[a][0] += s * wv.x; acc[a][1] += s * wv.y; acc[a][2] += s * wv.z; acc[a][3] += s * wv.w; } }
#pragma unroll
        for (int a = 0; a < 5; ++a)
#pragma unroll
            for (int q = 0; q < 4; ++q) red[(ks * 5 + a) * 64 + cg * 4 + q] = acc[a][q];
        __syncthreads();
        if (F.tid < 320) { const int a = F.tid >> 6, col = F.tid & 63; float s = 0.f;
            for (int k2 = 0; k2 < 32; ++k2) s += red[(k2 * 5 + a) * 64 + col];
            mod[((size_t)layer * 5 + a) * 6144 + n0 + col] = s + in[5][layer * 6144 + n0 + col]; }
        __syncthreads();
    }
}

struct RowArgs {
    const float* normg;
    const float* shift;
    const float* scale;
    const float* gate_prev; const bf16* Y; const int* tok_slot; const float* tok_w;
    const float* w_router; int* tok_e; float* tok_wo; int* tok_rank; gu32* cnt;
    float* out;
    int row_lo, row_hi;
    int ctx_nsplit; const float* ctx_gate;
};
template <bool COMBINE, bool ROUTE, bool FINAL>
__device__ __forceinline__ void rows_phase(Frame& F, const RowArgs& a) {
    const int gw = F.vcu * NWAVES + F.wave, NGW = F.G * NWAVES, lane = F.lane;
    bf16* X = (bf16*)(F.ws + WS_X); bf16* H = (bf16*)(F.ws + WS_H);
    volatile LAS int* lcnt = (volatile LAS int*)(F.lds + LDSCTL_OFF);
    if (ROUTE) { if (F.tid < 64) lcnt[F.tid] = 0; __syncthreads(); }
    f32x4 ng[4];
#pragma unroll
    for (int j = 0; j < 4; ++j) ng[j] = *(const f32x4*)(a.normg + 4 * lane + 256 * j);
    for (int row = a.row_lo + gw; row < a.row_hi; row += NGW) {
        const int cond = row_cond(row);
        f32x4 v[4]; bf16* xr = X + (size_t)row * D + 4 * lane;
#pragma unroll
        for (int j = 0; j < 4; ++j) { const v2u xw = *(const v2u*)(xr + 256 * j); v[j] = (f32x4){bflo(xw.x), bfhi(xw.x), bflo(xw.y), bfhi(xw.y)}; }
#define ROWS_STORE_X(j_) (*(v2u*)(xr + 256 * (j_)) = (v2u){pk2(v[j_].x, v[j_].y), pk2(v[j_].z, v[j_].w)})
        if (a.ctx_nsplit > 0 && row < NCTX) {
            const bf16* pp = (const bf16*)(F.ws + WS_OFB) + (size_t)row * D + 4 * lane; const float* gp = a.ctx_gate + 4 * 6144 + 4 * lane;
#pragma unroll
            for (int j = 0; j < 4; ++j) { f32x4 s = (f32x4){0.f, 0.f, 0.f, 0.f};
                for (int ks = 0; ks < a.ctx_nsplit; ++ks) { const v2u r = *(const v2u*)(pp + (size_t)ks * 1024 * 1024 + 256 * j); s = s + (f32x4){bflo(r.x), bfhi(r.x), bflo(r.y), bfhi(r.y)}; }
                v[j] = v[j] + *(const f32x4*)(gp + 256 * j) * s; ROWS_STORE_X(j); v[j] = (f32x4){bf2f((unsigned short)f2bf(v[j].x)), bf2f((unsigned short)f2bf(v[j].y)), bf2f((unsigned short)f2bf(v[j].z)), bf2f((unsigned short)f2bf(v[j].w))}; }
        }
        if (COMBINE) {
            const int s1 = a.tok_slot[row * 2], s2 = a.tok_slot[row * 2 + 1]; const float w1 = a.tok_w[row * 2], w2 = a.tok_w[row * 2 + 1];
            const float* gp = a.gate_prev + cond * 6144 + 4 * lane;
            const bool sp1 = s1 >= 32768, sp2 = s2 >= 32768; const bf16* YP = (const bf16*)(F.ws + WS_OFB);
            const bf16* yp1 = YP + (size_t)(sp1 ? s1 - 32768 : 0) * D + 4 * lane; const bf16* yp2 = YP + (size_t)(sp2 ? s2 - 32768 : 0) * D + 4 * lane;
            const bf16* yb1 = a.Y + (size_t)(sp1 ? 0 : s1) * D + 4 * lane; const bf16* yb2 = a.Y + (size_t)(sp2 ? 0 : s2) * D + 4 * lane;
#pragma unroll
            for (int j = 0; j < 4; ++j) { f32x4 p, q; const f32x4 g = *(const f32x4*)(gp + 256 * j);
                if (sp1) { p = (f32x4){0.f, 0.f, 0.f, 0.f}; for (int ks = 0; ks < 4; ++ks) { const v2u r = *(const v2u*)(yp1 + (size_t)ks * 4096 * 1024 + 256 * j); p = p + (f32x4){bflo(r.x), bfhi(r.x), bflo(r.y), bfhi(r.y)}; } }
                else { const v2u r = *(const v2u*)(yb1 + 256 * j); p = (f32x4){bflo(r.x), bfhi(r.x), bflo(r.y), bfhi(r.y)}; }
                if (sp2) { q = (f32x4){0.f, 0.f, 0.f, 0.f}; for (int ks = 0; ks < 4; ++ks) { const v2u r = *(const v2u*)(yp2 + (size_t)ks * 4096 * 1024 + 256 * j); q = q + (f32x4){bflo(r.x), bfhi(r.x), bflo(r.y), bfhi(r.y)}; } }
                else { const v2u r = *(const v2u*)(yb2 + 256 * j); q = (f32x4){bflo(r.x), bfhi(r.x), bflo(r.y), bfhi(r.y)}; }
                v[j] = v[j] + g * (p * w1 + q * w2); if (!FINAL) { ROWS_STORE_X(j); v[j] = (f32x4){bf2f((unsigned short)f2bf(v[j].x)), bf2f((unsigned short)f2bf(v[j].y)), bf2f((unsigned short)f2bf(v[j].z)), bf2f((unsigned short)f2bf(v[j].w))}; } }
        }
        float ss = 0.f;
#pragma unroll
        for (int j = 0; j < 4; ++j) ss += (v[j].x * v[j].x + v[j].y * v[j].y) + (v[j].z * v[j].z + v[j].w * v[j].w);
        const float rstd = 1.0f / sqrtf(wave_sum(ss) * (1.0f / D) + EPS);
        if (FINAL) {
            float* o = a.out + (size_t)(row - NCTX) * D + 4 * lane;
#pragma unroll
            for (int j = 0; j < 4; ++j) *(f32x4*)(o + 256 * j) = v[j] * rstd * ng[j];
        } else {
            const float* sh = a.shift + cond * 6144 + 4 * lane; const float* scp = a.scale + cond * 6144 + 4 * lane;
            f32x4 h[4];
#pragma unroll
            for (int j = 0; j < 4; ++j) { const f32x4 s = *(const f32x4*)(sh + 256 * j), c1 = *(const f32x4*)(scp + 256 * j); h[j] = (v[j] * rstd * ng[j]) * (c1 + 1.0f) + s; }
            bf16* hr = H + (size_t)row * D + 4 * lane;
#pragma unroll
            for (int j = 0; j < 4; ++j) { v2u w; w.x = pk2(h[j].x, h[j].y); w.y = pk2(h[j].z, h[j].w); *(v2u*)(hr + 256 * j) = w; }
            if (ROUTE) {
                float lg[8];
#pragma unroll
                for (int e = 0; e < 8; ++e) lg[e] = 0.f;
#pragma unroll
                for (int j = 0; j < 4; ++j)
#pragma unroll
                    for (int q = 0; q < 4; ++q) { const float hv = h[j][q]; const float* wr = a.w_router + (size_t)(4 * lane + 256 * j + q) * 8; const f32x4 w0 = *(const f32x4*)wr, w1 = *(const f32x4*)(wr + 4);
                        lg[0] += hv * w0.x; lg[1] += hv * w0.y; lg[2] += hv * w0.z; lg[3] += hv * w0.w; lg[4] += hv * w1.x; lg[5] += hv * w1.y; lg[6] += hv * w1.z; lg[7] += hv * w1.w; }
#pragma unroll
                for (int e = 0; e < 8; ++e) lg[e] = wave_sum(lg[e]);
                int i1 = 0; float v1 = lg[0];
#pragma unroll
                for (int e = 1; e < 8; ++e) if (lg[e] > v1) { v1 = lg[e]; i1 = e; }
                int i2 = -1; float v2 = -3.0e38f;
#pragma unroll
                for (int e = 0; e < 8; ++e) if (e != i1 && lg[e] > v2) { v2 = lg[e]; i2 = e; }
                const float e2 = __expf(v2 - v1), w1 = 1.0f / (1.0f + e2), w2 = e2 * w1;
                if (lane == 0) { const int r1 = lcnt[F.wave * 8 + i1]; lcnt[F.wave * 8 + i1] = r1 + 1; const int r2 = lcnt[F.wave * 8 + i2]; lcnt[F.wave * 8 + i2] = r2 + 1;
                    a.tok_e[row * 2] = i1; a.tok_e[row * 2 + 1] = i2; a.tok_wo[row * 2] = w1; a.tok_wo[row * 2 + 1] = w2; a.tok_rank[row * 2] = r1; a.tok_rank[row * 2 + 1] = r2; }
            }
        }
    }
    if (ROUTE) {
        __syncthreads();
        if (F.tid < 64) { int* cntw = (int*)(F.ws + WS_CNTW); cntw[(F.vcu * NWAVES + (F.tid >> 3)) * 8 + (F.tid & 7)] = lcnt[F.tid]; }
        if (F.tid < 8) { int s = 0; for (int wv = 0; wv < 8; ++wv) s += lcnt[wv * 8 + F.tid]; (void)__hip_atomic_fetch_add(a.cnt + 64 * F.tid, (unsigned)s, RLX_AGENT); }
    }
}
__device__ __forceinline__ void moe_offsets(gu32* cnt, int (&ts)[9], int (&cn)[8]) {
    int t = 0;
#pragma unroll
    for (int e = 0; e < 8; ++e) { cn[e] = (int)__hip_atomic_load(cnt + 64 * e, RLX_AGENT); ts[e] = t; t += (cn[e] + 255) >> 8; }
    ts[8] = t;
}
__device__ __forceinline__ void moe_lists(Frame& F, gu32* cnt, int row_lo, int row_hi) {
    int ts[9], cn[8]; moe_offsets(cnt, ts, cn);
    const int* tok_e = (const int*)(F.ws + WS_TOK); const int* tok_rank = tok_e + 4 * NR; int* tok_slot = (int*)tok_e + 6 * NR; int* rowidx = (int*)(F.ws + WS_ROWIDX);
    const int NGW = F.G * NWAVES;
    LAS int* pre = (LAS int*)F.lds; const int* cntw = (const int*)(F.ws + WS_CNTW);
    __syncthreads();
    for (int i = F.tid; i < NGW * 8; i += 512) pre[i] = cntw[i];
    __syncthreads();
    LAS int* tot = pre + NGW * 8;
    const int e_ = F.tid & 7, ch = F.tid >> 3, per = (NGW + 63) / 64, g0 = ch * per, g1 = (g0 + per < NGW) ? g0 + per : NGW;
    { int s = 0; for (int g = g0; g < g1; ++g) { const int c = pre[g * 8 + e_]; pre[g * 8 + e_] = s; s += c; } tot[ch * 8 + e_] = s; }
    __syncthreads();
    if (F.tid < 8) { int s = 0; for (int c2 = 0; c2 < 64; ++c2) { const int c = tot[c2 * 8 + F.tid]; tot[c2 * 8 + F.tid] = s; s += c; } }
    __syncthreads();
    { const int o = tot[ch * 8 + e_]; for (int g = g0; g < g1; ++g) pre[g * 8 + e_] += o; }
    __syncthreads();
    const int gt = blockIdx.x * 512 + F.tid, NT = F.G * 512;
    for (int i = row_lo * 2 + gt; i < row_hi * 2; i += NT) { const int e = tok_e[i], row = i >> 1, g = (row - row_lo) % NGW; int t0 = 0;
#pragma unroll
        for (int j = 0; j < 8; ++j) t0 = (e == j) ? ts[j] : t0;
        const int slot = t0 * 256 + pre[g * 8 + e] + tok_rank[i]; tok_slot[i] = slot; rowidx[slot] = row; }
    for (int i = gt; i < 8 * 256; i += NT) { const int e = i >> 8, k = i & 255; int t0 = 0, c0 = 0, t1 = 0;
#pragma unroll
        for (int j = 0; j < 8; ++j) { t0 = (e == j) ? ts[j] : t0; c0 = (e == j) ? cn[j] : c0; t1 = (e == j) ? ts[j + 1] : t1; }
        const int s = t0 * 256 + c0 + k; if (s < t1 * 256) rowidx[s] = row_lo; }
    __syncthreads();
}

__device__ __forceinline__ void ret_prep(Frame& F) {
    const int tid = F.tid, lane = F.lane, w = F.wave;
    const bf16* BIG = (const bf16*)(F.ws + RET_QKV);
    const f32x2* rope = (const f32x2*)(F.ws + WS_ROPE);
    LAS bf16* ks = (LAS bf16*)F.lds;
    for (int u = F.vcu; u < 544; u += F.G) {
        const int cg = u >> 2, h = u & 3, row0 = cg * 128;
        const bool isctx = row0 < NCTX;
        for (int it = tid; it < 1024; it += 512) { const int j = it >> 3, i0 = (it & 7) * 8, row = row0 + j;
            const bf16* kp = BIG + (size_t)NR * 1024 + (size_t)h * NR * 256 + (size_t)row * 256;
            const v4u a1 = *(const v4u*)(kp + i0), a2 = *(const v4u*)(kp + 64 + i0), b1 = *(const v4u*)(kp + 128 + i0), b2 = *(const v4u*)(kp + 192 + i0);
            const int p = (row - NCTX) & 4095, pr = p >> 6, pc = p & 63;
            unsigned o1[4], o2[4], o3[4], o4[4];
#pragma unroll
            for (int t = 0; t < 4; ++t) {
                float x1[2] = {bflo(a1[t]), bfhi(a1[t])}, x2[2] = {bflo(a2[t]), bfhi(a2[t])}, y1[2] = {bflo(b1[t]), bfhi(b1[t])}, y2[2] = {bflo(b2[t]), bfhi(b2[t])};
                float r1[2], r2[2], r3[2], r4[2];
#pragma unroll
                for (int q = 0; q < 2; ++q) { const int fi = i0 + 2 * t + q; f32x2 cr = (f32x2){1.f, 0.f}, cc = (f32x2){1.f, 0.f};
                    if (!isctx) { cr = rope[pr * 64 + fi]; cc = rope[pc * 64 + fi]; }
                    r1[q] = (x1[q] * cr.x - x2[q] * cr.y) * 0.0625f; r2[q] = (x2[q] * cr.x + x1[q] * cr.y) * 0.0625f;
                    r3[q] = (y1[q] * cc.x - y2[q] * cc.y) * 0.0625f; r4[q] = (y2[q] * cc.x + y1[q] * cc.y) * 0.0625f; }
                o1[t] = pk2(r1[0], r1[1]); o2[t] = pk2(r2[0], r2[1]); o3[t] = pk2(r3[0], r3[1]); o4[t] = pk2(r4[0], r4[1]); }
            LAS bf16* kd = ks + j * 264 + i0;
            *(LAS v4u*)(kd) = (v4u){o1[0], o1[1], o1[2], o1[3]}; *(LAS v4u*)(kd + 64) = (v4u){o2[0], o2[1], o2[2], o2[3]};
            *(LAS v4u*)(kd + 128) = (v4u){o3[0], o3[1], o3[2], o3[3]}; *(LAS v4u*)(kd + 192) = (v4u){o4[0], o4[1], o4[2], o4[3]}; }
        bf16x8 qf[8];
        { const int row = row0 + 16 * w + (lane & 15); const bf16* qp = BIG + (size_t)h * NR * 256 + (size_t)row * 256 + 8 * (lane >> 4);
          v4u raw[8];
#pragma unroll
          for (int s = 0; s < 8; ++s) raw[s] = *(const v4u*)(qp + 32 * s);
          const int p = (row - NCTX) & 4095, pr = p >> 6, pc = p & 63;
#pragma unroll
          for (int half = 0; half < 2; ++half)
#pragma unroll
              for (int s = 0; s < 2; ++s) { const int sa = 4 * half + s, sb = sa + 2; const int pos = half ? pc : pr; v4u oa, ob;
#pragma unroll
                  for (int t = 0; t < 4; ++t) { float xa[2] = {bflo(raw[sa][t]), bfhi(raw[sa][t])}, xb[2] = {bflo(raw[sb][t]), bfhi(raw[sb][t])}; float ra[2], rb[2];
#pragma unroll
                      for (int q = 0; q < 2; ++q) { const int fi = 32 * s + 8 * (lane >> 4) + 2 * t + q; f32x2 cs = (f32x2){1.f, 0.f}; if (!isctx) cs = rope[pos * 64 + fi];
                          ra[q] = xa[q] * cs.x - xb[q] * cs.y; rb[q] = xb[q] * cs.x + xa[q] * cs.y; }
                      oa[t] = pk2(ra[0], ra[1]); ob[t] = pk2(rb[0], rb[1]); }
                  raw[sa] = oa; raw[sb] = ob; }
          bf16* qro = (bf16*)(F.ws + PREP_QR) + (size_t)u * 32768 + (size_t)(w * 8) * 512 + lane * 8;
#pragma unroll
          for (int s = 0; s < 8; ++s) { *(v4u*)(qro + 512 * s) = raw[s]; qf[s] = __builtin_bit_cast(bf16x8, raw[s]); } }
        __syncthreads();
        { f32x4 acc[8];
#pragma unroll
          for (int n = 0; n < 8; ++n) acc[n] = (f32x4){0.f, 0.f, 0.f, 0.f};
#pragma unroll
          for (int s = 0; s < 8; ++s)
#pragma unroll
              for (int n = 0; n < 8; ++n) { const bf16x8 kf = *(const LAS bf16x8*)(ks + (16 * n + (lane & 15)) * 264 + 32 * s + 8 * (lane >> 4));
                  acc[n] = __builtin_amdgcn_mfma_f32_16x16x32_bf16(kf, qf[s], acc[n], 0, 0, 0); }
          bf16* pf = (bf16*)(F.ws + PREP_P) + (size_t)u * 16384;
#pragma unroll
          for (int n = 0; n < 8; ++n) { const int fo = ((w * 4 + (n >> 1)) * 64 + ((n & 1) * 2 + (lane >> 5)) * 16 + (lane & 15)) * 8 + 4 * ((lane >> 4) & 1);
              *(v2u*)(pf + fo) = (v2u){pk2(acc[n][0], acc[n][1]), pk2(acc[n][2], acc[n][3])}; } }
        { bf16* kt = (bf16*)(F.ws + PREP_KT) + (size_t)u * 32768;
          for (int it = tid; it < 4096; it += 512) { const int jg = it & 3, dl = (it >> 2) & 15, blk = it >> 6; const int d = (blk >> 2) * 16 + dl, j0 = ((blk & 3) * 4 + jg) * 8;
              unsigned short kv[8];
#pragma unroll
              for (int t = 0; t < 8; ++t) kv[t] = ks[(j0 + t) * 264 + d];
              v4u o; o.x = kv[0] | ((unsigned)kv[1] << 16); o.y = kv[2] | ((unsigned)kv[3] << 16); o.z = kv[4] | ((unsigned)kv[5] << 16); o.w = kv[6] | ((unsigned)kv[7] << 16);
              const int fo = (((d >> 4) * 4 + (j0 >> 5)) * 64 + ((j0 & 31) >> 3) * 16 + (d & 15)) * 8;
              *(v4u*)(kt + fo) = o; } }
        __syncthreads();
    }
}
#ifndef SCAN_UMAP
#define SCAN_UMAP F.vcu
#endif
template <int DRY = 0>
__device__ __forceinline__ void ret_scan(Frame& F, int j_ret, const float* decay_f, const float* decay_b, bool with_ctx) {
    const int lane = F.lane, w = F.wave, l15 = lane & 15, lq = lane >> 4;
    typedef short v4i16_t __attribute__((ext_vector_type(4)));
    LAS bf16* ST = (LAS bf16*)F.lds;
    LAS unsigned char* VI = F.lds + 33792;
    constexpr int VIB = 128 * 144;
    LAS bf16* OL = (LAS bf16*)(F.lds + 33792 + 2 * 128 * 144);
    for (int u = SCAN_UMAP; u < 256; u += F.G) {
        const int es = u & 7, dir = (u >> 3) & 1, h = (u >> 4) & 3, b = u >> 6;
        if (DRY == 2 && (es & 1)) continue;
        const float gam = sigmoidf_((dir ? decay_b : decay_f)[j_ret * 4 + h]), lg = log2f(gam), g128 = exp2f(lg * 128.f);
        const char* PD = (const char*)(F.ws + PREP_P); const char* KT = (const char*)(F.ws + PREP_KT); const char* QD = (const char*)(F.ws + PREP_QR);
        const char* Vg = (const char*)(F.ws + RET_QKV) + ((size_t)NR * 2048 + (size_t)h * NR * 512 + 64 * es) * 2;
        bf16* OUT = (bf16*)(F.ws + WS_OFB) + (dir ? (size_t)NR * 2048 : 0);
        f32x4 st[2][4];
#pragma unroll
        for (int dt = 0; dt < 2; ++dt)
#pragma unroll
            for (int et = 0; et < 4; ++et) st[dt][et] = (f32x4){0.f, 0.f, 0.f, 0.f};
#if defined(SCAN_STAGGER)
        { const unsigned long long t0 = __builtin_amdgcn_s_memrealtime(); const unsigned long long dt = (unsigned long long)(es * SCAN_STAGGER);
          while (__builtin_amdgcn_s_memrealtime() - t0 < dt) __builtin_amdgcn_s_sleep(4); }
#endif
        __syncthreads();
        for (int i = F.tid; i < 64 * 264 / 2; i += 512) ((LAS unsigned*)ST)[i] = 0u;
        const int il = 16 * w + l15;
        const float qs = dir ? exp2f(lg * (float)(128 - il)) : exp2f(lg * (float)(il + 1));
        const float rf = dir ? exp2f(-lg * (float)il) : exp2f(lg * (float)(il - 127));
#if !defined(SCAN_NOROT)
        const int r8 = es, r4 = es & 3;
#else
        const int r8 = 0, r4 = 0;
#endif
        v4u pm[4];
#pragma unroll
        for (int s4 = 0; s4 < 4; ++s4)
#pragma unroll
            for (int m = 0; m < 4; ++m) { const int j0 = 32 * ((s4 + r4) & 3) + 8 * lq + 2 * m, j1 = j0 + 1; const bool k0 = dir ? (j0 >= il) : (j0 <= il), k1 = dir ? (j1 >= il) : (j1 <= il);
                pm[s4][m] = (k0 ? 0x0000ffffu : 0u) | (k1 ? 0xffff0000u : 0u); }
        const int s4lo = dir ? (16 * w) >> 5 : 0, s4hi = dir ? 3 : (16 * w + 15) >> 5;
        const unsigned po = (unsigned)(w * 4096 + lane * 16), kto = (unsigned)(w * 8192 + lane * 16), qo = (unsigned)(w * 8192 + lane * 16);
        const int vr0 = F.tid >> 3, vpc = F.tid & 7;
        const unsigned vgo = (unsigned)(vr0 * 512 * 2 + vpc * 16); const int vlo = vr0 * 144 + vpc * 16;
        const float kd0 = dir ? exp2f(lg * (float)vr0) : exp2f(lg * (float)(127 - vr0)), kd1 = dir ? exp2f(lg * (float)(vr0 + 64)) : exp2f(lg * (float)(63 - vr0));
        const int vtr = (8 * lq + (l15 >> 2)) * 144 + (l15 & 3) * 8;
#define SCAN_CG(s_) ({ const int _s = (s_); const int _lc = dir ? (_s == 0 ? 1 : (_s == 1 ? 0 : 35 - _s)) : _s; (_lc < 2 ? b * 2 + _lc : 8 + b * 32 + (_lc - 2)); })
#define SCAN_VSCALE(x_, sc_) ({ const v4u _x = (x_); const float _s = (sc_); v4u _o; _Pragma("unroll") for (int _t = 0; _t < 4; ++_t) _o[_t] = pg8::cvt_pk_bf16(bflo(_x[_t]) * _s, bfhi(_x[_t]) * _s); _o; })
#define SCAN_VFRAG(vb_, et_, s4_) ({ const LAS unsigned char* _a = (vb_) + vtr + (s4_) * (32 * 144) + (et_) * 32; \
        const v4i16_t _lo = __builtin_amdgcn_ds_read_tr16_b64_v4i16((LAS v4i16_t*)_a), _hi = __builtin_amdgcn_ds_read_tr16_b64_v4i16((LAS v4i16_t*)(_a + 4 * 144)); \
        (bf16x8){_lo[0], _lo[1], _lo[2], _lo[3], _hi[0], _hi[1], _hi[2], _hi[3]}; })
        bf16x8 pf[4], qf[8], kf[2][4]; v4u vn0, vn1; unsigned warm = 0u, wpend = 0u;
        { const int cg = SCAN_CG(0), pu = cg * 4 + h;
          const char* vp = Vg + (size_t)cg * 128 * 512 * 2; const char* pp = PD + (size_t)pu * 32768; const char* qp = QD + (size_t)pu * 65536; const char* kp = KT + (size_t)pu * 65536;
          vn0 = __builtin_nontemporal_load((const v4u*)(vp + vgo)); vn1 = __builtin_nontemporal_load((const v4u*)(vp + vgo + 64 * 512 * 2));
#pragma unroll
          for (int s4 = 0; s4 < 4; ++s4) { const int s4r = (s4 + r4) & 3; if (s4r >= s4lo && s4r <= s4hi) pf[s4] = *(const bf16x8*)(pp + po + 1024 * s4r); }
#pragma unroll
          for (int s8 = 0; s8 < 8; ++s8) qf[s8] = *(const bf16x8*)(qp + qo + 1024 * ((s8 + r8) & 7));
#pragma unroll
          for (int dt = 0; dt < 2; ++dt)
#pragma unroll
              for (int s4 = 0; s4 < 4; ++s4) kf[dt][s4] = *(const bf16x8*)(kp + dt * 4096 + kto + 1024 * ((s4 + r4) & 3));
          *(LAS v4u*)(VI + vlo) = SCAN_VSCALE(vn0, kd0); *(LAS v4u*)(VI + vlo + 64 * 144) = SCAN_VSCALE(vn1, kd1); }
        __syncthreads();
        for (int s = 0; s < 34; ++s) {
            const int lc = dir ? (s == 0 ? 1 : (s == 1 ? 0 : 35 - s)) : s;
            const int cg = SCAN_CG(s), row0 = cg * 128;
            const int sn = s < 33 ? s + 1 : 33, cgn = SCAN_CG(sn), pun = cgn * 4 + h;
            const char* vpn = Vg + (size_t)cgn * 128 * 512 * 2; const char* ppn = PD + (size_t)pun * 32768; const char* qpn = QD + (size_t)pun * 65536; const char* kpn = KT + (size_t)pun * 65536;
            const LAS unsigned char* vcur = VI + (s & 1) * VIB;
#if defined(SCAN_L2WARM)
            {
              warm ^= wpend;
              const int s2 = s + SCAN_L2WARM < 34 ? s + SCAN_L2WARM : 33, cg2 = SCAN_CG(s2), pu2 = cg2 * 4 + h; const int slot = es * 8 + w; const int wl = lane < 20 ? lane : 0;
              const char* lp = wl < 4 ? PD + (size_t)pu2 * 32768 + (size_t)(slot * 4 + wl) * 128 : wl < 12 ? QD + (size_t)pu2 * 65536 + (size_t)(slot * 8 + wl - 4) * 128 : KT + (size_t)pu2 * 65536 + (size_t)(slot * 8 + wl - 12) * 128;
              wpend = *(const unsigned*)lp; }
#endif
            if (DRY != 1) { vn0 = __builtin_nontemporal_load((const v4u*)(vpn + vgo)); vn1 = __builtin_nontemporal_load((const v4u*)(vpn + vgo + 64 * 512 * 2)); }
            f32x4 a1[4], a2[4];
#pragma unroll
            for (int et = 0; et < 4; ++et) { a1[et] = (f32x4){0.f, 0.f, 0.f, 0.f}; a2[et] = (f32x4){0.f, 0.f, 0.f, 0.f}; }
#pragma unroll
            for (int s4 = 0; s4 < 4; ++s4) { const int s4r = (s4 + r4) & 3; if (s4r >= s4lo && s4r <= s4hi) {
                const bf16x8 pmk = __builtin_bit_cast(bf16x8, __builtin_bit_cast(v4u, pf[s4]) & pm[s4]);
#pragma unroll
                for (int et = 0; et < 4; ++et) { const bf16x8 vfr = SCAN_VFRAG(vcur, et, s4r); a1[et] = __builtin_amdgcn_mfma_f32_16x16x32_bf16(vfr, pmk, a1[et], 0, 0, 0); }
                if (DRY != 1) pf[s4] = *(const bf16x8*)(ppn + po + 1024 * s4r); } }
#pragma unroll
            for (int s8 = 0; s8 < 8; ++s8) { const int s8r = (s8 + r8) & 7;
#pragma unroll
                for (int et = 0; et < 4; ++et) { const bf16x8 sf = *(const LAS bf16x8*)(ST + (16 * et + l15) * 264 + 32 * s8r + 8 * lq);
                    a2[et] = __builtin_amdgcn_mfma_f32_16x16x32_bf16(sf, qf[s8], a2[et], 0, 0, 0); }
                if (DRY != 1) qf[s8] = *(const bf16x8*)(qpn + qo + 1024 * s8r); }
            const bool wr_o = (DRY == 0 || DRY == 2) && (with_ctx || lc >= 2);
            if (wr_o) {
#pragma unroll
                for (int et = 0; et < 4; ++et) { const f32x4 o = a1[et] * rf + a2[et] * qs; *(LAS v2u*)(OL + il * 72 + 16 * et + 4 * lq) = (v2u){pk2(o[0], o[1]), pk2(o[2], o[3])}; }
            }
            __syncthreads();
#pragma unroll
            for (int dt = 0; dt < 2; ++dt)
#pragma unroll
                for (int et = 0; et < 4; ++et) st[dt][et] = st[dt][et] * g128;
#pragma unroll
            for (int s4 = 0; s4 < 4; ++s4) { const int s4r = (s4 + r4) & 3;
#pragma unroll
                for (int et = 0; et < 4; ++et) { const bf16x8 vfr = SCAN_VFRAG(vcur, et, s4r);
                    st[0][et] = __builtin_amdgcn_mfma_f32_16x16x32_bf16(kf[0][s4], vfr, st[0][et], 0, 0, 0);
                    st[1][et] = __builtin_amdgcn_mfma_f32_16x16x32_bf16(kf[1][s4], vfr, st[1][et], 0, 0, 0); }
                if (DRY != 1) { kf[0][s4] = *(const bf16x8*)(kpn + kto + 1024 * s4r); kf[1][s4] = *(const bf16x8*)(kpn + 4096 + kto + 1024 * s4r); } }
#pragma unroll
            for (int dt = 0; dt < 2; ++dt)
#pragma unroll
                for (int et = 0; et < 4; ++et) *(LAS v2u*)(ST + (16 * et + l15) * 264 + 32 * w + 16 * dt + 4 * lq) = (v2u){pk2(st[dt][et][0], st[dt][et][1]), pk2(st[dt][et][2], st[dt][et][3])};
            if (wr_o) { const int orow = F.tid >> 3, opc = F.tid & 7;
#pragma unroll
                for (int k = 0; k < 2; ++k) { const v4u ov = *(const LAS v4u*)(OL + (orow + 64 * k) * 72 + 8 * opc);
                    *(v4u*)(OUT + (size_t)(row0 + orow + 64 * k) * 2048 + h * 512 + 64 * es + 8 * opc) = ov; } }
            { LAS unsigned char* vnx = VI + ((s + 1) & 1) * VIB + vlo; *(LAS v4u*)(vnx) = SCAN_VSCALE(vn0, kd0); *(LAS v4u*)(vnx + 64 * 144) = SCAN_VSCALE(vn1, kd1); }
            __syncthreads();
        }
#if defined(SCAN_L2WARM)
        if ((warm ^ wpend) == 0x12345677u) ((volatile unsigned*)(F.ws + WS_RSTD))[lane] = warm;
#endif
#undef SCAN_CG
#undef SCAN_VSCALE
#undef SCAN_VFRAG
    }
}
template <int PROBE = 0>
__device__ __forceinline__ void ret_gate(Frame& F, const float* gnf, const float* gnb, int row_lo) {
    const int gw = F.vcu * NWAVES + F.wave, NGW = F.G * NWAVES, lane = F.lane;
    const bf16* BIG = (const bf16*)(F.ws + RET_G); const bf16* OFp = (const bf16*)(F.ws + WS_OFB); const bf16* OBp = OFp + (size_t)NR * 2048; bf16* MIX = (bf16*)(F.ws + WS_MIX);
    const int col0 = (lane >> 4) * 512 + (lane & 15) * 8;
    v4u rf[4], rb[4], gf4[4], gb4[4];
#define GATE_LOAD(row_) do { const int _r = (row_) < NR ? (row_) : NR - 1; _Pragma("unroll") for (int p = 0; p < 4; ++p) { \
        rf[p] = *(const v4u*)(OFp + (size_t)_r * 2048 + col0 + 128 * p); rb[p] = *(const v4u*)(OBp + (size_t)_r * 2048 + col0 + 128 * p); \
        gf4[p] = *(const v4u*)(BIG + (size_t)_r * RET_LD + col0 + 128 * p); gb4[p] = *(const v4u*)(BIG + (size_t)_r * RET_LD + 2048 + col0 + 128 * p); } } while (0)
    GATE_LOAD(row_lo + gw);
    for (int row = row_lo + gw; row < NR; row += NGW) {
        v4u cf[4], cb[4], cgf[4], cgb[4];
#pragma unroll
        for (int p = 0; p < 4; ++p) { cf[p] = rf[p]; cb[p] = rb[p]; cgf[p] = gf4[p]; cgb[p] = gb4[p]; }
        if (PROBE != 1) GATE_LOAD(row + NGW);
        float sf = 0.f, sb = 0.f;
#pragma unroll
        for (int p = 0; p < 4; ++p)
#pragma unroll
            for (int t = 0; t < 4; ++t) { sf += bflo(cf[p][t]) + bfhi(cf[p][t]); sb += bflo(cb[p][t]) + bfhi(cb[p][t]); }
        const float muf = row16_sum(sf) * (1.0f / 512.0f), mub = row16_sum(sb) * (1.0f / 512.0f);
        float qf = 0.f, qb = 0.f;
#pragma unroll
        for (int p = 0; p < 4; ++p)
#pragma unroll
            for (int t = 0; t < 4; ++t) { const float a0 = bflo(cf[p][t]) - muf, a1 = bfhi(cf[p][t]) - muf, b0 = bflo(cb[p][t]) - mub, b1 = bfhi(cb[p][t]) - mub; qf += a0 * a0 + a1 * a1; qb += b0 * b0 + b1 * b1; }
        const float rsf = 1.0f / sqrtf(row16_sum(qf) * (1.0f / 512.0f) + EPS), rsb = 1.0f / sqrtf(row16_sum(qb) * (1.0f / 512.0f) + EPS);
#pragma unroll
        for (int p = 0; p < 4; ++p) { const float* gpf = gnf + col0 + 128 * p; const float* gpb = gnb + col0 + 128 * p;
            const f32x4 nf0 = *(const f32x4*)gpf, nf1 = *(const f32x4*)(gpf + 4), nb0 = *(const f32x4*)gpb, nb1 = *(const f32x4*)(gpb + 4); v4u o;
#pragma unroll
            for (int t = 0; t < 4; ++t) { const float g0 = bflo(cgf[p][t]), g1 = bfhi(cgf[p][t]), h0 = bflo(cgb[p][t]), h1 = bfhi(cgb[p][t]);
                const float yf0 = (bflo(cf[p][t]) - muf) * rsf * (t < 2 ? nf0[2 * t] : nf1[2 * t - 4]), yf1 = (bfhi(cf[p][t]) - muf) * rsf * (t < 2 ? nf0[2 * t + 1] : nf1[2 * t - 3]);
                const float yb0 = (bflo(cb[p][t]) - mub) * rsb * (t < 2 ? nb0[2 * t] : nb1[2 * t - 4]), yb1 = (bfhi(cb[p][t]) - mub) * rsb * (t < 2 ? nb0[2 * t + 1] : nb1[2 * t - 3]);
                o[t] = pg8::cvt_pk_bf16(g0 * pg8::fast_sigmoid(g0) * yf0 + h0 * pg8::fast_sigmoid(h0) * yb0, g1 * pg8::fast_sigmoid(g1) * yf1 + h1 * pg8::fast_sigmoid(h1) * yb1); }
            if (PROBE == 0) *(v4u*)(MIX + (size_t)row * 2048 + col0 + 128 * p) = o;
            else if (PROBE == 1) *(v4u*)((bf16*)(F.ws + WS_PREP) + (size_t)row * 2048 + col0 + 128 * p) = o;
            else if (row < 0) *(v4u*)(MIX + col0 + 128 * p) = o; }
    }
#undef GATE_LOAD
}

__device__ __forceinline__ void mla_rows(Frame& F, const float* g_q, const float* g_kv) {
    const int gw = F.vcu * NWAVES + F.wave, NGW = F.G * NWAVES, lane = F.lane;
    const float* CKV = (const float*)(F.ws + MLA_CKV); bf16* CQN = (bf16*)(F.ws + MLA_CQN); bf16* CKVN = (bf16*)(F.ws + MLA_CKVN); bf16* KR = (bf16*)(F.ws + MLA_KV) + 2048;
    const f32x2* rm = (const f32x2*)(F.ws + WS_ROPE) + 64 * 64;
    const f32x4 gq = *(const f32x4*)(g_q + 4 * lane), gk = *(const f32x4*)(g_kv + 4 * lane);
    for (int row = gw; row < NR; row += NGW) {
        const float* r = CKV + (size_t)row * 768;
        const f32x4 a = *(const f32x4*)(r + 4 * lane), c = *(const f32x4*)(r + 256 + 4 * lane);
        const float sa = wave_sum((a.x * a.x + a.y * a.y) + (a.z * a.z + a.w * a.w)), sc = wave_sum((c.x * c.x + c.y * c.y) + (c.z * c.z + c.w * c.w));
        const float ra = 1.0f / sqrtf(sa * (1.0f / 256.0f) + EPS), rc = 1.0f / sqrtf(sc * (1.0f / 256.0f) + EPS);
        *(v2u*)(CQN + (size_t)row * 256 + 4 * lane) = (v2u){pk2(a.x * ra * gq.x, a.y * ra * gq.y), pk2(a.z * ra * gq.z, a.w * ra * gq.w)};
        *(v2u*)(CKVN + (size_t)row * 256 + 4 * lane) = (v2u){pk2(c.x * rc * gk.x, c.y * rc * gk.y), pk2(c.z * rc * gk.z, c.w * rc * gk.w)};
        if (lane < 32) { const int part = lane >> 4, i = lane & 15; const float x1 = r[512 + part * 32 + i], x2 = r[512 + part * 32 + 16 + i];
            f32x2 cs = (f32x2){1.f, 0.f};
            if (row >= NCTX) { const int p = (row - NCTX) & 4095; const int pos = part ? (p & 63) : (p >> 6); cs = rm[pos * 16 + i]; }
            KR[(size_t)row * KVR_LD + part * 32 + i] = (bf16)f2bf(x1 * cs.x - x2 * cs.y); KR[(size_t)row * KVR_LD + part * 32 + 16 + i] = (bf16)f2bf(x2 * cs.x + x1 * cs.y); }
    }
}

__device__ __forceinline__ void sgu_spatial(Frame& F, const float* g_v, const float* b_s) {
    const int tid = F.tid, lane = F.lane, w = F.wave, l15 = lane & 15, lq = lane >> 4;
    const bf16* U = (const bf16*)(F.ws + SGU_UV); const bf16* VT = (const bf16*)(F.ws + SGU_VT); bf16* UZ = (bf16*)(F.ws + SGU_UZ); const float* SSQ = (const float*)(F.ws + SGU_SSQ); const bf16* WSB = (const bf16*)(F.ws + WS_WSB);
    LAS bf16* WL = (LAS bf16*)F.lds;
    LAS bf16* ZL = (LAS bf16*)(F.lds + 34816);
    LAS float* RS = (LAS float*)(F.lds + 69632);
    for (int u = F.vcu; u < 136 * 24; u += F.G) {
        const int cg = u / 24, r24 = u - cg * 24, g = r24 / 3, third = r24 - g * 3, row0 = cg * 128, c0 = g * 384 + third * 128;
        __syncthreads();
        if (tid < 128) { const float* sp = SSQ + row0 + tid; float s = 0.f;
#pragma unroll
            for (int k = 0; k < 24; ++k) s += sp[(size_t)k * NR];
            RS[tid] = 1.0f / sqrtf(s * (1.0f / 3072.0f) + EPS); }
        bf16x8 vf[4];
        { const bf16* vp = VT + (size_t)cg * (3072 * 128) + (size_t)(c0 + 16 * w + l15) * 128 + 8 * lq;
#pragma unroll
          for (int s4 = 0; s4 < 4; ++s4) vf[s4] = *(const bf16x8*)(vp + 32 * s4); }
        __syncthreads();
        for (int it = tid; it < 2048; it += 512) { const int p = it >> 4, pc = it & 15; const v4u x = *(const v4u*)(WSB + (size_t)g * 16384 + p * 128 + pc * 8); v4u o;
#pragma unroll
            for (int t = 0; t < 4; ++t) o[t] = pg8::cvt_pk_bf16(bflo(x[t]) * RS[pc * 8 + 2 * t], bfhi(x[t]) * RS[pc * 8 + 2 * t + 1]);
            *(LAS v4u*)(WL + p * 136 + pc * 8) = o; }
        __syncthreads();
        f32x4 acc[8];
#pragma unroll
        for (int pt = 0; pt < 8; ++pt) acc[pt] = (f32x4){0.f, 0.f, 0.f, 0.f};
#pragma unroll
        for (int s4 = 0; s4 < 4; ++s4)
#pragma unroll
            for (int pt = 0; pt < 8; ++pt) { const bf16x8 wf = *(const LAS bf16x8*)(WL + (16 * pt + l15) * 136 + 32 * s4 + 8 * lq);
                acc[pt] = __builtin_amdgcn_mfma_f32_16x16x32_bf16(vf[s4], wf, acc[pt], 0, 0, 0); }
        { const f32x4 gv = *(const f32x4*)(g_v + c0 + 16 * w + 4 * lq);
#pragma unroll
          for (int pt = 0; pt < 8; ++pt) { const float bs = b_s[g * 128 + 16 * pt + l15];
              *(LAS v2u*)(ZL + (16 * pt + l15) * 136 + 16 * w + 4 * lq) = (v2u){pg8::cvt_pk_bf16(acc[pt][0] * gv[0] + bs, acc[pt][1] * gv[1] + bs), pg8::cvt_pk_bf16(acc[pt][2] * gv[2] + bs, acc[pt][3] * gv[3] + bs)}; } }
        __syncthreads();
        for (int it = tid; it < 2048; it += 512) { const int p = it >> 4, pc = it & 15;
            const v4u uu = *(const v4u*)(U + (size_t)(row0 + p) * 3072 + c0 + pc * 8); const v4u zz = *(const LAS v4u*)(ZL + p * 136 + pc * 8); v4u o;
#pragma unroll
            for (int t = 0; t < 4; ++t) o[t] = pg8::cvt_pk_bf16(bflo(uu[t]) * bflo(zz[t]), bfhi(uu[t]) * bfhi(zz[t]));
            *(v4u*)(UZ + (size_t)(row0 + p) * 3072 + c0 + pc * 8) = o; }
    }
}

namespace att {
constexpr int NW = 8, QBLK = 32, KVBLK = 64;
constexpr float SCALE = 0.07216878364870322f;
constexpr float THR = 8.f;
constexpr int SHM_V = KVBLK * 128 * 2, SHM_K = KVBLK * 192 * 2;
constexpr int NQL = 4;
constexpr int NKB = 3;
constexpr int SHM_ATTN = 2 * SHM_V + NKB * SHM_K + NW * 64 * 4 + NW * NQL * 1024;
using s16x4  = __attribute__((ext_vector_type(4))) short;
using f32x16 = __attribute__((ext_vector_type(16))) float;
#define KSWZ(row, colB) ((row) * 384 + ((colB) ^ (((row) & 7) << 4)))
#define SBAR() __builtin_amdgcn_sched_barrier(0)
__device__ __forceinline__ int crow(int r, int hi) { return (r & 3) + 8 * (r >> 2) + 4 * hi; }
__device__ __forceinline__ unsigned cvtpk(float lo, float hi) { unsigned r; asm volatile("v_cvt_pk_bf16_f32 %0, %1, %2" : "=v"(r) : "v"(lo), "v"(hi)); return r; }

__device__ __forceinline__ void partialSM(f32x16& p0, f32x16& p1, float& m_reg, float& mn, float& alpha) {
  constexpr float C = SCALE * 1.4426950408889634f;
  float pmax = p0[0]; for (int r = 1; r < 16; ++r) pmax = fmaxf(pmax, p0[r]); for (int r = 0; r < 16; ++r) pmax = fmaxf(pmax, p1[r]);
  { auto rr = __builtin_amdgcn_permlane32_swap(__float_as_uint(pmax), __float_as_uint(pmax), false, false);
    pmax = fmaxf(__uint_as_float(rr[0]), __uint_as_float(rr[1])); }
  if (__builtin_expect(__all(pmax - m_reg <= THR / SCALE), 1)) { mn = m_reg; alpha = 1.f; }
  else { mn = fmaxf(m_reg, pmax); alpha = __builtin_amdgcn_exp2f((m_reg - mn) * C); m_reg = mn; }
  float mnC = -mn * C;
  for (int r = 0; r < 16; ++r) p0[r] = fmaf(p0[r], C, mnC); for (int r = 0; r < 16; ++r) p1[r] = fmaf(p1[r], C, mnC);
  for (int r = 0; r < 16; ++r) p0[r] = __builtin_amdgcn_exp2f(p0[r]);
}
__device__ __forceinline__ void finishSM(f32x16& p0, f32x16& p1, float alpha, float& l_reg, bf16x8& pa0, bf16x8& pa1, bf16x8& pa2, bf16x8& pa3) {
  for (int r = 0; r < 16; ++r) p1[r] = __builtin_amdgcn_exp2f(p1[r]);
  float ps = 0; for (int r = 0; r < 16; ++r) ps += p0[r]; for (int r = 0; r < 16; ++r) ps += p1[r];
  { auto rr = __builtin_amdgcn_permlane32_swap(__float_as_uint(ps), __float_as_uint(ps), false, false);
    ps = __uint_as_float(rr[0]) + __uint_as_float(rr[1]); }
  l_reg = l_reg * alpha + ps;
#define PK4(P, BASE, OUT) do { unsigned a0 = cvtpk(P[BASE + 0], P[BASE + 1]), a1 = cvtpk(P[BASE + 2], P[BASE + 3]);   \
    unsigned b0 = cvtpk(P[BASE + 4], P[BASE + 5]), b1 = cvtpk(P[BASE + 6], P[BASE + 7]);                              \
    auto r0 = __builtin_amdgcn_permlane32_swap(a0, b0, false, false); auto r1 = __builtin_amdgcn_permlane32_swap(a1, b1, false, false); \
    v4u w = {r0[0], r1[0], r0[1], r1[1]}; OUT = __builtin_bit_cast(bf16x8, w); } while (0)
  PK4(p0, 0, pa0); PK4(p0, 8, pa1); PK4(p1, 0, pa2); PK4(p1, 8, pa3);
#undef PK4
}
__device__ __forceinline__ void qkt(f32x16& p0, f32x16& p1, const LAS char* const (&ka)[4], int kbo, const bf16x8* qr, const LAS char* qrope) {
  p0 = f32x16{}; p1 = f32x16{};
  const LAS char* kb[4];
#pragma unroll
  for (int dr = 0; dr < 4; ++dr) kb[dr] = ka[dr] + kbo;
#pragma unroll
  for (int d0 = 0; d0 < 12; ++d0) { const LAS char* a = kb[d0 & 3] + (d0 >> 2) * 128;
    const bf16x8 b0 = *reinterpret_cast<const LAS bf16x8*>(a);
    const bf16x8 b1 = *reinterpret_cast<const LAS bf16x8*>(a + 32 * 384);
    const bf16x8 qv = d0 < 12 - NQL ? qr[d0] : *reinterpret_cast<const LAS bf16x8*>(qrope + (d0 - (12 - NQL)) * 1024);
    p0 = __builtin_amdgcn_mfma_f32_32x32x16_bf16(b0, qv, p0, 0, 0, 0);
    p1 = __builtin_amdgcn_mfma_f32_32x32x16_bf16(b1, qv, p1, 0, 0, 0); }
}
__device__ __forceinline__ int v_st(int k, int c) { const int kk = (k & ~0xC) | ((k & 4) << 1) | ((k & 8) >> 1); return ((kk >> 3) * 4 + (c >> 5)) * 512 + ((kk & 7) * 32 + (c & 31)) * 2; }
__device__ __forceinline__ int v_rd_base(int lane) { return ((lane & 3) << 3) | (((lane >> 2) & 3) << 6) | (((lane >> 4) & 1) << 5) | (((lane >> 5) & 1) << 8); }
constexpr int v_rd_off(int d0, int ks, int half) { return d0 * 512 + ks * 4096 + half * 2048; }
template <int OFF> __device__ __forceinline__ s16x4 tr_read(int vb) {
  s16x4 r; asm volatile("ds_read_b64_tr_b16 %0, %1 offset:%2" : "=&v"(r) : "v"(vb), "i"(OFF) : "memory"); return r;
}
template <int D0> __device__ __forceinline__ void pv_one(f32x16& od, int vb, bf16x8 pa0, bf16x8 pa1, bf16x8 pa2, bf16x8 pa3) {
  const s16x4 l0 = tr_read<v_rd_off(D0, 0, 0)>(vb), h0 = tr_read<v_rd_off(D0, 0, 1)>(vb), l1 = tr_read<v_rd_off(D0, 1, 0)>(vb), h1 = tr_read<v_rd_off(D0, 1, 1)>(vb);
  const s16x4 l2 = tr_read<v_rd_off(D0, 2, 0)>(vb), h2 = tr_read<v_rd_off(D0, 2, 1)>(vb), l3 = tr_read<v_rd_off(D0, 3, 0)>(vb), h3 = tr_read<v_rd_off(D0, 3, 1)>(vb);
  asm volatile("s_waitcnt lgkmcnt(0)" ::: "memory"); SBAR();
#define PK(L, H) (bf16x8){L[0], L[1], L[2], L[3], H[0], H[1], H[2], H[3]}
  od = __builtin_amdgcn_mfma_f32_32x32x16_bf16(pa0, PK(l0, h0), od, 0, 0, 0);
  od = __builtin_amdgcn_mfma_f32_32x32x16_bf16(pa1, PK(l1, h1), od, 0, 0, 0);
  od = __builtin_amdgcn_mfma_f32_32x32x16_bf16(pa2, PK(l2, h2), od, 0, 0, 0);
  od = __builtin_amdgcn_mfma_f32_32x32x16_bf16(pa3, PK(l3, h3), od, 0, 0, 0);
#undef PK
}
__device__ __forceinline__ void pv_d0(f32x16* o, int vb, bf16x8 pa0, bf16x8 pa1, bf16x8 pa2, bf16x8 pa3) {
  pv_one<0>(o[0], vb, pa0, pa1, pa2, pa3); pv_one<1>(o[1], vb, pa0, pa1, pa2, pa3); pv_one<2>(o[2], vb, pa0, pa1, pa2, pa3); pv_one<3>(o[3], vb, pa0, pa1, pa2, pa3);
}
template <bool NODMA = false>
__device__ __forceinline__ void attn_unit(const bf16* __restrict__ Q, const bf16* __restrict__ KVR, bf16* __restrict__ O, const f32x2* __restrict__ ropem,
                                          int qrow0, int h, int kc0, int kl0, int nk, LAS unsigned char* ldsL) {
  char* lds = (char*)ldsL;
  int tid_ = threadIdx.x; asm volatile("" : "+v"(tid_));
  const int tid = tid_, wid = __builtin_amdgcn_readfirstlane(tid >> 6), lane = tid & 63, r32 = lane & 31, hi = lane >> 5;
  char* V_lds = lds;
  float* wsf = (float*)(lds + 2 * SHM_V + NKB * SHM_K) + wid * 64; float* li_l = wsf; float* al_l = wsf + 32;
  LAS char* qrope = (LAS char*)ldsL + 2 * SHM_V + NKB * SHM_K + NW * 64 * 4 + wid * (NQL * 1024) + lane * 16;
  const LAS char* ka[4];
#pragma unroll
  for (int dr = 0; dr < 4; ++dr) ka[dr] = (const LAS char*)ldsL + 2 * SHM_V + r32 * 384 + (((dr * 2 + hi) ^ (r32 & 7)) << 4);
  float m_reg = -1e30f, l_reg = 0; f32x16 o[4] = {}; bf16x8 qr[12 - NQL];
  { const bf16* Qs = Q; asm volatile("" : "+s"(Qs));
    const int qrow = qrow0 + wid * QBLK + r32; const bf16* Qw = Qs + (size_t)qrow * 1536 + h * 192 + hi * 8;
#pragma unroll
    for (int d0 = 0; d0 < 12 - NQL; ++d0) qr[d0] = *reinterpret_cast<const bf16x8*>(Qw + d0 * 16);
#pragma unroll
    for (int d0 = 12 - NQL; d0 < 8; ++d0) *reinterpret_cast<LAS bf16x8*>(qrope + (d0 - (12 - NQL)) * 1024) = *reinterpret_cast<const bf16x8*>(Qw + d0 * 16);
    bf16x8 qx[4];
#pragma unroll
    for (int d0 = 0; d0 < 4; ++d0) qx[d0] = *reinterpret_cast<const bf16x8*>(Qw + (8 + d0) * 16);
    if (qrow >= NCTX) {
      const int p = (qrow - NCTX) & 4095;
#pragma unroll
      for (int part = 0; part < 2; ++part) { const int pos = part ? (p & 63) : (p >> 6); const v4u xa = __builtin_bit_cast(v4u, qx[2 * part]), xb = __builtin_bit_cast(v4u, qx[1 + 2 * part]); v4u oa, ob;
#pragma unroll
        for (int t = 0; t < 4; ++t) { const f32x2 c0 = ropem[pos * 16 + hi * 8 + 2 * t], c1 = ropem[pos * 16 + hi * 8 + 2 * t + 1];
          const float a0 = bflo(xa[t]), a1 = bfhi(xa[t]), b0 = bflo(xb[t]), b1 = bfhi(xb[t]);
          oa[t] = pk2(a0 * c0.x - b0 * c0.y, a1 * c1.x - b1 * c1.y); ob[t] = pk2(b0 * c0.x + a0 * c0.y, b1 * c1.x + a1 * c1.y); }
        qx[2 * part] = __builtin_bit_cast(bf16x8, oa); qx[1 + 2 * part] = __builtin_bit_cast(bf16x8, ob); } }
#pragma unroll
    for (int d0 = 0; d0 < 4; ++d0) *reinterpret_cast<LAS bf16x8*>(qrope + (d0 + NQL - 4) * 1024) = qx[d0]; }
  const int vb0 = (int)(uintptr_t)V_lds + v_rd_base(lane);
#define KROW(k) ((k) < 256 ? kc0 + (k) : kl0 + (k) - 256)
#define KDMA(k0, b) do { const char* _kb = (const char*)(KVR + (size_t)KROW(k0) * 2112); int _ln = lane; asm volatile("" : "+v"(_ln)); _Pragma("unroll") for (int _i = 0; _i < 3; ++_i) { \
    const int _ob = (wid * 3 + _i) * 1024 + _ln * 16, _row = _ob / 384, _cb = (_ob - _row * 384) ^ ((_row & 7) << 4), _pc = _cb >> 4; \
    const unsigned _off = 2u * (unsigned)(_row * 2112 + (_pc < 16 ? h * 256 + _pc * 8 : 2048 + (_pc - 16) * 8)); \
    __builtin_amdgcn_global_load_lds((const unsigned*)(_kb + _off), (LAS unsigned*)(ldsL + 2 * SHM_V + (b) * SHM_K + (wid * 3 + _i) * 1024), 16, 0, 0); } } while (0)
#define VDMA(k0, b) do { const char* _kb = (const char*)(KVR + (size_t)KROW(k0) * 2112); int _ln = lane; asm volatile("" : "+v"(_ln)); _Pragma("unroll") for (int _i = 0; _i < 2; ++_i) { \
    const int _ob = (wid * 2 + _i) * 1024 + _ln * 16, _sub = _ob >> 9, _within = (_ob & 511) >> 1, _kk = (_sub >> 2) * 8 + (_within >> 5); \
    const int _k = (_kk & ~0xC) | ((_kk & 4) << 1) | ((_kk & 8) >> 1), _c = (_sub & 3) * 32 + (_within & 31); \
    const unsigned _off = 2u * (unsigned)(_k * 2112 + h * 256 + 128 + _c); \
    __builtin_amdgcn_global_load_lds((const unsigned*)(_kb + _off), (LAS unsigned*)(ldsL + (b) * SHM_V + (wid * 2 + _i) * 1024), 16, 0, 0); } } while (0)
#define RESC(a) do { if (__any((a) < 1.f)) { if (hi == 0) al_l[r32] = (a); asm volatile("s_waitcnt lgkmcnt(0)" ::: "memory"); \
    for (int d = 0; d < 4; ++d) for (int r = 0; r < 16; ++r) o[d][r] *= al_l[crow(r, hi)]; } } while (0)
#define SEAM3() do { asm volatile("s_waitcnt vmcnt(3) lgkmcnt(0)" ::: "memory"); __builtin_amdgcn_s_barrier(); asm volatile("" ::: "memory"); } while (0)
#define SEAM0() do { asm volatile("s_waitcnt vmcnt(0) lgkmcnt(0)" ::: "memory"); __builtin_amdgcn_s_barrier(); asm volatile("" ::: "memory"); } while (0)
#define KT_(t) ((t) < NT ? (t) : NT - 1)
  f32x16 pA0, pA1, pB0, pB1; float mnA, mnB, alA, alB; bf16x8 pa0, pa1, pa2, pa3; const int NT = nk / KVBLK;
  KDMA(0, 0); VDMA(0, 0); KDMA(KVBLK, 1); VDMA(KVBLK, 1); SEAM0();
  qkt(pA0, pA1, ka, 0, qr, qrope); partialSM(pA0, pA1, m_reg, mnA, alA);
  asm volatile("s_waitcnt lgkmcnt(0)" ::: "memory"); __builtin_amdgcn_s_barrier(); asm volatile("" ::: "memory");
  KDMA(KT_(2) * KVBLK, 2);
  int kb1 = SHM_K, kb2 = 2 * SHM_K;
  for (int j = 1; j + 1 < NT; j += 2) {
    SBAR(); qkt(pB0, pB1, ka, kb1, qr, qrope); SBAR();
    { const int kt = KT_(j + 2); const int kbuf = (j + 2) % NKB; KDMA(kt * KVBLK, kbuf); } SBAR();
    finishSM(pA0, pA1, alA, l_reg, pa0, pa1, pa2, pa3); SBAR();
    pv_d0(o, vb0, pa0, pa1, pa2, pa3); partialSM(pB0, pB1, m_reg, mnB, alB);
    SEAM3();
    VDMA(KT_(j + 1) * KVBLK, 0);
    RESC(alB);
    SBAR(); qkt(pA0, pA1, ka, kb2, qr, qrope); SBAR();
    { const int kt = KT_(j + 3); const int kbuf = (j + 3) % NKB; KDMA(kt * KVBLK, kbuf); } SBAR();
    finishSM(pB0, pB1, alB, l_reg, pa0, pa1, pa2, pa3); SBAR();
    pv_d0(o, vb0 + SHM_V, pa0, pa1, pa2, pa3); partialSM(pA0, pA1, m_reg, mnA, alA);
    SEAM3();
    VDMA(KT_(j + 2) * KVBLK, 1);
    RESC(alA);
    kb1 = ((j + 2) % NKB) * SHM_K; kb2 = ((j + 3) % NKB) * SHM_K;
  }
  SBAR(); qkt(pB0, pB1, ka, kb1, qr, qrope);
  finishSM(pA0, pA1, alA, l_reg, pa0, pa1, pa2, pa3); SBAR();
  pv_d0(o, vb0, pa0, pa1, pa2, pa3); partialSM(pB0, pB1, m_reg, mnB, alB);
  SEAM0(); RESC(alB);
  finishSM(pB0, pB1, alB, l_reg, pa0, pa1, pa2, pa3); SBAR();
  pv_d0(o, vb0 + SHM_V, pa0, pa1, pa2, pa3);
  if (hi == 0) li_l[r32] = l_reg; asm volatile("s_waitcnt lgkmcnt(0)" ::: "memory");
  float rli[16];
#pragma unroll
  for (int r = 0; r < 16; ++r) rli[r] = __builtin_amdgcn_rcpf(li_l[crow(r, hi)]);
  { LAS bf16* ot = (LAS bf16*)(ldsL + 2 * SHM_V) + wid * (32 * 136);
#pragma unroll
    for (int r = 0; r < 16; ++r) { const int orow = crow(r, hi);
#pragma unroll
      for (int d0 = 0; d0 < 4; ++d0) ot[orow * 136 + d0 * 32 + r32] = (bf16)f2bf(o[d0][r] * rli[r]); }
    asm volatile("s_waitcnt lgkmcnt(0)" ::: "memory");
    bf16* Ow = O + (size_t)(qrow0 + wid * QBLK) * 1024 + h * 128;
#pragma unroll
    for (int k = 0; k < 8; ++k) { const int p = lane + 64 * k, row = p >> 4, pc = p & 15;
      *(v4u*)(Ow + (size_t)row * 1024 + pc * 8) = *(const LAS v4u*)(ot + row * 136 + pc * 8); } }
  __syncthreads();
#undef KROW
#undef KDMA
#undef VDMA
#undef SEAM3
#undef SEAM0
#undef KT_
#undef RESC
}
#undef KSWZ
}

enum Phase { P_PRO, P0_MOD, P0_WIN, P0_PREP, P0_SCAN, P0_GATE, P0_WO, P0_MOD2, P0_GU, P0_DOWN, P1_MOD, P1_WD, P1_ROWS, P1_UQ, P1_UKV, P1_ATT, P1_WO, P1_MOD2, P1_LIST, P1_MGU, P1_MDN, P2_MOD, P2_WIN, P2_RSTD, P2_SPA, P2_WOUT, P2_MOD2, P2_GU, P2_DOWN, P3_MOD, P3_WIN, P3_PREP, P3_SCAN, P3_GATE, P3_WO, P3_MOD2, P3_LIST, P3_MGU, P3_MDN, P3_FIN, NPH };
struct Args { const float* in[31]; float* out; unsigned char* ws; int ph_lo, ph_hi, li, pad; };

template <class Epi>
__device__ __forceinline__ void run_gemm(Frame& F, const bf16* A, int lda, const bf16* Bt, int K, int nM, int nN, const Epi& E) {
    pg8::Gemm g{A, Bt, K, lda}; pg8::StaticOrder S; S.init(nM, nN, F.G, (int)blockIdx.x, K, lda);
    pg8::gemm_phase<Epi, pg8::StaticOrder, false, true>(F.lds, g, S, E);
}
template <bool ABLK = false>
__device__ __forceinline__ void run_gemm_res(Frame& F, const bf16* A, int lda, const bf16* Bt, int K, const float* gate) {
    pg8::Gemm g{A, Bt, K, lda}; pg8::ResOrder S; S.init2(F.G, (int)blockIdx.x, K, lda); S.ablk = ABLK;
    pg8::EpiRes E{(bf16*)(F.ws + WS_X), gate, 0, (float*)(F.ws + WS_OFB)};
    pg8::gemm_phase<pg8::EpiRes, pg8::ResOrder, false, true, ABLK>(F.lds, g, S, E);
}
__device__ __forceinline__ void moe_gemms_gu(Frame& F, gu32* cnt, const bf16* Wgu) {
    int ts[9], cn[8]; moe_offsets(cnt, ts, cn);
    pg8::MoeOrder S; S.init(ts[8], 2 * EFF / 256, F.G, (int)blockIdx.x, 1024, 1024);
#pragma unroll
    for (int j = 0; j < 9; ++j) S.ts[j] = ts[j];
    S.estride = (size_t)2 * EFF * 1024 * 2; S.rowidx = (const int*)(F.ws + WS_ROWIDX);
    pg8::Gemm g{(const bf16*)(F.ws + WS_H), Wgu, 1024, 1024};
    pg8::EpiSwiglu E{(bf16*)(F.ws + MOE_HID), EFF, true};
    pg8::gemm_phase<pg8::EpiSwiglu, pg8::MoeOrder, true, true>(F.lds, g, S, E);
}
constexpr size_t MOE_YP = WS_OFB;
__device__ __forceinline__ void moe_gemms_down(Frame& F, gu32* cnt, const bf16* Wd) {
    int ts[9], cn[8]; moe_offsets(cnt, ts, cn);
    pg8::MoeDownOrder S; S.init(ts[8], 4, F.G, (int)blockIdx.x, EFF, EFF);
#pragma unroll
    for (int j = 0; j < 9; ++j) S.ts[j] = ts[j];
    S.estride = (size_t)1024 * EFF * 2; S.rowidx = nullptr;
    pg8::Gemm g{(const bf16*)(F.ws + MOE_HID), Wd, EFF, EFF};
    pg8::EpiY E{(bf16*)(F.ws + MOE_Y), (float*)(F.ws + MOE_YP), pg8::MoeDownOrder::NFULL, (size_t)4096 * 1024};
    pg8::gemm_phase<pg8::EpiY, pg8::MoeDownOrder, false, true, true>(F.lds, g, S, E);
}
template <bool NODMA = false>
__device__ __forceinline__ void attn_phase(Frame& F) {
    const bf16* Q = (const bf16*)(F.ws + MLA_Q); const bf16* KV = (const bf16*)(F.ws + MLA_KV); bf16* O = NODMA ? (bf16*)(F.ws + WS_MIX) : (bf16*)(F.ws + MLA_O);
    const f32x2* ropem = (const f32x2*)(F.ws + WS_ROPE) + 64 * 64;
    for (int i = 0;; ++i) { const int L = i * F.G + F.vcu; if (L >= 544) break;
        int qrow0, hh, b, nk;
        if (L < 512) { const int qb = L & 15; hh = (L >> 4) & 7; b = L >> 7; qrow0 = NCTX + b * SEQ + qb * 256; nk = TT; }
        else { const int Lc = L - 512; hh = Lc & 7; b = Lc >> 3; qrow0 = b * CTXL; nk = CTXL; }
        att::attn_unit<NODMA>(Q, KV, O, ropem, qrow0, hh, b * CTXL, NCTX + b * SEQ, nk, F.lds); }
}

__global__ void __launch_bounds__(NWAVES * 64, 2) mega_fwd(Args args) {
    extern __shared__ __attribute__((aligned(16))) unsigned char lds[];
    Frame F;
    F.lds = (LAS unsigned char*)lds; F.ws = args.ws;
    F.tid = threadIdx.x; F.lane = F.tid & 63; F.wave = __builtin_amdgcn_readfirstlane(F.tid >> 6);
    F.G = gridDim.x; { const int bx = blockIdx.x; F.vcu = (F.G % 8 == 0) ? (bx % 8) * (F.G / 8) + bx / 8 : bx; }
    F.ctl = (gu32*)(args.ws + WS_CTL);
    for (int u = F.tid; u < (LDS_BYTES - LDSCTL_OFF) / 4; u += NWAVES * 64) ((LAS unsigned*)(F.lds + LDSCTL_OFF))[u] = 0u;
    __syncthreads();
    const int lo = args.ph_lo, hi = args.ph_hi;
    XcdBarrier bar; bar.bar = (unsigned*)(F.ctl + CW_BAR) + args.li * XCD_BAR_WORDS; bar.x = 0; bar.st = (volatile LAS unsigned*)(F.lds + MISC_OFF + 32);
    if (hi - lo > 1) bar = xcd_barrier_post((unsigned*)(F.ctl + CW_BAR) + args.li * XCD_BAR_WORDS, (volatile LAS unsigned*)(F.lds + MISC_OFF + 32));
    unsigned char* ws = args.ws;
    struct InPtr { __device__ __forceinline__ const float* operator[](int k) const { int kk = k; asm volatile("" : "+s"(kk));
        const __attribute__((address_space(4))) char* ka = (const __attribute__((address_space(4))) char*)__builtin_amdgcn_kernarg_segment_ptr();
        return *(const float* const __attribute__((address_space(4)))*)(ka + 8 * kk); } } in;
    float* mod = (float*)(ws + WS_MOD); bf16* X = (bf16*)(ws + WS_X); bf16* H = (bf16*)(ws + WS_H); bf16* BIG = (bf16*)(ws + WS_BIG); bf16* MIX = (bf16*)(ws + WS_MIX);
    int* tok_e = (int*)(ws + WS_TOK); float* tok_w = (float*)(tok_e + 2 * NR); int* tok_rank = tok_e + 4 * NR; int* tok_slot = tok_e + 6 * NR;
#ifndef PH_MASK
#define PH_MASK 0xFFFFFFFFFFFFFFFFull
#endif
#define IN(k) ((((PH_MASK) >> (k)) & 1ull) && lo <= (k) && (k) < hi)
#define SEAM(k) do { if ((k) + 1 < hi) xcd_barrier(bar); } while (0)
#ifndef REP_PRO
#define REP_PRO 1
#endif
#ifndef REP_SCAN
#define REP_SCAN 1
#endif
#ifndef REP_GATE
#define REP_GATE 1
#endif
#ifndef REP_ATT
#define REP_ATT 1
#endif
#ifndef REP_GEMM
#define REP_GEMM 1
#endif
#ifndef REP_MOD
#define REP_MOD 1
#endif
#ifndef REP_SGU
#define REP_SGU 1
#endif
#define REPEAT(n) for (int _r = 0; _r < (n); ++_r, (_r < (n) ? xcd_barrier(bar) : (void)0)) if (({ asm volatile("" : "+v"(F.tid), "+v"(F.lane)); true; }))
#define MODP(layer, k) (mod + (size_t)(layer) * 5 * 6144 + (k) * 1024)
#define WB(off) ((const bf16*)(ws + (off)))

    if (IN(P_PRO)) { REPEAT(REP_PRO) { p0_prologue(F, in); } SEAM(P_PRO); }
    if (IN(P0_MOD)) { REPEAT(REP_MOD) { RowArgs a{}; a.normg = in[6]; a.shift = MODP(0, 0); a.scale = MODP(0, 1); a.row_lo = 0; a.row_hi = NR; rows_phase<false, false, false>(F, a); } SEAM(P0_MOD); }
#ifndef REP_WIN
#define REP_WIN REP_GEMM
#endif
#ifndef REP_GU
#define REP_GU REP_GEMM
#endif
#ifndef REP_MGU
#define REP_MGU REP_GEMM
#endif
#ifndef REP_MDN
#define REP_MDN REP_GEMM
#endif
#ifndef REP_WINNULL
#define REP_WINNULL 0
#endif
#ifndef REP_WINHALF
#define REP_WINHALF 0
#endif
    if (IN(P0_WIN)) { for (int _q = 0; _q < REP_WINHALF; ++_q) {
            if ((blockIdx.x & 8) == 0) { pg8::Gemm g{H, WB(W_RETIN), 1024, 1024}; pg8::StaticOrder S; S.init(68, 32, F.G / 2, (int)((blockIdx.x >> 4) * 8 + (blockIdx.x & 7)), 1024, 1024);
                pg8::EpiQKVG E{(bf16*)(ws + RET_QKV), (bf16*)(ws + RET_G), NR}; pg8::gemm_phase<pg8::EpiQKVG, pg8::StaticOrder, false, true>(F.lds, g, S, E); }
            xcd_barrier(bar); }
#ifndef REP_WINSHAPE
#define REP_WINSHAPE 0
#endif
#ifndef SHAPE_MODE
#define SHAPE_MODE 0
#endif
      for (int _q = 0; _q < REP_WINSHAPE; ++_q) { run_gemm(F, H, 1024, WB(W_RETIN), 1024, 68, 32, pg8::EpiShape<SHAPE_MODE>{(bf16*)(ws + RET_QKV)}); xcd_barrier(bar); }
      for (int _q = 0; _q < REP_WINNULL; ++_q) { run_gemm(F, H, 1024, WB(W_RETIN), 1024, 68, 32, pg8::EpiNull{(float*)(ws + WS_RSTD)}); xcd_barrier(bar); }
      REPEAT(REP_WIN) { run_gemm(F, H, 1024, WB(W_RETIN), 1024, 68, 32, pg8::EpiQKVG{(bf16*)(ws + RET_QKV), (bf16*)(ws + RET_G), NR}); } SEAM(P0_WIN); }
#ifndef REP_PREP
#define REP_PREP 1
#endif
    if (IN(P0_PREP)) { REPEAT(REP_PREP) { ret_prep(F); } SEAM(P0_PREP); }
#ifndef REP_SCANDRY
#define REP_SCANDRY 0
#endif
#ifndef SCANDRY_MODE
#define SCANDRY_MODE 1
#endif
    if (IN(P0_SCAN)) { for (int _q = 0; _q < REP_SCANDRY; ++_q) { ret_scan<SCANDRY_MODE>(F, 0, in[11], in[12], true); xcd_barrier(bar); }
      REPEAT(REP_SCAN) { ret_scan(F, 0, in[11], in[12], true); } SEAM(P0_SCAN); }
#ifndef GATE_PROBE
#define GATE_PROBE 0
#endif
#ifndef REP_GATEPROBE
#define REP_GATEPROBE 0
#endif
    if (IN(P0_GATE)) { for (int _q = 0; _q < REP_GATEPROBE; ++_q) { ret_gate<GATE_PROBE>(F, in[13], in[14], 0); xcd_barrier(bar); }
      REPEAT(REP_GATE) { ret_gate(F, in[13], in[14], 0); } SEAM(P0_GATE); }
    if (IN(P0_WO)) { run_gemm_res(F, MIX, 2048, WB(W_RETO), 2048, MODP(0, 2)); SEAM(P0_WO); }
    if (IN(P0_MOD2)) { REPEAT(REP_MOD) { RowArgs a{}; a.normg = in[7]; a.shift = MODP(0, 3); a.scale = MODP(0, 4); a.row_lo = 0; a.row_hi = NR; a.ctx_nsplit = 8; a.ctx_gate = MODP(0, 2); rows_phase<false, false, false>(F, a); } SEAM(P0_MOD2); }
    if (IN(P0_GU)) { REPEAT(REP_GU) { run_gemm(F, H, 1024, WB(W_FFNGU), 1024, 68, 22, pg8::EpiSwiglu{(bf16*)(ws + FFN_HID), DFF, true}); } SEAM(P0_GU); }
    if (IN(P0_DOWN)) { run_gemm_res<true>(F, WB(FFN_HID), DFF, WB(W_FFND), DFF, MODP(0, 5)); SEAM(P0_DOWN); }
    if (IN(P1_MOD)) { REPEAT(REP_MOD) { RowArgs a{}; a.normg = in[6] + 1024; a.shift = MODP(1, 0); a.scale = MODP(1, 1); a.row_lo = 0; a.row_hi = NR; a.ctx_nsplit = 11; a.ctx_gate = MODP(0, 5); rows_phase<false, false, false>(F, a); } SEAM(P1_MOD); }
    if (IN(P1_WD)) { REPEAT(REP_GEMM) { run_gemm(F, H, 1024, WB(W_MLAD), 1024, 68, 3, pg8::EpiF32{(float*)(ws + MLA_CKV), 768, nullptr, 0, 0}); } SEAM(P1_WD); }
    if (IN(P1_ROWS)) { mla_rows(F, in[16], in[17]); SEAM(P1_ROWS); }
    if (IN(P1_UQ)) { REPEAT(REP_GEMM) {
        const bf16* A0 = WB(MLA_CQN); const bf16* A1 = WB(MLA_CKVN); const bf16* B0 = WB(W_UQ); const bf16* B1 = WB(W_UKV);
        pg8::Gemm g{A0, B0, 256, 256}; pg8::SguOrder S; S.su.init(68, 6, 1, 0, 256, 256); S.sv.init(68, 8, 1, 0, 256, 256); S.G = F.G; S.c = (int)blockIdx.x; S.nwg = S.su.nwg + S.sv.nwg;
        S.dA = (size_t)((const char*)A1 - (const char*)A0); S.dB = (size_t)((const char*)B1 - (const char*)B0);
        typedef pg8::EpiPair<pg8::EpiBf16<0>, pg8::EpiBf16<0>> EpiQKV;
        EpiQKV E{pg8::EpiBf16<0>{(bf16*)(ws + MLA_Q), 1536}, pg8::EpiBf16<0>{(bf16*)(ws + MLA_KV), KVR_LD}};
        pg8::gemm_phase<EpiQKV, pg8::SguOrder, false, true>(F.lds, g, S, E); } SEAM(P1_UQ); }
#ifndef REP_ATTNODMA
#define REP_ATTNODMA 0
#endif
    if (IN(P1_ATT)) { for (int _q = 0; _q < REP_ATTNODMA; ++_q) { attn_phase<true>(F); xcd_barrier(bar); }
      REPEAT(REP_ATT) { attn_phase(F); } SEAM(P1_ATT); }
    if (IN(P1_WO)) { run_gemm_res(F, WB(MLA_O), 1024, WB(W_MLAO), 1024, MODP(1, 2)); SEAM(P1_WO); }
    if (IN(P1_MOD2)) { RowArgs a{}; a.normg = in[7] + 1024; a.shift = MODP(1, 3); a.scale = MODP(1, 4); a.row_lo = 0; a.row_hi = NR;
                  a.w_router = in[28]; a.tok_e = tok_e; a.tok_wo = tok_w; a.tok_rank = tok_rank; a.cnt = F.ctl + CW_MOECNT; a.ctx_nsplit = 4; a.ctx_gate = MODP(1, 2); rows_phase<false, true, false>(F, a); SEAM(P1_MOD2); }
    if (IN(P1_LIST)) { moe_lists(F, F.ctl + CW_MOECNT, 0, NR); SEAM(P1_LIST); }
#if defined(PROBE_SLEEP_US)
    if (IN(P1_MGU)) { const unsigned long long t0 = __builtin_amdgcn_s_memrealtime(); while (__builtin_amdgcn_s_memrealtime() - t0 < (unsigned long long)PROBE_SLEEP_US * 100ull) __builtin_amdgcn_s_sleep(32); }
#endif
    if (IN(P1_MGU)) { REPEAT(REP_MGU) { moe_gemms_gu(F, F.ctl + CW_MOECNT, WB(W_MOEGU)); } SEAM(P1_MGU); }
    if (IN(P1_MDN)) { REPEAT(REP_MDN) { moe_gemms_down(F, F.ctl + CW_MOECNT, WB(W_MOED)); } SEAM(P1_MDN); }
    if (IN(P2_MOD)) { RowArgs a{}; a.normg = in[6] + 2048; a.shift = MODP(2, 0); a.scale = MODP(2, 1); a.row_lo = 0; a.row_hi = NR;
                  a.gate_prev = MODP(1, 5); a.Y = (const bf16*)(ws + MOE_Y); a.tok_slot = tok_slot; a.tok_w = tok_w; rows_phase<true, false, false>(F, a); SEAM(P2_MOD); }
#ifndef REP_SGUIN
#define REP_SGUIN 1
#endif
    if (IN(P2_WIN)) { REPEAT(REP_SGUIN) {
        const bf16* Wu = WB(W_SGUIN); const bf16* Wv = WB(W_SGUIN + (size_t)3072 * 1024 * 2);
        pg8::Gemm g{H, Wu, 1024, 1024}; pg8::SguOrder S; S.su.init(68, 12, 1, 0, 1024, 1024); S.sv.init(12, 68, 1, 0, 1024, 1024); S.G = F.G; S.c = (int)blockIdx.x; S.nwg = S.su.nwg + S.sv.nwg;
        S.dA = (size_t)((const char*)Wv - (const char*)H); S.dB = (size_t)((const char*)H - (const char*)Wu);
        pg8::EpiSguIn E{pg8::EpiBf16<3>{(bf16*)(ws + SGU_UV), 3072}, pg8::EpiVT{(bf16*)(ws + SGU_VT), 3072, (float*)(ws + SGU_SSQ), NR}};
        pg8::gemm_phase<pg8::EpiSguIn, pg8::SguOrder, false, true, false, false>(F.lds, g, S, E); } SEAM(P2_WIN); }
    if (IN(P2_SPA)) { REPEAT(REP_SGU) { sgu_spatial(F, in[22], in[24]); } SEAM(P2_SPA); }
    if (IN(P2_WOUT)) { run_gemm_res(F, WB(SGU_UZ), 3072, WB(W_SGUOUT), 3072, MODP(2, 2)); SEAM(P2_WOUT); }
    if (IN(P2_MOD2)) { REPEAT(REP_MOD) { RowArgs a{}; a.normg = in[7] + 2048; a.shift = MODP(2, 3); a.scale = MODP(2, 4); a.row_lo = 0; a.row_hi = NR; a.ctx_nsplit = 12; a.ctx_gate = MODP(2, 2); rows_phase<false, false, false>(F, a); } SEAM(P2_MOD2); }
    if (IN(P2_GU)) { REPEAT(REP_GEMM) { run_gemm(F, H, 1024, WB(W_FFNGU + (size_t)2 * DFF * 1024 * 2), 1024, 68, 22, pg8::EpiSwiglu{(bf16*)(ws + FFN_HID), DFF, true}); } SEAM(P2_GU); }
    if (IN(P2_DOWN)) { run_gemm_res<true>(F, WB(FFN_HID), DFF, WB(W_FFND + (size_t)1024 * DFF * 2), DFF, MODP(2, 5)); SEAM(P2_DOWN); }
    if (IN(P3_MOD)) { REPEAT(REP_MOD) { RowArgs a{}; a.normg = in[6] + 3072; a.shift = MODP(3, 0); a.scale = MODP(3, 1); a.row_lo = 0; a.row_hi = NR; a.ctx_nsplit = 11; a.ctx_gate = MODP(2, 5); rows_phase<false, false, false>(F, a); } SEAM(P3_MOD); }
    if (IN(P3_WIN)) { REPEAT(REP_GEMM) { run_gemm(F, H, 1024, WB(W_RETIN + (size_t)RET_NIN * 1024 * 2), 1024, 68, 32, pg8::EpiQKVG{(bf16*)(ws + RET_QKV), (bf16*)(ws + RET_G), NR}); } SEAM(P3_WIN); }
    if (IN(P3_PREP)) { REPEAT(REP_PREP) { ret_prep(F); } SEAM(P3_PREP); }
#ifndef REP_SCAN3
#define REP_SCAN3 REP_SCAN
#endif
    if (IN(P3_SCAN)) { REPEAT(REP_SCAN3) { ret_scan(F, 1, in[11], in[12], false); } SEAM(P3_SCAN); }
    if (IN(P3_GATE)) { REPEAT(REP_GATE) { ret_gate(F, in[13] + 2048, in[14] + 2048, NCTX); } SEAM(P3_GATE); }
    if (IN(P3_WO)) { run_gemm(F, MIX + (size_t)NCTX * 2048, 2048, WB(W_RETO + (size_t)1024 * 2048 * 2), 2048, 64, 4, pg8::EpiRes{X + (size_t)NCTX * 1024, MODP(3, 2), 4, nullptr}); SEAM(P3_WO); }
    if (IN(P3_MOD2)) { RowArgs a{}; a.normg = in[7] + 3072; a.shift = MODP(3, 3); a.scale = MODP(3, 4); a.row_lo = NCTX; a.row_hi = NR;
                  a.w_router = in[28] + 8192; a.tok_e = tok_e; a.tok_wo = tok_w; a.tok_rank = tok_rank; a.cnt = F.ctl + CW_MOECNT + 512; rows_phase<false, true, false>(F, a); SEAM(P3_MOD2); }
    if (IN(P3_LIST)) { moe_lists(F, F.ctl + CW_MOECNT + 512, NCTX, NR); SEAM(P3_LIST); }
    if (IN(P3_MGU)) { REPEAT(REP_GEMM) { moe_gemms_gu(F, F.ctl + CW_MOECNT + 512, WB(W_MOEGU + (size_t)8 * 2 * EFF * 1024 * 2)); } SEAM(P3_MGU); }
    if (IN(P3_MDN)) { REPEAT(REP_GEMM) { moe_gemms_down(F, F.ctl + CW_MOECNT + 512, WB(W_MOED + (size_t)8 * 1024 * EFF * 2)); } SEAM(P3_MDN); }
    if (IN(P3_FIN)) { RowArgs a{}; a.normg = in[8]; a.row_lo = NCTX; a.row_hi = NR; a.gate_prev = MODP(3, 5); a.Y = (const bf16*)(ws + MOE_Y); a.tok_slot = tok_slot; a.tok_w = tok_w; a.out = args.out;
                  rows_phase<true, false, true>(F, a); }
#undef IN
#undef SEAM
#undef MODP
#undef WB
}

#ifndef MK_PER_PHASE
#define MK_PER_PHASE 0
#endif
extern "C" void kernel_launch(void* const* d_in, const int* in_sizes, int n_in, void* d_out, int out_size, void* d_ws, size_t ws_size, hipStream_t stream) {
    static int grid = 0;
    if (grid == 0) {
        if (n_in != 31 || out_size != NLAT * D || ws_size < WS_END) { fprintf(stderr, "kernel_launch: unexpected shapes: n_in %d out %d ws %zu (need %zu)\n", n_in, out_size, ws_size, (size_t)WS_END); grid = -1; return; }
        int dev = 0, cus = 0, per_cu = 0;
        if (hipGetDevice(&dev) != hipSuccess || hipDeviceGetAttribute(&cus, hipDeviceAttributeMultiprocessorCount, dev) != hipSuccess) { grid = -1; return; }
        if (hipFuncSetAttribute((const void*)mega_fwd, hipFuncAttributeMaxDynamicSharedMemorySize, LDS_BYTES) != hipSuccess) { fprintf(stderr, "kernel_launch: hipFuncSetAttribute failed\n"); grid = -1; return; }
        if (hipOccupancyMaxActiveBlocksPerMultiprocessor(&per_cu, (const void*)mega_fwd, NWAVES * 64, LDS_BYTES) != hipSuccess || per_cu < 1)
            fprintf(stderr, "kernel_launch: note: occupancy query reports %d workgroups per CU\n", per_cu);
        (void)hipGetLastError();
        grid = cus;
    }
    if (grid < 0) return;
    if (hipMemsetAsync((char*)d_ws + WS_CTL, 0, CTL_ZERO_BYTES, stream) != hipSuccess) return;
    Args a{};
    for (int i = 0; i < 31; ++i) a.in[i] = (const float*)d_in[i];
    a.out = (float*)d_out; a.ws = (unsigned char*)d_ws; a.pad = 0;
#if MK_PER_PHASE
    for (int p = 0; p < NPH; ++p) { a.ph_lo = p; a.ph_hi = p + 1; a.li = 0; hipLaunchKernelGGL(mega_fwd, dim3(grid), dim3(NWAVES * 64), LDS_BYTES, stream, a); }
#else
    a.ph_lo = 0; a.ph_hi = NPH; a.li = 0; hipLaunchKernelGGL(mega_fwd, dim3(grid), dim3(NWAVES * 64), LDS_BYTES, stream, a);
#endif
    const hipError_t le = hipPeekAtLastError();
    if (le != hipSuccess) fprintf(stderr, "kernel_launch: launch failed: %s\n", hipGetErrorName(le));
}
```
